# Optimizing an MI355X kernel written in HIP

```python
import jax, jax.numpy as jnp
from jax import lax
import numpy as np

D_MODEL = 1024
BATCH = 4
SEQ = 4096
DEPTH = 1

N_META = 16
ATTN_BLOCK = 128
META_PAD = ATTN_BLOCK - N_META
PREFIX = ATTN_BLOCK
FOX_HEADS = 8
FOX_HEAD_DIM = 64
FOX_WIDTH = FOX_HEADS * FOX_HEAD_DIM
DN_HEADS = 4
DN_HEAD_DIM = 128
DN_WIDTH = DN_HEADS * DN_HEAD_DIM
DN_CHUNK = 64
CONV_WIDTH = 4
D_FF = -(-8 * D_MODEL // (3 * 256)) * 256
EPS = 1e-6
NEG_INF = -1e30
IN_SPLITS = (FOX_WIDTH, FOX_WIDTH, FOX_WIDTH, FOX_HEADS,
             DN_WIDTH, DN_WIDTH, DN_WIDTH, DN_HEADS, DN_HEADS,
             DN_WIDTH,
             D_MODEL, D_MODEL)
D_IN = sum(IN_SPLITS)

kernel_name = "fox_gdn_gated_hybrid_block"


def rmsnorm(x, w):
    xf = x.astype(jnp.float32)
    y = xf * lax.rsqrt(jnp.mean(xf * xf, axis=-1, keepdims=True) + EPS)
    return (y * w.astype(jnp.float32)).astype(x.dtype)


def l2norm(x):
    return x * lax.rsqrt(jnp.sum(x * x, axis=-1, keepdims=True) + EPS)


def split_columns(t, sizes):
    out, start = [], 0
    for s in sizes:
        out.append(t[..., start:start + s])
        start += s
    return out


def causal_short_conv(u, w):
    K = w.shape[0]
    L = u.shape[1]
    up = jnp.pad(u, ((0, 0), (K - 1, 0), (0, 0)))
    return sum(up[:, i:i + L, :] * w[i] for i in range(K))


def fox_attention(q, k, v, log_f, valid):
    B, L, H, dh = q.shape
    nb = L // ATTN_BLOCK
    qf = q.astype(jnp.float32) * (dh ** -0.5)
    kf = k.astype(jnp.float32)
    vf = v.astype(jnp.float32)
    c = jnp.cumsum(log_f, axis=1)
    c_keys = c.transpose(0, 2, 1)
    kpos = jnp.arange(L)
    q_blocks = qf.reshape(B, nb, ATTN_BLOCK, H, dh).transpose(1, 0, 2, 3, 4)
    c_blocks = c.reshape(B, nb, ATTN_BLOCK, H).transpose(1, 0, 3, 2)

    def one_block(args):
        qb, cb, bi = args
        qpos = bi * ATTN_BLOCK + jnp.arange(ATTN_BLOCK)
        s = jnp.einsum('bqhd,bkhd->bhqk', qb, kf)
        s = s + cb[..., :, None] - c_keys[:, :, None, :]
        mask = (kpos[None, :] <= qpos[:, None]) & valid[None, :]
        s = jnp.where(mask, s, NEG_INF)
        p = jax.nn.softmax(s, axis=-1)
        return jnp.einsum('bhqk,bkhd->bqhd', p, vf)

    o = lax.map(one_block, (q_blocks, c_blocks, jnp.arange(nb)))
    return o.transpose(1, 0, 2, 3, 4).reshape(B, L, H * dh)


def gated_delta_rule(q, k, v, g, beta):
    B, H, L, dk = q.shape
    dv = v.shape[-1]
    C = DN_CHUNK
    N = L // C
    q = q * (dk ** -0.5)
    q, k, v = (t.reshape(B, H, N, C, t.shape[-1]) for t in (q, k, v))
    g, beta = (t.reshape(B, H, N, C) for t in (g, beta))
    gc = jnp.cumsum(g, axis=-1)
    tril = jnp.tril(jnp.ones((C, C), dtype=bool))
    strict = jnp.tril(jnp.ones((C, C), dtype=bool), -1)
    decay = jnp.exp(jnp.where(tril, gc[..., :, None] - gc[..., None, :], -jnp.inf))
    kb = k * beta[..., None]
    low = jnp.where(strict, jnp.einsum('bhncd,bhnsd->bhncs', kb, k) * decay, 0.0)
    a = low + jnp.eye(C, dtype=jnp.float32)
    rhs = jnp.concatenate([v * beta[..., None], kb * jnp.exp(gc)[..., None]], axis=-1)
    sol = lax.linalg.triangular_solve(a, rhs, left_side=True, lower=True, unit_diagonal=True)
    u, w = sol[..., :dv], sol[..., dv:]
    attn = jnp.einsum('bhncd,bhnsd->bhncs', q, k) * decay
    q_dec = q * jnp.exp(gc)[..., None]
    k_dec = k * jnp.exp(gc[..., -1:] - gc)[..., None]
    chunk_decay = jnp.exp(gc[..., -1])
    xs = tuple(jnp.moveaxis(t, 2, 0) for t in (q_dec, k_dec, u, w, attn, chunk_decay))

    def step(S, inp):
        qd, kd, uc, wc, ac, cd = inp
        v_new = uc - jnp.einsum('bhcd,bhde->bhce', wc, S)
        o = jnp.einsum('bhcd,bhde->bhce', qd, S) + jnp.einsum('bhcs,bhse->bhce', ac, v_new)
        S = S * cd[..., None, None] + jnp.einsum('bhcd,bhce->bhde', kd, v_new)
        return S, o

    S0 = jnp.zeros((B, H, dk, dv), jnp.float32)
    _, o = lax.scan(step, S0, xs)
    return jnp.moveaxis(o, 0, 2).reshape(B, H, L, dv)


def hybrid_mixer(h, valid, w_in, fox_forget_bias, dn_conv_w, dn_a_log, dn_dt_bias,
                 dn_out_norm_w, w_branch_fox, w_branch_dn, w_out):
    B, L, _ = h.shape
    proj = h @ w_in
    (fq, fk, fv, f_logit, dq, dk_, dv_, b_logit, a_logit, dz, ga, gb) = split_columns(proj, IN_SPLITS)
    vm = valid[None, :, None].astype(h.dtype)

    log_f = jax.nn.log_sigmoid(f_logit.astype(jnp.float32) + fox_forget_bias.astype(jnp.float32))
    rs_f = lambda t: t.reshape(B, L, FOX_HEADS, FOX_HEAD_DIM)
    o_fox = fox_attention(rs_f(fq), rs_f(fk), rs_f(fv), log_f, valid).astype(h.dtype)

    qkv = jax.nn.silu(causal_short_conv(jnp.concatenate([dq, dk_, dv_], axis=-1) * vm, dn_conv_w))
    qkv = qkv.astype(jnp.float32)
    rs_d = lambda t: t.reshape(B, L, DN_HEADS, DN_HEAD_DIM).transpose(0, 2, 1, 3)
    q_d = l2norm(rs_d(qkv[..., :DN_WIDTH]))
    k_d = l2norm(rs_d(qkv[..., DN_WIDTH:2 * DN_WIDTH]))
    v_d = rs_d(qkv[..., 2 * DN_WIDTH:])
    vmf = valid[None, None, :].astype(jnp.float32)
    beta = jax.nn.sigmoid(b_logit.astype(jnp.float32)).transpose(0, 2, 1) * vmf
    g = (-jnp.exp(dn_a_log.astype(jnp.float32))[None, :, None]
         * jax.nn.softplus(a_logit.astype(jnp.float32) + dn_dt_bias.astype(jnp.float32)).transpose(0, 2, 1)) * vmf
    o_dn = gated_delta_rule(q_d, k_d, v_d, g, beta).transpose(0, 2, 1, 3)
    z = dz.reshape(B, L, DN_HEADS, DN_HEAD_DIM)
    o_dn = (rmsnorm(o_dn, dn_out_norm_w) * jax.nn.silu(z.astype(jnp.float32))).reshape(B, L, DN_WIDTH)
    o_dn = o_dn.astype(h.dtype)

    y = jax.nn.sigmoid(ga) * (o_fox @ w_branch_fox) + jax.nn.sigmoid(gb) * (o_dn @ w_branch_dn)
    return y @ w_out


def swiglu(h, w_gate, w_up, w_down):
    return (jax.nn.silu(h @ w_gate) * (h @ w_up)) @ w_down


def setup_inputs(seed: int = 0) -> dict:
    key = jax.random.key(seed)
    ks = jax.random.split(key, 20)
    f32 = jnp.float32
    nrm = lambda k, shape, s: jax.random.normal(k, shape, f32) * s
    dt = jnp.exp(jax.random.uniform(ks[7], (DEPTH, DN_HEADS), f32)
                 * (np.log(0.1) - np.log(0.001)) + np.log(0.001))
    return {
        "x": nrm(ks[0], (BATCH, SEQ, D_MODEL), 1.0),
        "meta_tokens": nrm(ks[1], (N_META, D_MODEL), 1.0),
        "mix_norm_w": 1.0 + nrm(ks[2], (DEPTH, D_MODEL), 0.02),
        "w_in": nrm(ks[3], (DEPTH, D_MODEL, D_IN), D_MODEL ** -0.5),
        "fox_forget_bias": 3.0 + nrm(ks[4], (DEPTH, FOX_HEADS), 0.1),
        "dn_conv_w": nrm(ks[5], (DEPTH, CONV_WIDTH, 3 * DN_WIDTH), CONV_WIDTH ** -0.5),
        "dn_a_log": jnp.log(jax.random.uniform(ks[6], (DEPTH, DN_HEADS), f32, 1.0, 16.0)),
        "dn_dt_bias": dt + jnp.log(-jnp.expm1(-dt)),
        "dn_out_norm_w": 1.0 + nrm(ks[8], (DEPTH, DN_HEAD_DIM), 0.02),
        "w_branch_fox": nrm(ks[9], (DEPTH, FOX_WIDTH, D_MODEL), FOX_WIDTH ** -0.5),
        "w_branch_dn": nrm(ks[10], (DEPTH, DN_WIDTH, D_MODEL), DN_WIDTH ** -0.5),
        "w_out": nrm(ks[11], (DEPTH, D_MODEL, D_MODEL), D_MODEL ** -0.5),
        "ffn_norm_w": 1.0 + nrm(ks[12], (DEPTH, D_MODEL), 0.02),
        "w_ffn_gate": nrm(ks[13], (DEPTH, D_MODEL, D_FF), D_MODEL ** -0.5),
        "w_ffn_up": nrm(ks[14], (DEPTH, D_MODEL, D_FF), D_MODEL ** -0.5),
        "w_ffn_down": nrm(ks[15], (DEPTH, D_FF, D_MODEL), D_FF ** -0.5),
        "final_norm_w": 1.0 + nrm(ks[16], (D_MODEL,), 0.02),
    }


def reference(x, meta_tokens, mix_norm_w, w_in, fox_forget_bias, dn_conv_w, dn_a_log,
              dn_dt_bias, dn_out_norm_w, w_branch_fox, w_branch_dn, w_out, ffn_norm_w,
              w_ffn_gate, w_ffn_up, w_ffn_down, final_norm_w):
    B = x.shape[0]
    pad = jnp.zeros((B, META_PAD, D_MODEL), x.dtype)
    meta = jnp.broadcast_to(meta_tokens.astype(x.dtype)[None], (B, N_META, D_MODEL))
    h = jnp.concatenate([pad, meta, x], axis=1)
    L = h.shape[1]
    valid = jnp.arange(L) >= META_PAD
    for l in range(DEPTH):
        h = h + hybrid_mixer(rmsnorm(h, mix_norm_w[l]), valid, w_in[l], fox_forget_bias[l],
                             dn_conv_w[l], dn_a_log[l], dn_dt_bias[l], dn_out_norm_w[l],
                             w_branch_fox[l], w_branch_dn[l], w_out[l])
        h = h + swiglu(rmsnorm(h, ffn_norm_w[l]), w_ffn_gate[l], w_ffn_up[l], w_ffn_down[l])
    h = rmsnorm(h, final_norm_w)
    return h[:, PREFIX:, :]
```

```cpp
#include <hip/hip_runtime.h>
#include <cstdint>
#include <cstdio>

typedef unsigned short bf16;
constexpr int NB = 4, SEQ = 4096, DM = 1024, LP = 4224, R = NB * LP, RT = NB * SEQ, DIN = 5648, DFF = 2816;
constexpr int NPAD = 112;
constexpr float EPS = 1e-6f;
constexpr float LOG2E = 1.4426950408889634f;
constexpr float C2 = 0.125f * LOG2E;

constexpr size_t MiB = 1u << 20;
constexpr size_t WS_LG = 1 * MiB;
constexpr size_t WS_CQ = 2 * MiB + 256 * 1024;
constexpr size_t WS_GG = 2 * MiB + 896 * 1024;
constexpr size_t WS_BT = 3 * MiB + 256 * 1024;
constexpr size_t WS_SS1 = 3 * MiB + 512 * 1024;
constexpr size_t WS_SS2 = 3 * MiB + 768 * 1024;
constexpr size_t WS_LF = 4 * MiB;
constexpr size_t WS_WIN = 5 * MiB;
constexpr size_t WS_WG = 12 * MiB;
constexpr size_t WS_WB = 16 * MiB;
constexpr size_t WS_WOUT = 18 * MiB;
constexpr size_t WS_WGU = 20 * MiB;
constexpr size_t WS_WDN = 31 * MiB;
constexpr size_t WS_HN = 37 * MiB;
constexpr size_t WS_OD = 70 * MiB;
constexpr size_t WS_FK = 103 * MiB;
constexpr size_t WS_FV = 119 * MiB + 512 * 1024;
constexpr size_t WS_DQKV = 136 * MiB;
constexpr size_t WS_DZ = 185 * MiB + 512 * 1024;
constexpr size_t WS_Y = 202 * MiB;
constexpr size_t WS_HID = 70 * MiB;
constexpr size_t WS_END = 256 * MiB;

__device__ __forceinline__ unsigned f2bf(float f) { unsigned u = __builtin_bit_cast(unsigned, f); return (u + 0x7fffu + ((u >> 16) & 1u)) >> 16; }
__device__ __forceinline__ float bf2f(bf16 b) { return __builtin_bit_cast(float, (unsigned)b << 16); }
__device__ __forceinline__ float sigmoidf_(float x) { return 1.f / (1.f + expf(-x)); }
__device__ __forceinline__ float siluf_(float x) { return x / (1.f + expf(-x)); }
__device__ __forceinline__ int nat_row(int m) { return (m >> 12) * LP + 128 + (m & 4095); }

__global__ void nv_wconv(int mode, const float* __restrict__ src, const float* __restrict__ src2, const float* __restrict__ scale, bf16* __restrict__ dst, int N, int K, int srcN, int ldk, int koff) {
    const int n = blockIdx.x * 64 + (threadIdx.x & 63); const int k = blockIdx.y * 4 + (threadIdx.x >> 6);
    if (n >= N || k >= K) return;
    int col = n; const float* s = src;
    if (mode == 0) col = n < 1536 ? n : (n < 3072 ? n + 8 : n + 16);
    else if (mode == 1) col = 3600 + n;
    else if (mode == 5) { const int t = n >> 8, jj = n & 255; if (jj < 128) col = t * 128 + jj; else { col = t * 128 + jj - 128; s = src2; } }
    float v = s[(size_t)k * srcN + col]; if (scale) v *= scale[k];
    dst[(size_t)n * ldk + koff + k] = (bf16)f2bf(v);
}

__global__ void __launch_bounds__(256) nv_hn(const float* __restrict__ x, const float* __restrict__ meta, const float* __restrict__ nw, const float* __restrict__ w_in,
                                             const float* __restrict__ fbias, const float* __restrict__ a_log, const float* __restrict__ dt_bias,
                                             bf16* __restrict__ HN, float* __restrict__ LF, float* __restrict__ GG, float* __restrict__ BT) {
    __shared__ float hs[1024]; __shared__ float red[4];
    const int r = blockIdx.x, b = r / LP, pos = r % LP, tid = threadIdx.x;
    const float* src = pos < NPAD ? nullptr : (pos < 128 ? meta + (size_t)(pos - NPAD) * DM : x + ((size_t)b * SEQ + (pos - 128)) * DM);
    float v[4]; float ss = 0.f;
    for (int j = 0; j < 4; ++j) { v[j] = src ? src[tid + 256 * j] : 0.f; ss += v[j] * v[j]; }
    for (int o = 32; o > 0; o >>= 1) ss += __shfl_xor(ss, o);
    if ((tid & 63) == 0) red[tid >> 6] = ss;
    __syncthreads();
    const float rs = rsqrtf((red[0] + red[1] + red[2] + red[3]) * (1.f / DM) + EPS);
    for (int j = 0; j < 4; ++j) { const int c = tid + 256 * j; const float hn = v[j] * rs * nw[c]; hs[c] = hn; HN[(size_t)r * DM + c] = (bf16)f2bf(hn); }
    __syncthreads();
    const int j = tid >> 4, part = tid & 15;
    const int col = j < 8 ? 1536 + j : (j < 12 ? 3080 + (j - 8) : 3084 + (j - 12));
    float acc = 0.f;
    for (int k = part; k < DM; k += 16) acc += hs[k] * w_in[(size_t)k * DIN + col];
    acc += __shfl_xor(acc, 1); acc += __shfl_xor(acc, 2); acc += __shfl_xor(acc, 4); acc += __shfl_xor(acc, 8);
    if (part == 0) {
        const bool valid = pos >= NPAD;
        if (j < 8) { const float z = acc + fbias[j]; const float ls = fminf(z, 0.f) - log1pf(expf(-fabsf(z))); LF[(size_t)(b * 8 + j) * LP + pos] = ls; }
        else if (j < 12) { const int h = j - 8; BT[(size_t)(b * 4 + h) * LP + pos] = valid ? sigmoidf_(acc) : 0.f; }
        else { const int h = j - 12; const float z = acc + dt_bias[h]; const float sp = fmaxf(z, 0.f) + log1pf(expf(-fabsf(z))); GG[(size_t)(b * 4 + h) * LP + pos] = valid ? -expf(a_log[h]) * sp : 0.f; }
    }
}
__global__ void nv_scan(const float* __restrict__ LF, float* __restrict__ CQ) {
    __shared__ float buf[LP];
    const int bh = blockIdx.x;
    for (int i = threadIdx.x; i < LP; i += blockDim.x) buf[i] = LF[(size_t)bh * LP + i];
    __syncthreads();
    if (threadIdx.x == 0) { float c = 0.f; for (int i = 0; i < LP; ++i) { if (i >= NPAD) { c += buf[i]; buf[i] = c * LOG2E; } else buf[i] = 1e30f; } }
    __syncthreads();
    for (int i = threadIdx.x; i < LP; i += blockDim.x) CQ[(size_t)bh * LP + i] = buf[i];
}

template <class Epi, int NACC> __global__ void __launch_bounds__(256) nv_gemm(const bf16* __restrict__ A, int lda, int amap, const bf16* __restrict__ Bt, int ldb, int bmap, int K, Epi E) {
    __shared__ float As[16][68]; __shared__ float Bs[NACC][16][68];
    const int tid = threadIdx.x, tx = tid & 15, ty = tid >> 4; const int m0 = blockIdx.y * 64, n0 = blockIdx.x * 64;
    const int lr = tid >> 2, lk = (tid & 3) * 4;
    const int am = m0 + lr; const size_t arow = amap ? (size_t)nat_row(am) : (size_t)am;
    const int bn = n0 + lr; size_t brow[NACC];
    if (bmap) { brow[0] = (size_t)((bn >> 7) * 256 + (bn & 127)); if (NACC > 1) brow[NACC - 1] = brow[0] + 128; } else { brow[0] = bn; if (NACC > 1) brow[NACC - 1] = bn; }
    float acc[NACC][4][4];
    for (int a = 0; a < NACC; ++a) for (int i = 0; i < 4; ++i) for (int j = 0; j < 4; ++j) acc[a][i][j] = 0.f;
    for (int k0 = 0; k0 < K; k0 += 16) {
        { const ushort4 av = *(const ushort4*)(A + arow * lda + k0 + lk); As[lk][lr] = bf2f(av.x); As[lk + 1][lr] = bf2f(av.y); As[lk + 2][lr] = bf2f(av.z); As[lk + 3][lr] = bf2f(av.w); }
        for (int a = 0; a < NACC; ++a) { const ushort4 bv = *(const ushort4*)(Bt + brow[a] * ldb + k0 + lk); Bs[a][lk][lr] = bf2f(bv.x); Bs[a][lk + 1][lr] = bf2f(bv.y); Bs[a][lk + 2][lr] = bf2f(bv.z); Bs[a][lk + 3][lr] = bf2f(bv.w); }
        __syncthreads();
#pragma unroll
        for (int k = 0; k < 16; ++k) { float av[4], bv[4];
            for (int i = 0; i < 4; ++i) av[i] = As[k][ty * 4 + i];
            for (int a = 0; a < NACC; ++a) { for (int j = 0; j < 4; ++j) bv[j] = Bs[a][k][tx * 4 + j];
                for (int i = 0; i < 4; ++i) for (int j = 0; j < 4; ++j) acc[a][i][j] += av[i] * bv[j]; } }
        __syncthreads();
    }
    for (int i = 0; i < 4; ++i) for (int j = 0; j < 4; ++j) { if (NACC == 1) E(m0 + ty * 4 + i, n0 + tx * 4 + j, acc[0][i][j], 0.f); else E(m0 + ty * 4 + i, n0 + tx * 4 + j, acc[0][i][j], acc[NACC - 1][i][j]); }
}
struct EpiG1 { bf16 *OD, *FK, *FV, *DQKV, *DZ;
    __device__ void operator()(int m, int n, float a, float) const {
        if (n < 512) OD[(size_t)m * 1024 + n] = (bf16)f2bf(a * C2);
        else if (n < 1024) FK[(size_t)m * 512 + n - 512] = (bf16)f2bf(a);
        else if (n < 1536) FV[(size_t)m * 512 + n - 1024] = (bf16)f2bf(a);
        else if (n < 3072) DQKV[(size_t)m * 1536 + n - 1536] = (bf16)f2bf(a);
        else DZ[(size_t)m * 512 + n - 3072] = (bf16)f2bf(a); } };
struct EpiGate { bf16* S; __device__ void operator()(int m, int n, float a, float) const { S[(size_t)m * 2048 + n] = (bf16)f2bf(sigmoidf_(a)); } };
struct EpiBrF { const bf16* S; bf16* Y; __device__ void operator()(int m, int n, float a, float) const { Y[(size_t)m * 1024 + n] = (bf16)f2bf(bf2f(S[(size_t)m * 2048 + n]) * a); } };
struct EpiBrD { const bf16* S; bf16* Y; __device__ void operator()(int m, int n, float a, float) const { Y[(size_t)m * 1024 + n] = (bf16)f2bf(bf2f(Y[(size_t)m * 1024 + n]) + bf2f(S[(size_t)m * 2048 + 1024 + n]) * a); } };
struct EpiOut { const float* x; float* out; bf16* H1B; __device__ void operator()(int m, int n, float a, float) const { const float h = x[(size_t)m * 1024 + n] + a; out[(size_t)m * 1024 + n] = h; H1B[(size_t)m * 1024 + n] = (bf16)f2bf(h); } };
struct EpiGU { const float* SS; bf16* HID; __device__ void operator()(int m, int n, float g, float u) const {
        const float rs = rsqrtf((SS[m] + SS[RT + m] + SS[2 * RT + m] + SS[3 * RT + m]) * (1.f / DM) + EPS); HID[(size_t)m * DFF + n] = (bf16)f2bf(siluf_(g * rs) * (u * rs)); } };
struct EpiDown { float* out; __device__ void operator()(int m, int n, float a, float) const { out[(size_t)m * 1024 + n] += a; } };

__global__ void __launch_bounds__(256) nv_sumsq(const float* __restrict__ out, float* __restrict__ SS) {
    __shared__ float red[4]; const int m = blockIdx.x, tid = threadIdx.x; float ss = 0.f;
    for (int j = 0; j < 4; ++j) { const float v = out[(size_t)m * DM + tid + 256 * j]; ss += v * v; }
    for (int o = 32; o > 0; o >>= 1) ss += __shfl_xor(ss, o);
    if ((tid & 63) == 0) red[tid >> 6] = ss;
    __syncthreads();
    if (tid == 0) { SS[m] = red[0] + red[1] + red[2] + red[3]; SS[RT + m] = 0.f; SS[2 * RT + m] = 0.f; SS[3 * RT + m] = 0.f; }
}
__global__ void __launch_bounds__(256) nv_final(float* __restrict__ out, const float* __restrict__ fw) {
    __shared__ float red[4]; const int m = blockIdx.x, tid = threadIdx.x; float v[4]; float ss = 0.f;
    for (int j = 0; j < 4; ++j) { v[j] = out[(size_t)m * DM + tid + 256 * j]; ss += v[j] * v[j]; }
    for (int o = 32; o > 0; o >>= 1) ss += __shfl_xor(ss, o);
    if ((tid & 63) == 0) red[tid >> 6] = ss;
    __syncthreads();
    const float rs = rsqrtf((red[0] + red[1] + red[2] + red[3]) * (1.f / DM) + EPS);
    for (int j = 0; j < 4; ++j) out[(size_t)m * DM + tid + 256 * j] = v[j] * rs * fw[tid + 256 * j];
}

__global__ void __launch_bounds__(128) nv_fox(bf16* __restrict__ OD, const bf16* __restrict__ FK, const bf16* __restrict__ FV, const float* __restrict__ CQ) {
    __shared__ float sc[2][LP]; __shared__ float qs[2][64];
    const int wid = threadIdx.x >> 6, lane = threadIdx.x & 63;
    const int gq = blockIdx.x * 2 + wid;
    const int i = gq & 4095, h = (gq >> 12) & 7, b = gq >> 15;
    const int posq = 128 + i; const size_t rowq = (size_t)b * LP + posq;
    const float* cq = CQ + (size_t)(b * 8 + h) * LP;
    qs[wid][lane] = bf2f(OD[rowq * 1024 + h * 64 + lane]);
    __syncthreads();
    const float cqq = cq[posq]; const int nk = posq - NPAD + 1;
    float mx = -INFINITY;
    for (int j = lane; j < nk; j += 64) { const int s = NPAD + j; const bf16* kr = FK + ((size_t)b * LP + s) * 512 + h * 64; float dot = 0.f;
        for (int d = 0; d < 64; d += 8) { const uint4 kv = *(const uint4*)(kr + d); const unsigned w[4] = {kv.x, kv.y, kv.z, kv.w};
            for (int e = 0; e < 4; ++e) { dot += qs[wid][d + 2 * e] * __builtin_bit_cast(float, w[e] << 16); dot += qs[wid][d + 2 * e + 1] * __builtin_bit_cast(float, w[e] & 0xffff0000u); } }
        const float xv = dot + cqq - cq[s]; sc[wid][j] = xv; mx = fmaxf(mx, xv); }
    for (int o = 32; o > 0; o >>= 1) mx = fmaxf(mx, __shfl_xor(mx, o));
    float l = 0.f;
    for (int j = lane; j < nk; j += 64) { const float p = exp2f(sc[wid][j] - mx); sc[wid][j] = p; l += p; }
    for (int o = 32; o > 0; o >>= 1) l += __shfl_xor(l, o);
    __syncthreads();
    float o = 0.f; const bf16* vb = FV + ((size_t)b * LP + NPAD) * 512 + h * 64 + lane;
    for (int j = 0; j < nk; ++j) o += sc[wid][j] * bf2f(vb[(size_t)j * 512]);
    OD[rowq * 1024 + h * 64 + lane] = (bf16)f2bf(o / l);
}

__global__ void __launch_bounds__(128) nv_dnconv(const bf16* __restrict__ DQKV, const float* __restrict__ cw, bf16* __restrict__ QKVN) {
    __shared__ float red[2];
    const int r = blockIdx.x, pos = r % LP, grp = blockIdx.y;
    const int ch = grp * 128 + threadIdx.x; float acc = 0.f;
    for (int i = 0; i < 4; ++i) { const int p = pos - 3 + i; if (p >= 0) acc += cw[i * 1536 + ch] * bf2f(DQKV[(size_t)(r - 3 + i) * 1536 + ch]); }
    float v = siluf_(acc);
    if (grp < 8) { float ss = v * v; for (int o = 32; o > 0; o >>= 1) ss += __shfl_xor(ss, o); if ((threadIdx.x & 63) == 0) red[threadIdx.x >> 6] = ss; __syncthreads(); v *= rsqrtf(red[0] + red[1] + EPS); }
    QKVN[(size_t)r * 1536 + ch] = (bf16)f2bf(v);
}
__global__ void __launch_bounds__(128) nv_dnrec(const bf16* __restrict__ QKVN, const float* __restrict__ GG, const float* __restrict__ BT, const bf16* __restrict__ DZ, const float* __restrict__ onw, bf16* __restrict__ OD) {
    __shared__ float ks[128], qs[128], red[2];
    const int bh = blockIdx.x, b = bh >> 2, h = bh & 3, e = threadIdx.x;
    float S[128];
#pragma unroll
    for (int d = 0; d < 128; ++d) S[d] = 0.f;
    const float nw = onw[e]; const float scale = 0.08838834764831845f;
    for (int pos = NPAD; pos < LP; ++pos) {
        const size_t row = (size_t)b * LP + pos;
        __syncthreads();
        qs[e] = bf2f(QKVN[row * 1536 + h * 128 + e]) * scale; ks[e] = bf2f(QKVN[row * 1536 + 512 + h * 128 + e]);
        const float v = bf2f(QKVN[row * 1536 + 1024 + h * 128 + e]);
        const float g = GG[(size_t)bh * LP + pos], beta = BT[(size_t)bh * LP + pos];
        __syncthreads();
        const float dec = expf(g); float kS = 0.f;
#pragma unroll
        for (int d = 0; d < 128; ++d) { S[d] *= dec; kS += ks[d] * S[d]; }
        const float vn = beta * (v - kS); float o = 0.f;
#pragma unroll
        for (int d = 0; d < 128; ++d) { S[d] += ks[d] * vn; o += qs[d] * S[d]; }
        float ss = o * o; for (int of = 32; of > 0; of >>= 1) ss += __shfl_xor(ss, of);
        if ((e & 63) == 0) red[e >> 6] = ss;
        __syncthreads();
        const float rs = rsqrtf((red[0] + red[1]) * (1.f / 128.f) + EPS);
        const float z = bf2f(DZ[row * 512 + h * 128 + e]);
        OD[row * 1024 + 512 + h * 128 + e] = (bf16)f2bf(o * rs * nw * siluf_(z));
    }
}

extern "C" void kernel_launch(void* const* d_in, const int* in_sizes, int n_in, void* d_out, int out_size, void* d_ws, size_t ws_size, hipStream_t stream) {
    if (n_in != 17 || ws_size < WS_END || out_size != RT * DM) { fprintf(stderr, "kernel_launch: unexpected shapes (n_in %d, ws %zu, out %d)\n", n_in, ws_size, out_size); return; }
    const float* x = (const float*)d_in[0]; const float* meta = (const float*)d_in[1]; const float* mix_nw = (const float*)d_in[2]; const float* w_in = (const float*)d_in[3];
    const float* fbias = (const float*)d_in[4]; const float* conv_w = (const float*)d_in[5]; const float* a_log = (const float*)d_in[6]; const float* dt_bias = (const float*)d_in[7];
    const float* onw = (const float*)d_in[8]; const float* wbf = (const float*)d_in[9]; const float* wbd = (const float*)d_in[10]; const float* wout = (const float*)d_in[11];
    const float* ffn_nw = (const float*)d_in[12]; const float* wg = (const float*)d_in[13]; const float* wu = (const float*)d_in[14]; const float* wd = (const float*)d_in[15]; const float* fnw = (const float*)d_in[16];
    unsigned char* ws = (unsigned char*)d_ws; float* out = (float*)d_out;
    float *CQ = (float*)(ws + WS_CQ), *GG = (float*)(ws + WS_GG), *BT = (float*)(ws + WS_BT), *SS1 = (float*)(ws + WS_SS1), *LF = (float*)(ws + WS_LF);
    bf16 *WIN = (bf16*)(ws + WS_WIN), *WG = (bf16*)(ws + WS_WG), *WB = (bf16*)(ws + WS_WB), *WOUT = (bf16*)(ws + WS_WOUT), *WGU = (bf16*)(ws + WS_WGU), *WDN = (bf16*)(ws + WS_WDN);
    bf16 *HN = (bf16*)(ws + WS_HN), *OD = (bf16*)(ws + WS_OD), *FK = (bf16*)(ws + WS_FK), *FV = (bf16*)(ws + WS_FV), *DQKV = (bf16*)(ws + WS_DQKV), *DZ = (bf16*)(ws + WS_DZ), *Y = (bf16*)(ws + WS_Y), *HID = (bf16*)(ws + WS_HID);
    bf16* H1B = HN; bf16* SCR = (bf16*)d_out;
    nv_wconv<<<dim3(3584 / 64, 1024 / 4), 256, 0, stream>>>(0, w_in, nullptr, nullptr, WIN, 3584, 1024, DIN, 1024, 0);
    nv_wconv<<<dim3(2048 / 64, 1024 / 4), 256, 0, stream>>>(1, w_in, nullptr, nullptr, WG, 2048, 1024, DIN, 1024, 0);
    nv_wconv<<<dim3(1024 / 64, 512 / 4), 256, 0, stream>>>(2, wbf, nullptr, nullptr, WB, 1024, 512, 1024, 1024, 0);
    nv_wconv<<<dim3(1024 / 64, 512 / 4), 256, 0, stream>>>(3, wbd, nullptr, nullptr, WB, 1024, 512, 1024, 1024, 512);
    nv_wconv<<<dim3(1024 / 64, 1024 / 4), 256, 0, stream>>>(4, wout, nullptr, nullptr, WOUT, 1024, 1024, 1024, 1024, 0);
    nv_wconv<<<dim3(5632 / 64, 1024 / 4), 256, 0, stream>>>(5, wg, wu, ffn_nw, WGU, 5632, 1024, DFF, 1024, 0);
    nv_wconv<<<dim3(1024 / 64, 2816 / 4), 256, 0, stream>>>(6, wd, nullptr, nullptr, WDN, 1024, 2816, 1024, 2816, 0);
    nv_hn<<<R, 256, 0, stream>>>(x, meta, mix_nw, w_in, fbias, a_log, dt_bias, HN, LF, GG, BT);
    nv_scan<<<32, 256, 0, stream>>>(LF, CQ);
    nv_gemm<EpiG1, 1><<<dim3(3584 / 64, R / 64), 256, 0, stream>>>(HN, 1024, 0, WIN, 1024, 0, 1024, EpiG1{OD, FK, FV, DQKV, DZ});
    nv_fox<<<NB * 8 * SEQ / 2, 128, 0, stream>>>(OD, FK, FV, CQ);
    nv_dnconv<<<dim3(R, 12), 128, 0, stream>>>(DQKV, conv_w, SCR);
    nv_dnrec<<<16, 128, 0, stream>>>(SCR, GG, BT, DZ, onw, OD);
    nv_gemm<EpiGate, 1><<<dim3(2048 / 64, RT / 64), 256, 0, stream>>>(HN, 1024, 1, WG, 1024, 0, 1024, EpiGate{SCR});
    nv_gemm<EpiBrF, 1><<<dim3(1024 / 64, RT / 64), 256, 0, stream>>>(OD, 1024, 1, WB, 1024, 0, 512, EpiBrF{SCR, Y});
    nv_gemm<EpiBrD, 1><<<dim3(1024 / 64, RT / 64), 256, 0, stream>>>(OD + 512, 1024, 1, WB + 512, 1024, 0, 512, EpiBrD{SCR, Y});
    nv_gemm<EpiOut, 1><<<dim3(1024 / 64, RT / 64), 256, 0, stream>>>(Y, 1024, 0, WOUT, 1024, 0, 1024, EpiOut{x, out, H1B});
    nv_sumsq<<<RT, 256, 0, stream>>>(out, SS1);
    nv_gemm<EpiGU, 2><<<dim3(DFF / 64, RT / 64), 256, 0, stream>>>(H1B, 1024, 0, WGU, 1024, 1, 1024, EpiGU{SS1, HID});
    nv_gemm<EpiDown, 1><<<dim3(1024 / 64, RT / 64), 256, 0, stream>>>(HID, DFF, 0, WDN, DFF, 0, DFF, EpiDown{out});
    nv_final<<<RT, 256, 0, stream>>>(out, fnw);
}
```

```cpp
#include <hip/hip_runtime.h>
#include <hip/hip_cooperative_groups.h>
#include <hip/hip_bf16.h>
#include <cmath>
#include <cstdint>
#include <cstdio>

namespace cg = cooperative_groups;
typedef unsigned short bf16;
constexpr int NB = 4, SEQ = 4096, DM = 1024, LP = 4224, R = NB * LP, RT = NB * SEQ, DIN = 5648, DFF = 2816;
constexpr int NPAD = 112;
constexpr float EPS = 1e-6f;
constexpr float LOG2E = 1.4426950408889634f;
constexpr float C2 = 0.125f * LOG2E;

constexpr size_t MiB = 1u << 20;
constexpr size_t WS_LG = 1 * MiB;
constexpr size_t WS_CQ = 2 * MiB + 256 * 1024;
constexpr size_t WS_GG = 2 * MiB + 896 * 1024;
constexpr size_t WS_BT = 3 * MiB + 256 * 1024;
constexpr size_t WS_SS1 = 3 * MiB + 512 * 1024;
constexpr size_t WS_SS2 = 3 * MiB + 768 * 1024;
constexpr size_t WS_LF = 4 * MiB;
constexpr size_t WS_WIN = 5 * MiB;
constexpr size_t WS_WG = 12 * MiB;
constexpr size_t WS_WB = 16 * MiB;
constexpr size_t WS_WOUT = 18 * MiB;
constexpr size_t WS_WGU = 20 * MiB;
constexpr size_t WS_WDN = 31 * MiB;
constexpr size_t WS_HN = 37 * MiB;
constexpr size_t WS_OD = 70 * MiB;
constexpr size_t WS_FK = 103 * MiB;
constexpr size_t WS_FV = 119 * MiB + 512 * 1024;
constexpr size_t WS_DQKV = 136 * MiB;
constexpr size_t WS_DZ = 185 * MiB + 512 * 1024;
constexpr size_t WS_CD = 1 * MiB;
constexpr size_t WS_U = 202 * MiB;
constexpr size_t WS_Y = 202 * MiB;
constexpr size_t WS_HID = 70 * MiB;
constexpr size_t WS_END = 256 * MiB;

__device__ __forceinline__ unsigned f2bf(float f) { unsigned u = __builtin_bit_cast(unsigned, f); return (u + 0x7fffu + ((u >> 16) & 1u)) >> 16; }
__device__ __forceinline__ float bf2f(bf16 b) { return __builtin_bit_cast(float, (unsigned)b << 16); }
__device__ __forceinline__ float sigmoidf_(float x) { return 1.f / (1.f + expf(-x)); }
__device__ __forceinline__ float siluf_(float x) { return x / (1.f + expf(-x)); }
__device__ __forceinline__ int lane_id() { return (int)__builtin_amdgcn_mbcnt_hi(~0u, __builtin_amdgcn_mbcnt_lo(~0u, 0u)); }
__device__ __forceinline__ int nat_row(int m) { return (m >> 12) * LP + 128 + (m & 4095); }

namespace pg8 {
#define PG8_LAS __attribute__((address_space(3)))
typedef unsigned short bf16_t;
typedef short bf16x8 __attribute__((ext_vector_type(8)));
typedef float f32x4 __attribute__((ext_vector_type(4)));
typedef unsigned u32x4 __attribute__((ext_vector_type(4)));
constexpr int BM = 256, BK = 64, HALF = 128, HTB = HALF * BK * 2  , STAGE_BYTES = 8 * HTB, NXCD = 8, WGM = 8;
__host__ __device__ __forceinline__ int lds_byte(int r, int c) { const int st = (r >> 4) * 2 + (c >> 5), rr = r & 15, cc = c & 31, ob = rr * 64 + cc * 2; return st * 1024 + (ob ^ (((ob >> 9) & 1) << 5)); }
__host__ __device__ __forceinline__ void stage_rc(int b, int& R, int& C) { const int st = b / 1024, sb = b % 1024, swz = sb ^ (((sb >> 9) & 1) << 5); R = (st >> 1) * 16 + swz / 64; C = (st & 1) * 32 + (swz % 64) / 2; }
__host__ __device__ __forceinline__ int perm32(int rho) { const int n = rho >> 4, i = rho & 15; return 8 * (i >> 2) + 4 * n + (i & 3); }
struct Unit { const char* A; const char* B; int nt; int pm, pn, sub; };
struct Gemm { int lda, ldb; };
__device__ __forceinline__ bool static_tile(int nM, int nN, int G, int c, int i, int& pm, int& pn) {
    const int nwg = nM * nN; const long L = (long)i * G + c; if (L >= nwg) return false;
    int wgid = (int)L; { const int q = nwg / NXCD, r = nwg % NXCD, xcd = wgid % NXCD, off = wgid / NXCD; wgid = (xcd < r ? xcd * (q + 1) : r * (q + 1) + (xcd - r) * q) + off; }
    const int nig = WGM * nN, gid = wgid / nig, fm = gid * WGM, gsz = (nM - fm) < WGM ? (nM - fm) : WGM;
    pm = fm + ((wgid % nig) % gsz); pn = (wgid % nig) / gsz; return true;
}
__device__ __forceinline__ unsigned cvt_pk_bf16(float lo, float hi) { unsigned r; asm volatile("v_cvt_pk_bf16_f32 %0, %1, %2" : "=v"(r) : "v"(lo), "v"(hi)); return r; }
template <class Epi, class Sched, bool ALIGN_EPI = false, bool SP2 = false>
__device__ __forceinline__ void gemm_phase(PG8_LAS unsigned char* lds, const Gemm g, const Sched& S, const Epi& E, const int wave_s) {
    int lane = lane_id(); asm volatile("" : "+v"(lane)); const int wid = wave_s, tid = wid * 64 + lane, wr = wid >> 2, wc = wid & 3, fr = lane & 15, fq = lane >> 4;
    const int lda = g.lda, ldb = g.ldb;
    unsigned voffA[2], voffB[2];
#pragma unroll
    for (int i = 0; i < 2; ++i) { int R, C; stage_rc(tid * 16 + i * 8192, R, C); const int Rb = Epi::PERM ? ((R & ~31) + perm32(R & 31)) : R;
        voffA[i] = (unsigned)(R * lda + C) * 2u; voffB[i] = (unsigned)(Rb * ldb + C) * 2u; }
    const size_t kstep = (size_t)(BK * 2);
    const size_t hstepA = (size_t)HALF * lda * 2, hstepB = (size_t)HALF * ldb * 2;
    const unsigned ldsw = (unsigned)wid * 1024u;
    const int aoff = lds_byte(wr * 64 + fr, fq * 8), boff = lds_byte(wc * 32 + fr, fq * 8);
#define PG8_SA(b, h) (((b) * 2 + (h)) * HTB)
#define PG8_SB(b, h) ((4 + (b) * 2 + (h)) * HTB)
#define PG8_STAGE(bufoff, gbase, voff) do { _Pragma("unroll") for (int _i = 0; _i < 2; ++_i) \
        __builtin_amdgcn_global_load_lds((const unsigned*)((const char*)(gbase) + (voff)[_i]), (PG8_LAS unsigned*)(lds + (bufoff) + ldsw + _i * 8192), 16, 0, 0); } while (0)
#define PG8_LDA(dst, b, h) do { _Pragma("unroll") for (int m = 0; m < 4; ++m) _Pragma("unroll") for (int k = 0; k < 2; ++k) dst[m][k] = *(const PG8_LAS bf16x8*)(lds + PG8_SA(b, h) + aoff + m * 2048 + k * 1024); } while (0)
#define PG8_LDB(dst, b, h) do { _Pragma("unroll") for (int n = 0; n < 2; ++n) _Pragma("unroll") for (int k = 0; k < 2; ++k) dst[n][k] = *(const PG8_LAS bf16x8*)(lds + PG8_SB(b, h) + boff + n * 2048 + k * 1024); } while (0)
#define PG8_MMA(ai, bj, At, Bt) do { __builtin_amdgcn_s_setprio(1); _Pragma("unroll") for (int m = 0; m < 4; ++m) _Pragma("unroll") for (int n = 0; n < 2; ++n) _Pragma("unroll") for (int k = 0; k < 2; ++k) \
        acc[ai][bj][m][n] = __builtin_amdgcn_mfma_f32_16x16x32_bf16(Bt[n][k], At[m][k], acc[ai][bj][m][n], 0, 0, 0); __builtin_amdgcn_s_setprio(0); } while (0)
#define PG8_WAIT_V(n) asm volatile("s_waitcnt vmcnt(" #n ")" ::: "memory")
#define PG8_WAIT_L(n) asm volatile("s_waitcnt lgkmcnt(" #n ")" ::: "memory")
#define PG8_BAR __builtin_amdgcn_s_barrier()
#define PG8_SCHED __builtin_amdgcn_sched_barrier(0)
    Unit cur, nxt; int ui = 0;
    if (!S.next(0, cur)) return;
    f32x4 acc[2][2][4][2];
#pragma unroll
    for (int a = 0; a < 2; ++a)
#pragma unroll
        for (int b = 0; b < 2; ++b)
#pragma unroll
            for (int m = 0; m < 4; ++m)
#pragma unroll
                for (int n = 0; n < 2; ++n) acc[a][b][m][n] = (f32x4){0.f, 0.f, 0.f, 0.f};
    bf16x8 At[4][2], B0[2][2], B1[2][2];
    const char* cA = cur.A; const char* cB = cur.B;
    S.a_ready(cur);
    if constexpr (SP2) {
        PG8_STAGE(PG8_SB(0, 0), cB, voffB); PG8_STAGE(PG8_SB(0, 1), cB + hstepB, voffB); PG8_STAGE(PG8_SA(0, 0), cA, voffA); PG8_STAGE(PG8_SA(0, 1), cA + hstepA, voffA);
        if (wr == 1) PG8_BAR;
        PG8_WAIT_V(2); PG8_BAR;
        PG8_STAGE(PG8_SB(1, 0), cB + kstep, voffB); PG8_STAGE(PG8_SA(1, 0), cA + kstep, voffA); PG8_STAGE(PG8_SB(1, 1), cB + hstepB + kstep, voffB);
        PG8_WAIT_V(6); PG8_BAR;
    } else {
        PG8_STAGE(PG8_SB(0, 0), cB, voffB); PG8_STAGE(PG8_SA(0, 0), cA, voffA); PG8_STAGE(PG8_SB(0, 1), cB + hstepB, voffB); PG8_STAGE(PG8_SA(0, 1), cA + hstepA, voffA);
        if (wr == 1) PG8_BAR;
        PG8_WAIT_V(4); PG8_BAR;
        PG8_STAGE(PG8_SB(1, 0), cB + kstep, voffB); PG8_STAGE(PG8_SA(1, 0), cA + kstep, voffA); PG8_STAGE(PG8_SB(1, 1), cB + hstepB + kstep, voffB);
        PG8_WAIT_V(6); PG8_BAR;
    }
    for (;;) {
        const bool has_next = S.next(ui + 1, nxt);
        const char* nA = has_next ? nxt.A : cA; const char* nB = has_next ? nxt.B : cB;
        const int nt = cur.nt;
        for (int t = 0; t < nt; t += 2) {
            const bool last = (t == nt - 2);
            const char* a1 = cA + (size_t)(t + 1) * kstep;
            const char* a2 = last ? nA : cA + (size_t)(t + 2) * kstep; const char* b2 = last ? nB : cB + (size_t)(t + 2) * kstep;
            const char* a3 = a2 + kstep; const char* b3 = b2 + kstep;
            if (last && has_next) S.a_ready(nxt);
            if constexpr (SP2) {
            PG8_LDB(B0, 0, 0); PG8_LDB(B1, 0, 1); PG8_SCHED; PG8_LDA(At, 0, 0); PG8_STAGE(PG8_SA(1, 1), a1 + hstepA, voffA);
            PG8_WAIT_V(8); PG8_WAIT_L(0); PG8_BAR; PG8_MMA(0, 0, At, B0); PG8_MMA(0, 1, At, B1); PG8_BAR; PG8_SCHED;
            PG8_LDA(At, 0, 1); PG8_STAGE(PG8_SB(0, 0), b2, voffB); PG8_STAGE(PG8_SB(0, 1), b2 + hstepB, voffB); PG8_STAGE(PG8_SA(0, 0), a2, voffA);
            PG8_WAIT_V(8); PG8_WAIT_L(0); PG8_BAR; PG8_MMA(1, 0, At, B0); PG8_MMA(1, 1, At, B1); PG8_BAR; PG8_SCHED;
            PG8_LDB(B0, 1, 0); PG8_LDB(B1, 1, 1); PG8_SCHED; PG8_LDA(At, 1, 0); PG8_STAGE(PG8_SA(0, 1), a2 + hstepA, voffA);
            PG8_WAIT_V(8); PG8_WAIT_L(0); PG8_BAR; PG8_MMA(0, 0, At, B0); PG8_MMA(0, 1, At, B1); PG8_BAR; PG8_SCHED;
            PG8_LDA(At, 1, 1); PG8_STAGE(PG8_SB(1, 0), b3, voffB); PG8_STAGE(PG8_SB(1, 1), b3 + hstepB, voffB); PG8_STAGE(PG8_SA(1, 0), a3, voffA);
            PG8_WAIT_V(8); PG8_WAIT_L(0); PG8_BAR; PG8_MMA(1, 0, At, B0); PG8_MMA(1, 1, At, B1); PG8_BAR; PG8_SCHED;
            } else {
            PG8_LDB(B0, 0, 0); PG8_SCHED; PG8_LDA(At, 0, 0); PG8_STAGE(PG8_SA(1, 1), a1 + hstepA, voffA);
            PG8_WAIT_L(8); PG8_BAR; PG8_WAIT_L(0); PG8_MMA(0, 0, At, B0); PG8_BAR; PG8_SCHED;
            PG8_LDB(B1, 0, 1); PG8_STAGE(PG8_SB(0, 0), b2, voffB);
            PG8_BAR; PG8_WAIT_L(0); PG8_MMA(0, 1, At, B1); PG8_BAR;
            PG8_LDA(At, 0, 1); PG8_STAGE(PG8_SA(0, 0), a2, voffA);
            PG8_BAR; PG8_WAIT_L(0); PG8_MMA(1, 0, At, B0); PG8_BAR; PG8_SCHED;
            PG8_STAGE(PG8_SB(0, 1), b2 + hstepB, voffB);
            PG8_WAIT_V(6); PG8_BAR; PG8_MMA(1, 1, At, B1); PG8_BAR;
            PG8_LDB(B0, 1, 0); PG8_SCHED; PG8_LDA(At, 1, 0); PG8_STAGE(PG8_SA(0, 1), a2 + hstepA, voffA);
            PG8_WAIT_L(8); PG8_BAR; PG8_WAIT_L(0); PG8_MMA(0, 0, At, B0); PG8_BAR; PG8_SCHED;
            PG8_LDB(B1, 1, 1); PG8_STAGE(PG8_SB(1, 0), b3, voffB);
            PG8_BAR; PG8_WAIT_L(0); PG8_MMA(0, 1, At, B1); PG8_BAR;
            PG8_LDA(At, 1, 1); PG8_STAGE(PG8_SA(1, 0), a3, voffA);
            PG8_BAR; PG8_WAIT_L(0); PG8_MMA(1, 0, At, B0); PG8_BAR; PG8_SCHED;
            PG8_STAGE(PG8_SB(1, 1), b3 + hstepB, voffB);
            PG8_WAIT_V(6); PG8_BAR; PG8_MMA(1, 1, At, B1); PG8_BAR;
            }
        }
        if constexpr (ALIGN_EPI) { if (wr == 0) PG8_BAR; }
        if constexpr (!Epi::AFTER_DRAIN) { E(acc, cur, wr, wc, fr, fq); S.done(cur); }
        if (!has_next) break;
#pragma unroll
        for (int a = 0; a < 2; ++a)
#pragma unroll
            for (int b = 0; b < 2; ++b)
#pragma unroll
                for (int m = 0; m < 4; ++m)
#pragma unroll
                    for (int n = 0; n < 2; ++n) acc[a][b][m][n] = (f32x4){0.f, 0.f, 0.f, 0.f};
        cur = nxt; cA = nA; cB = nB; ++ui;
        if constexpr (ALIGN_EPI) { if (wr == 1) PG8_BAR; }
    }
    PG8_WAIT_V(0);
    if constexpr (!ALIGN_EPI) { if (wr == 0) PG8_BAR; }
    PG8_BAR;
    if constexpr (Epi::AFTER_DRAIN) { E.fused(acc, cur, wr, wc, fr, fq, lds, wid, lane); S.done(cur); }
#undef PG8_SA
#undef PG8_SB
#undef PG8_STAGE
#undef PG8_LDA
#undef PG8_LDB
#undef PG8_MMA
#undef PG8_WAIT_V
#undef PG8_WAIT_L
#undef PG8_BAR
#undef PG8_SCHED
}
}

namespace attn_body {
using bf16=__hip_bfloat16;
using bf16x8=__attribute__((ext_vector_type(8)))short;
using s16x4=__attribute__((ext_vector_type(4)))short;
using f32x16=__attribute__((ext_vector_type(16)))float;
using u32x4=__attribute__((ext_vector_type(4)))unsigned;
constexpr int BATCH=4,NHEAD=8,SEQ=4224,D=64,QP=1024,KP=512;
constexpr int NW=8,QBLK=32,QB=QBLK*NW,KVBLK=64,NQB=16;
constexpr int ATTN_UNIT_ROWS=QB;
__device__ __forceinline__ int crow(int r,int hi){return (r&3)+8*(r>>2)+4*hi;}
#define SBAR() __builtin_amdgcn_sched_barrier(0)
__device__ __forceinline__ void cmask(f32x16&p0,f32x16&p1,int jb,int qrel,int hi){
  const float NEG=-INFINITY; int kb=64*jb+4*hi;
  #pragma unroll
  for(int r=0;r<16;++r){int kv=kb+(r&3)+8*(r>>2); if(kv>qrel)p0[r]=NEG; if(kv+32>qrel)p1[r]=NEG;}
}

constexpr int NSLOT=3, SLOTB=8192;
constexpr int LDS_K=0, LDS_V=NSLOT*SLOTB, LDS_WS=2*NSLOT*SLOTB, LDS_OST=LDS_WS+NW*64*4, LDS_CT=LDS_OST+NW*4096+2048, LDS_BYTES=LDS_CT+SEQ*4;
constexpr float C2=0.125f*1.4426950408889634f;
__device__ __forceinline__ void glds16(const void*gsrc,unsigned lds_dst){unsigned keep;
  asm volatile("s_mov_b32 %0, m0\n\ts_mov_b32 m0, %2\n\ts_nop 0\n\tglobal_load_lds_dwordx4 %1, off\n\ts_mov_b32 m0, %0":"=&s"(keep):"v"(gsrc),"s"(lds_dst):"memory");}
__device__ __forceinline__ float max3f(float a,float b,float c){float r;asm("v_max3_f32 %0, %1, %2, %3":"=v"(r):"v"(a),"v"(b),"v"(c));return r;}
__device__ __forceinline__ float max2f(float a,float b){float r;asm("v_max_f32_e32 %0, %1, %2":"=v"(r):"v"(a),"v"(b));return r;}
__device__ __forceinline__ float fadd_s(float a,float b){float r;asm("v_add_f32_e32 %0, %1, %2":"=v"(r):"v"(a),"v"(b));return r;}
__device__ __forceinline__ float fsub_s(float a,float b){float r;asm("v_sub_f32_e32 %0, %1, %2":"=v"(r):"v"(a),"v"(b));return r;}
typedef float f32x2_t __attribute__((ext_vector_type(2))); typedef float f32x4_t __attribute__((ext_vector_type(4))); typedef __bf16 bf16x2_t __attribute__((ext_vector_type(2)));
__device__ __forceinline__ unsigned cvtpk_s(float lo,float hi){f32x2_t v={lo,hi};bf16x2_t b=__builtin_convertvector(v,bf16x2_t);return __builtin_bit_cast(unsigned,b);}
#define WAIT_BAR(N) asm volatile("s_waitcnt vmcnt(" #N ") lgkmcnt(0)\n\ts_barrier":::"memory")

__device__ __forceinline__ void qkt(f32x16&p0,f32x16&p1,const char*Kslot,const bf16x8*qr,const f32x16&negm,int r32,int hi){
  const char*kb=Kslot+hi*1024+r32*16;
  #pragma unroll
  for(int d0=0;d0<4;++d0){
    const bf16x8 b0=*reinterpret_cast<const bf16x8*>(kb+d0*2048);
    const bf16x8 b1=*reinterpret_cast<const bf16x8*>(kb+d0*2048+512);
    if(d0==0){p0=__builtin_amdgcn_mfma_f32_32x32x16_bf16(b0,qr[0],negm,0,0,0);p1=__builtin_amdgcn_mfma_f32_32x32x16_bf16(b1,qr[0],negm,0,0,0);}
    else{p0=__builtin_amdgcn_mfma_f32_32x32x16_bf16(b0,qr[d0],p0,0,0,0);p1=__builtin_amdgcn_mfma_f32_32x32x16_bf16(b1,qr[d0],p1,0,0,0);}}
}
typedef __attribute__((address_space(3))) const char* lds_cptr;
typedef short v4i16_t __attribute__((ext_vector_type(4)));
__device__ __forceinline__ void kload8(bf16x8*kf,lds_cptr kp){
  kf[0]=*(const __attribute__((address_space(3))) bf16x8*)(kp);      kf[1]=*(const __attribute__((address_space(3))) bf16x8*)(kp+512);
  kf[2]=*(const __attribute__((address_space(3))) bf16x8*)(kp+2048); kf[3]=*(const __attribute__((address_space(3))) bf16x8*)(kp+2560);
  kf[4]=*(const __attribute__((address_space(3))) bf16x8*)(kp+4096); kf[5]=*(const __attribute__((address_space(3))) bf16x8*)(kp+4608);
  kf[6]=*(const __attribute__((address_space(3))) bf16x8*)(kp+6144); kf[7]=*(const __attribute__((address_space(3))) bf16x8*)(kp+6656);
}
__device__ __forceinline__ void kload2(bf16x8*kf,lds_cptr kp,int j){ kf[2*j]=*(const __attribute__((address_space(3))) bf16x8*)(kp+j*2048); kf[2*j+1]=*(const __attribute__((address_space(3))) bf16x8*)(kp+j*2048+512); }
__device__ __forceinline__ s16x4 vtr(lds_cptr p){ return __builtin_bit_cast(s16x4,__builtin_amdgcn_ds_read_tr16_b64_v4i16((__attribute__((address_space(3))) v4i16_t*)p)); }
__device__ __forceinline__ float rowmax(const f32x16&p0,const f32x16&p1){
  float a=max3f(p0[0],p0[1],p1[0]),b=max3f(p0[2],p0[3],p1[1]);a=max3f(a,p1[2],p1[3]);
  #pragma unroll
  for(int r=4;r<16;r+=4){a=max3f(a,p0[r],p0[r+1]);b=max3f(b,p0[r+2],p0[r+3]);a=max3f(a,p1[r],p1[r+1]);b=max3f(b,p1[r+2],p1[r+3]);}
  const float m=max2f(a,b);
  auto rr=__builtin_amdgcn_permlane32_swap(__float_as_uint(m),__float_as_uint(m),false,false);
  return max2f(__uint_as_float(rr[0]),__uint_as_float(rr[1]));
}
__device__ __forceinline__ void pv(f32x16*o,int vb,bf16x8 pa0,bf16x8 pa1,bf16x8 pa2,bf16x8 pa3){
  #pragma unroll
  for(int d0=0;d0<2;++d0){s16x4 lo[4],hi[4];
    #pragma unroll
    for(int ks=0;ks<4;++ks){
      asm volatile("ds_read_b64_tr_b16 %0,%1 offset:%c2":"=&v"(lo[ks]):"v"(vb),"i"(d0*4096+ks*1024):"memory");
      asm volatile("ds_read_b64_tr_b16 %0,%1 offset:%c2":"=&v"(hi[ks]):"v"(vb),"i"(d0*4096+ks*1024+512):"memory");}
    asm volatile("s_waitcnt lgkmcnt(0)":::"memory");SBAR();
    #define PK(k) (bf16x8){lo[k][0],lo[k][1],lo[k][2],lo[k][3],hi[k][0],hi[k][1],hi[k][2],hi[k][3]}
    o[d0]=__builtin_amdgcn_mfma_f32_32x32x16_bf16(pa0,PK(0),o[d0],0,0,0);
    o[d0]=__builtin_amdgcn_mfma_f32_32x32x16_bf16(pa1,PK(1),o[d0],0,0,0);
    o[d0]=__builtin_amdgcn_mfma_f32_32x32x16_bf16(pa2,PK(2),o[d0],0,0,0);
    o[d0]=__builtin_amdgcn_mfma_f32_32x32x16_bf16(pa3,PK(3),o[d0],0,0,0);
    #undef PK
  }
}

#ifndef ATTN_STORE16
#define ATTN_STORE16(p,v) (*(u32x4*)(p)=(v))
#endif
template<int THRL> __device__ __forceinline__ void attn_unit(int b,int h,int qb,const bf16*Q,const bf16*__restrict__ K,const bf16*__restrict__ V,bf16*O,const float*__restrict__ CQ,char*shm,const int wave_s){
  int lane=lane_id(); asm volatile("":"+v"(lane));
  const int wid=wave_s,tid=wid*64+lane,r32=lane&31,hi=lane>>5;
  const long rowbase=(long)b*SEQ; const int q0=128+qb*QB;
  const bf16*Qw=Q+(rowbase+q0+wid*QBLK)*QP+h*D;
  const bf16*Kh=K+rowbase*KP+h*D,*Vh=V+rowbase*KP+h*D;
  const unsigned lds0=(unsigned)(uintptr_t)shm;
  float*wsf=(float*)(shm+LDS_WS)+wid*64;
  const bf16*ksrc=Kh+(long)lane*KP+wid*8;
  const bf16*vsrc=Vh+(long)(16*(wid&3)+(lane>>2))*KP+(wid>>2)*32+(lane&3)*8;
  const unsigned kdst=lds0+LDS_K+wid*1024, vdst=lds0+LDS_V+wid*1024;
  #define PT(t) (((t)<2)?((t)^1):(t))
  #define DMA_K(t,slot) glds16(ksrc+(long)PT(t)*KVBLK*KP,(unsigned)__builtin_amdgcn_readfirstlane(kdst+(slot)))
  #define DMA_V(t,slot) glds16(vsrc+(long)PT(t)*KVBLK*KP,(unsigned)__builtin_amdgcn_readfirstlane(vdst+(slot)))
  const int vb0=(int)(lds0+LDS_V)+((lane>>4)&1)*32+(lane&3)*8+(4*hi+((lane&15)>>2))*64;
  const char*Kbase=shm+LDS_K; bf16x8 kf[8];
  const lds_cptr shm3=(lds_cptr)shm; const lds_cptr kp0=shm3+LDS_K+hi*1024+r32*16; const lds_cptr vp0=shm3+LDS_V+((lane>>4)&1)*32+(lane&3)*8+(4*hi+((lane&15)>>2))*64;
  const int NT=(q0+QB)/KVBLK;
  DMA_K(0,0);DMA_V(0,0);DMA_K(1,SLOTB);
  bf16x8 qr[4];
  #pragma unroll
  for(int d0=0;d0<4;++d0)qr[d0]=*reinterpret_cast<const bf16x8*>(&Qw[(long)r32*QP+d0*16+hi*8]);
  { const float*cg=CQ+(long)(b*NHEAD+h)*SEQ; __attribute__((address_space(3))) float*ct=(__attribute__((address_space(3))) float*)((lds_cptr)shm+LDS_CT); const int ncp=q0+QB;
    for(int i=tid;i<ncp;i+=NW*64)ct[i]=cg[i]; }
  const lds_cptr ctp=(lds_cptr)shm+LDS_CT+hi*16;
  float mhat=0.f,l_reg=0.f;f32x16 o[2];o[0]=f32x16{};o[1]=f32x16{};
  const float cqp=CQ[(long)(b*NHEAD+h)*SEQ+q0+wid*QBLK+r32];
  const f32x16 negm=f32x16{};
  float base=cqp;
  const int qrel=wid*QBLK+r32;
  #define CMASK(P0,P1,t) do{int jb_=(t)-(NT-4); if(jb_>=0)cmask(P0,P1,jb_,qrel,hi);}while(0)
  bool resc=false;
  #define START(P0,P1) do{ const float rm=rowmax(P0,P1); resc=false; \
    { const float dl=rm; mhat=fadd_s(mhat,dl); \
      _Pragma("unroll") for(int r=0;r<16;++r){P0[r]=fsub_s(P0[r],dl);P1[r]=fsub_s(P1[r],dl);} \
      base=cqp-mhat; } \
    _Pragma("unroll") for(int r=0;r<16;++r)P0[r]=__builtin_amdgcn_exp2f(P0[r]); }while(0)
  #define RESC() do{ if(resc){ asm volatile("s_waitcnt lgkmcnt(0)":::"memory"); \
      _Pragma("unroll") for(int d_=0;d_<2;++d_) _Pragma("unroll") for(int r=0;r<16;++r)o[d_][r]*=wsf[crow(r,hi)]; } }while(0)
  #define CKSUB(C0,C1,t) do{ const lds_cptr cp_=ctp+256*PT(t); \
    const f32x2_t b2_={base,base}; \
    _Pragma("unroll") for(int g_=0;g_<4;++g_){ const f32x4_t a_=*(const __attribute__((address_space(3))) f32x4_t*)(cp_+32*g_); \
      f32x2_t x_={C0[4*g_],C0[4*g_+1]},y_={C0[4*g_+2],C0[4*g_+3]}; x_=(x_-(f32x2_t){a_[0],a_[1]})+b2_; y_=(y_-(f32x2_t){a_[2],a_[3]})+b2_; \
      C0[4*g_]=x_[0];C0[4*g_+1]=x_[1];C0[4*g_+2]=y_[0];C0[4*g_+3]=y_[1]; } SBAR(); \
    _Pragma("unroll") for(int g_=0;g_<4;++g_){ const f32x4_t a_=*(const __attribute__((address_space(3))) f32x4_t*)(cp_+128+32*g_); \
      f32x2_t x_={C1[4*g_],C1[4*g_+1]},y_={C1[4*g_+2],C1[4*g_+3]}; x_=(x_-(f32x2_t){a_[0],a_[1]})+b2_; y_=(y_-(f32x2_t){a_[2],a_[3]})+b2_; \
      C1[4*g_]=x_[0];C1[4*g_+1]=x_[1];C1[4*g_+2]=y_[0];C1[4*g_+3]=y_[1]; } SBAR(); }while(0)
  f32x16 pA0,pA1,pB0,pB1;
  int sl_prev=0,sl_cur=0,sl_next=SLOTB;
  #define ROT() do{sl_prev=sl_cur;sl_cur=sl_next;sl_next=(sl_next==(NSLOT-1)*SLOTB)?0:sl_next+SLOTB;}while(0)
  DMA_K(2,2*SLOTB);
  WAIT_BAR(3);
  qkt(pA0,pA1,Kbase,qr,negm,r32,hi);asm volatile("s_nop 15\n\ts_nop 7":"+v"(pA0),"+v"(pA1));CKSUB(pA0,pA1,0);CMASK(pA0,pA1,0);
  START(pA0,pA1);
  _Pragma("unroll") for(int r=0;r<16;++r)pA1[r]=__builtin_amdgcn_exp2f(pA1[r]);
  WAIT_BAR(0);
  DMA_K(3,0);DMA_V(1,SLOTB);
  ROT();
  kload8(kf,kp0+sl_cur);
  WAIT_BAR(2);
  s16x4 vlo[8],vhi[8]; u32x4 pw0,pw1,pw2,pw3;
  #define PKW(P,B) cvtpk_s(P[B],P[B+1])
  #define PAF(k) __builtin_bit_cast(bf16x8,pw##k)
  #define VFR(i) (bf16x8){vlo[i][0],vlo[i][1],vlo[i][2],vlo[i][3],vhi[i][0],vhi[i][1],vhi[i][2],vhi[i][3]}
  #define PIN(x) asm volatile("":"+v"(x))
  #define MX3(a,b,c) __builtin_fmaxf(__builtin_fmaxf((a),(b)),(c))
  #define GAPA(MF,A0,A1,A2,A3,W0,W1,PW) do{ MF; sacc+=A0; sacc+=A1; sacc+=A2; sacc+=A3; PIN(sacc); W0; W1; PIN(PW); SBAR(); }while(0)
  #define EX(v) __builtin_amdgcn_exp2f(v)
  #define GAPB(MF,X,B) do{ MF; X[B]=EX(X[B]); X[B+1]=EX(X[B+1]); X[B+2]=EX(X[B+2]); X[B+3]=EX(X[B+3]); PIN(X); SBAR(); }while(0)
  #define VRD(i) do{ vlo[i]=vtr(vp_+(((i)>>2)*4096+((i)&3)*1024)); vhi[i]=vtr(vp_+(((i)>>2)*4096+((i)&3)*1024+512)); }while(0)
  #define KRD(G,j) do{ if(G){ kload2(kf,kp0+sl_next,j); SBAR(); } }while(0)
  #define STEP(C0,C1,P0,P1,t,GK,GV,GL) do{ SBAR(); \
    const lds_cptr vp_=vp0+sl_prev; \
    VRD(0); SBAR(); float sacc=(P0[0]+P0[1]); \
    GAPA(C0=__builtin_amdgcn_mfma_f32_32x32x16_bf16(kf[0],qr[0],negm,0,0,0), P0[2],P0[3],P0[4],P0[5],     pw0[0]=PKW(P0,0), pw0[1]=PKW(P0,2), pw0); \
    VRD(4); SBAR(); GAPA(C1=__builtin_amdgcn_mfma_f32_32x32x16_bf16(kf[1],qr[0],negm,0,0,0), P0[6],P0[7],P0[8],P0[9],     pw0[2]=PKW(P0,4), pw0[3]=PKW(P0,6), pw0); \
    VRD(1); SBAR(); GAPA(C0=__builtin_amdgcn_mfma_f32_32x32x16_bf16(kf[2],qr[1],C0,0,0,0),   P0[10],P0[11],P0[12],P0[13], pw1[0]=PKW(P0,8), pw1[1]=PKW(P0,10), pw1); \
    VRD(5); SBAR(); GAPA(C1=__builtin_amdgcn_mfma_f32_32x32x16_bf16(kf[3],qr[1],C1,0,0,0),   P0[14],P0[15],P1[0],P1[1],   pw1[2]=PKW(P0,12),pw1[3]=PKW(P0,14), pw1); \
    VRD(2); SBAR(); GAPA(C0=__builtin_amdgcn_mfma_f32_32x32x16_bf16(kf[4],qr[2],C0,0,0,0),   P1[2],P1[3],P1[4],P1[5],     pw2[0]=PKW(P1,0), pw2[1]=PKW(P1,2), pw2); \
    VRD(6); SBAR(); GAPA(C1=__builtin_amdgcn_mfma_f32_32x32x16_bf16(kf[5],qr[2],C1,0,0,0),   P1[6],P1[7],P1[8],P1[9],     pw2[2]=PKW(P1,4), pw2[3]=PKW(P1,6), pw2); \
    VRD(3); SBAR(); GAPA(C0=__builtin_amdgcn_mfma_f32_32x32x16_bf16(kf[6],qr[3],C0,0,0,0),   P1[10],P1[11],P1[12],P1[13], pw3[0]=PKW(P1,8), pw3[1]=PKW(P1,10), pw3); \
    VRD(7); SBAR(); GAPA(C1=__builtin_amdgcn_mfma_f32_32x32x16_bf16(kf[7],qr[3],C1,0,0,0),   P1[14],P1[15],0.f,0.f,       pw3[2]=PKW(P1,12),pw3[3]=PKW(P1,14), pw3); \
    l_reg+=sacc; \
    if(GK){DMA_K((t)+3,sl_cur);} if(GV){DMA_V((t)+1,sl_next);} \
    CKSUB(C0,C1,t); CMASK(C0,C1,t); \
    { float a=MX3(C0[0],C0[1],C1[0]),b=MX3(C0[2],C0[3],C1[1]); a=MX3(a,C1[2],C1[3]); \
      _Pragma("unroll") for(int r=4;r<16;r+=4){a=MX3(a,C0[r],C0[r+1]);b=MX3(b,C0[r+2],C0[r+3]);a=MX3(a,C1[r],C1[r+1]);b=MX3(b,C1[r+2],C1[r+3]);} \
      float rm=__builtin_fmaxf(a,b); { auto rr=__builtin_amdgcn_permlane32_swap(__float_as_uint(rm),__float_as_uint(rm),false,false); rm=__builtin_fmaxf(__uint_as_float(rr[0]),__uint_as_float(rr[1])); } \
      resc=false; \
      if(__builtin_expect(__any(rm>(float)THRL),0)){ const float dl=__builtin_fmaxf(rm,0.f); mhat+=dl; \
        _Pragma("unroll") for(int r=0;r<16;++r){C0[r]-=dl;C1[r]-=dl;} \
        base=cqp-mhat; \
        const float f=__builtin_amdgcn_exp2f(-dl); l_reg*=f; if(hi==0)wsf[r32]=f; resc=true; } } \
    SBAR(); \
    GAPB(o[0]=__builtin_amdgcn_mfma_f32_32x32x16_bf16(PAF(0),VFR(0),o[0],0,0,0), C0,0); \
    GAPB(o[1]=__builtin_amdgcn_mfma_f32_32x32x16_bf16(PAF(0),VFR(4),o[1],0,0,0), C0,4); \
    KRD(GL,0); GAPB(o[0]=__builtin_amdgcn_mfma_f32_32x32x16_bf16(PAF(1),VFR(1),o[0],0,0,0), C0,8); \
    KRD(GL,1); GAPB(o[1]=__builtin_amdgcn_mfma_f32_32x32x16_bf16(PAF(1),VFR(5),o[1],0,0,0), C0,12); \
    KRD(GL,2); GAPB(o[0]=__builtin_amdgcn_mfma_f32_32x32x16_bf16(PAF(2),VFR(2),o[0],0,0,0), C1,0); \
    KRD(GL,3); GAPB(o[1]=__builtin_amdgcn_mfma_f32_32x32x16_bf16(PAF(2),VFR(6),o[1],0,0,0), C1,4); \
    GAPB(o[0]=__builtin_amdgcn_mfma_f32_32x32x16_bf16(PAF(3),VFR(3),o[0],0,0,0), C1,8); \
    GAPB(o[1]=__builtin_amdgcn_mfma_f32_32x32x16_bf16(PAF(3),VFR(7),o[1],0,0,0), C1,12); \
    }while(0)
  int t=1;
  #undef CMASK
  #define CMASK(P0,P1,t) do{}while(0)
  for(;t+5<NT;t+=2){
    STEP(pB0,pB1,pA0,pA1,t,true,true,true);     WAIT_BAR(2); RESC(); ROT();
    STEP(pA0,pA1,pB0,pB1,t+1,true,true,true);   WAIT_BAR(2); RESC(); ROT();
  }
  #undef CMASK
  #define CMASK(P0,P1,t) do{int jb_=(t)-(NT-4); if(jb_>=0)cmask(P0,P1,jb_,qrel,hi);}while(0)
  #define ENDW(tt) do{ if((tt)+3<NT){WAIT_BAR(2);} else if((tt)+2<NT){WAIT_BAR(1);} else {WAIT_BAR(0);} }while(0)
  for(;t+1<NT;t+=2){
    STEP(pB0,pB1,pA0,pA1,t,(t+3<NT),(t+1<NT),(t+1<NT));       ENDW(t);   RESC(); ROT();
    STEP(pA0,pA1,pB0,pB1,t+1,(t+4<NT),(t+2<NT),(t+2<NT));     ENDW(t+1); RESC(); ROT();
  }
  STEP(pB0,pB1,pA0,pA1,NT-1,false,false,false); RESC();
  { float sacc=pB0[0]+pB0[1]; _Pragma("unroll") for(int r=2;r<16;++r)sacc+=pB0[r]; _Pragma("unroll") for(int r=0;r<16;++r)sacc+=pB1[r]; l_reg+=sacc;
    pw0=(u32x4){PKW(pB0,0),PKW(pB0,2),PKW(pB0,4),PKW(pB0,6)};pw1=(u32x4){PKW(pB0,8),PKW(pB0,10),PKW(pB0,12),PKW(pB0,14)};pw2=(u32x4){PKW(pB1,0),PKW(pB1,2),PKW(pB1,4),PKW(pB1,6)};pw3=(u32x4){PKW(pB1,8),PKW(pB1,10),PKW(pB1,12),PKW(pB1,14)};
    SBAR(); pv(o,vb0+sl_cur,PAF(0),PAF(1),PAF(2),PAF(3)); }
  #undef PKW
  #undef PAF
  #undef VFR
  #undef PIN
  #undef MX3
  #undef GAPA
  #undef GAPB
  #undef EX
  #undef VRD
  #undef KRD
  #undef STEP
  #undef ENDW
  {auto rr=__builtin_amdgcn_permlane32_swap(__float_as_uint(l_reg),__float_as_uint(l_reg),false,false);l_reg=__uint_as_float(rr[0])+__uint_as_float(rr[1]);}
  int lane_e=lane_id(); asm volatile("":"+v"(lane_e));
  const int r32e=lane_e&31,hie=lane_e>>5; float*wsfe=(float*)(shm+LDS_WS)+wid*64;
  if(hie==0)wsfe[32+r32e]=l_reg;asm volatile("s_waitcnt lgkmcnt(0)":::"memory");
  float rli[16];
  #pragma unroll
  for(int r=0;r<16;++r)rli[r]=__builtin_amdgcn_rcpf(wsfe[32+crow(r,hie)]);
  bf16*Ow=O+(rowbase+q0+wid*QBLK)*QP+h*D;
  { bf16*stg=(bf16*)(shm+LDS_OST)+wid*2048;
    #pragma unroll
    for(int r=0;r<16;++r){const int orow=crow(r,hie);
      #pragma unroll
      for(int d0=0;d0<2;++d0)stg[orow*64+d0*32+r32e]=__float2bfloat16(o[d0][r]*rli[r]);}
    asm volatile("s_waitcnt lgkmcnt(0)":::"memory");
    #pragma unroll
    for(int i=0;i<4;++i){const int row=i*8+(lane_e>>3),ch=lane_e&7; const u32x4 v=*(const u32x4*)(stg+row*64+ch*8); ATTN_STORE16(Ow+(long)row*QP+ch*8,v);} }
  asm volatile("s_waitcnt lgkmcnt(0)\n\ts_barrier":::"memory");
  #undef DMA_K
  #undef PT
  #undef CKSUB
  #undef DMA_V
  #undef CMASK
  #undef START
  #undef RESC
  #undef ROT
}
constexpr int ATTN_LDS_BYTES=LDS_BYTES;
struct AttnTensors { const bf16* Q; const bf16* K; const bf16* V; bf16* O; const float* CQ; };
struct AttnUnit { int bh; int qb; };
struct StaticOrder {
  int vcu;
  __device__ __forceinline__ explicit StaticOrder(int grid,int block):vcu((block%8)*(grid/8)+block/8){}
  __device__ __forceinline__ bool next(int i,AttnUnit&u)const{ if(i>=2)return false; const int s=vcu&7; u.bh=vcu>>3; u.qb=(i==0)?s:15-s; return true; }
  __device__ __forceinline__ void a_ready(const AttnUnit&)const{}
  __device__ __forceinline__ void done(const AttnUnit&)const{}
};
template<class Sched,int THRL=8> __device__ __forceinline__ void attn_phase(char*lds,const AttnTensors&T,const Sched&S,const int wave_s){
  AttnUnit u;
  for(int i=0;S.next(i,u);++i){ S.a_ready(u); attn_unit<THRL>(u.bh/NHEAD,u.bh%NHEAD,u.qb,T.Q,T.K,T.V,T.O,T.CQ,lds,wave_s); S.done(u); }
}
#undef SBAR
#undef WAIT_BAR
}

namespace dn {
typedef short bf16x8 __attribute__((ext_vector_type(8)));
typedef float f32x16 __attribute__((ext_vector_type(16)));
typedef float f32x4 __attribute__((ext_vector_type(4)));
typedef float f32x2 __attribute__((ext_vector_type(2)));
typedef unsigned u32x4 __attribute__((ext_vector_type(4)));
typedef unsigned u32x2 __attribute__((ext_vector_type(2)));
#define DLAS __attribute__((address_space(3)))
constexpr int NCH = 66, NITEM = 16 * 65;
constexpr int IMG_W = 0, IMG_Q = 16384, IMG_K = 32768, IMG_A = 49152, IMG_BYTES = 57344;
constexpr float QSCALE = 0.08838834764831845f;
__device__ __forceinline__ int img_off128(int m, int k) { const int ch = 2 * (k >> 4) + ((k >> 2) & 1), pos = 4 * ((k >> 3) & 1) + (k & 3); return m * 256 + ((ch ^ (m & 15)) << 4) + pos * 2; }
__device__ __forceinline__ int img_off64(int m, int k)  { const int ch = 2 * (k >> 4) + ((k >> 2) & 1), pos = 4 * ((k >> 3) & 1) + (k & 3); return m * 128 + ((ch ^ ((m >> 1) & 7)) << 4) + pos * 2; }
__device__ __forceinline__ float bfl(unsigned w) { return __builtin_bit_cast(float, w << 16); }
__device__ __forceinline__ float bfh(unsigned w) { return __builtin_bit_cast(float, w & 0xffff0000u); }
typedef __bf16 bf16x2_t __attribute__((ext_vector_type(2)));
__device__ __forceinline__ unsigned pkbf(float lo, float hi) { const f32x2 v = {lo, hi}; return __builtin_bit_cast(unsigned, __builtin_convertvector(v, bf16x2_t)); }
__device__ __forceinline__ float wsum(float v) {
#pragma unroll
    for (int o = 1; o < 64; o <<= 1) v += __shfl_xor(v, o);
    return v;
}
struct PrepArgs { const bf16* DQKV; const float* cw; const float* GG; const float* BT; unsigned char* PREP; float* U; float* CD; };
constexpr int L_QB = 0, L_KB = 17408, L_RHS = 34816, L_AM = 100352, L_AIMG = 117760, L_SC = 125952, L_IMG = L_RHS;

#define DN_FRESH_LANE() asm volatile("" : "+v"(lane))
__device__ __forceinline__ void prep_item(DLAS unsigned char* lds, const PrepArgs& P, int bh, int n, int wave, int lane) {
    DN_FRESH_LANE();
    const int b = bh >> 2, h = bh & 3; const size_t rowbase = (size_t)b * LP + 64 * n; const int item = bh * NCH + n;
    int vz = 0; asm volatile("" : "+v"(vz));
    DLAS float* SCf = (DLAS float*)(lds + L_SC + vz);
    if (wave == 0) { const float g = P.GG[(size_t)bh * LP + 64 * n + lane], be = P.BT[(size_t)bh * LP + 64 * n + lane]; float gc = g;
#pragma unroll
        for (int o = 1; o < 64; o <<= 1) { const float t = __shfl_up(gc, o); if (lane >= o) gc += t; }
        const float gl = __shfl(gc, 63);
        SCf[lane] = gc; SCf[64 + lane] = be; SCf[128 + lane] = __expf(gc); SCf[192 + lane] = __expf(gl - gc);
        if (lane == 63) P.CD[item] = __expf(gc); }
    { const int r0 = 8 * wave;
#pragma unroll 1
      for (int which = 0; which < 3; ++which) { const int col = which * 512 + h * 128 + 2 * lane;
        float w0[4], w1[4];
#pragma unroll
        for (int i = 0; i < 4; ++i) { const f32x2 wv = *(const f32x2*)(P.cw + i * 1536 + col); w0[i] = wv.x; w1[i] = wv.y; }
        unsigned u[11];
#pragma unroll
        for (int rr = 0; rr < 11; ++rr) u[rr] = *(const unsigned*)(P.DQKV + (rowbase + r0 - 3 + rr) * 1536 + col);
#pragma unroll
        for (int r = 0; r < 8; ++r) { float a0 = 0.f, a1 = 0.f;
#pragma unroll
            for (int i = 0; i < 4; ++i) { a0 += w0[i] * bfl(u[r + i]); a1 += w1[i] * bfh(u[r + i]); }
            a0 = a0 / (1.f + __expf(-a0)); a1 = a1 / (1.f + __expf(-a1));
            const int row = r0 + r;
            if (which < 2) { const float rs = rsqrtf(wsum(a0 * a0 + a1 * a1) + EPS); a0 *= rs; a1 *= rs;
                *(DLAS unsigned*)(lds + (which == 0 ? L_QB : L_KB) + row * 272 + 4 * lane) = pkbf(a0, a1);
                if (which == 1) *(DLAS f32x2*)(lds + L_RHS + row * 1024 + 512 + 8 * lane) = (f32x2){a0, a1}; }
            else *(DLAS f32x2*)(lds + L_RHS + row * 1024 + 8 * lane) = (f32x2){a0, a1}; } } }
    __syncthreads();
    DN_FRESH_LANE();
    { const int which = wave >> 2, ti = (wave >> 1) & 1, tj = wave & 1, m = lane & 31, hh = lane >> 5;
      const DLAS unsigned char* ap = lds + (which == 0 ? L_KB : L_QB) + (32 * ti + m) * 272 + hh * 16; const DLAS unsigned char* bp = lds + L_KB + (32 * tj + m) * 272 + hh * 16;
      f32x16 acc = f32x16{};
#pragma unroll
      for (int s = 0; s < 8; ++s) acc = __builtin_amdgcn_mfma_f32_32x32x16_bf16(*(const DLAS bf16x8*)(ap + 32 * s), *(const DLAS bf16x8*)(bp + 32 * s), acc, 0, 0, 0);
      const int col = 32 * tj + m; const float gcc = SCf[col];
#pragma unroll
      for (int r = 0; r < 16; ++r) { const int row = 32 * ti + (r & 3) + 8 * (r >> 2) + 4 * hh; const float d = __expf(fminf(SCf[row] - gcc, 0.f));
          if (which == 0) { *(DLAS float*)(lds + L_AM + (row * 68 + col) * 4) = col < row ? SCf[64 + row] * acc[r] * d : 0.f; }
          else { const float v = col <= row ? acc[r] * QSCALE * d : 0.f; *(DLAS unsigned short*)(lds + L_AIMG + img_off64(row, col)) = (unsigned short)(pkbf(v, 0.f) & 0xffffu); } } }
    __syncthreads();
    DN_FRESH_LANE();
    if (wave < 4) {
        const int c = 64 * wave + lane; float x[64];
#pragma unroll
        for (int i = 0; i < 64; ++i) { const float sc = (c < 128) ? SCf[64 + i] : SCf[64 + i] * SCf[128 + i]; x[i] = *(const DLAS float*)(lds + L_RHS + (i * 256 + c) * 4) * sc; }
        __syncthreads();
#pragma unroll
        for (int i = 1; i < 64; ++i) { float s0 = 0.f, s1 = 0.f, s2 = 0.f, s3 = 0.f;
#pragma unroll
            for (int j4 = 0; j4 < (i + 3) / 4; ++j4) { const f32x4 a = *(const DLAS f32x4*)(lds + vz + L_AM + (i * 68 + 4 * j4) * 4);
                s0 += a.x * x[4 * j4]; s1 += a.y * x[4 * j4 + 1]; s2 += a.z * x[4 * j4 + 2]; s3 += a.w * x[4 * j4 + 3]; }
            x[i] -= (s0 + s1) + (s2 + s3); __builtin_amdgcn_sched_barrier(0); }
        if (c < 128) {
            float* up = P.U + (size_t)item * 8192 + (size_t)(c >> 5) * 2048 + (c & 31) * 16;
#pragma unroll
            for (int t = 0; t < 2; ++t)
#pragma unroll
                for (int hi = 0; hi < 2; ++hi)
#pragma unroll
                    for (int q = 0; q < 4; ++q) { const int rb = 32 * t + 8 * q + 4 * hi; *(f32x4*)(up + t * 1024 + hi * 512 + 4 * q) = (f32x4){x[rb], x[rb + 1], x[rb + 2], x[rb + 3]}; }
        } else { const int dk = c - 128;
#pragma unroll
            for (int i = 0; i < 64; ++i) *(DLAS unsigned short*)(lds + L_IMG + IMG_W + img_off128(i, dk)) = (unsigned short)(pkbf(-x[i], 0.f) & 0xffffu); }
    } else {
        __syncthreads();
        const int t = (wave - 4) * 64 + lane;
        { const int i = t >> 2, d0 = (t & 3) * 32; const float sc = QSCALE * SCf[128 + i];
#pragma unroll
          for (int g8 = 0; g8 < 4; ++g8) { const u32x4 qv = *(const DLAS u32x4*)(lds + L_QB + i * 272 + (d0 + 8 * g8) * 2);
              u32x2 lo, hi2; lo.x = pkbf(bfl(qv.x) * sc, bfh(qv.x) * sc); lo.y = pkbf(bfl(qv.y) * sc, bfh(qv.y) * sc); hi2.x = pkbf(bfl(qv.z) * sc, bfh(qv.z) * sc); hi2.y = pkbf(bfl(qv.w) * sc, bfh(qv.w) * sc);
              *(DLAS u32x2*)(lds + L_IMG + IMG_Q + img_off128(i, d0 + 8 * g8)) = lo; *(DLAS u32x2*)(lds + L_IMG + IMG_Q + img_off128(i, d0 + 8 * g8 + 4)) = hi2; } }
        { const int d = t >> 1, g0 = (t & 1) * 8;
#pragma unroll
          for (int g = 0; g < 8; ++g) { const int c0 = 4 * (g0 + g); float v[4];
#pragma unroll
              for (int e = 0; e < 4; ++e) v[e] = bfl((unsigned)*(const DLAS unsigned short*)(lds + L_KB + (c0 + e) * 272 + d * 2)) * SCf[192 + c0 + e];
              u32x2 w; w.x = pkbf(v[0], v[1]); w.y = pkbf(v[2], v[3]); *(DLAS u32x2*)(lds + L_IMG + IMG_K + img_off64(d, c0)) = w; } }
    }
    __syncthreads();
    DN_FRESH_LANE();
    { const int t = wave * 64 + lane; unsigned char* dst = P.PREP + (size_t)item * IMG_BYTES;
#pragma unroll
      for (int p = 0; p < 6; ++p) *(u32x4*)(dst + (p * 512 + t) * 16) = *(const DLAS u32x4*)(lds + L_IMG + (p * 512 + t) * 16);
      *(u32x4*)(dst + IMG_A + t * 16) = *(const DLAS u32x4*)(lds + L_AIMG + t * 16); }
    __syncthreads();
}
struct RecArgs { const unsigned char* PREP; const float* U; const float* CD; const bf16* DZ; const float* onw; bf16* OD; };
constexpr int R_IMG0 = 0, R_IMG1 = IMG_BYTES, R_OB = 2 * IMG_BYTES, R_BYTES = R_OB + 64 * 128 * 4;
#define DN_BAR() do { asm volatile("s_waitcnt vmcnt(0) lgkmcnt(0)" ::: "memory"); __builtin_amdgcn_s_barrier(); asm volatile("" ::: "memory"); } while (0)
__device__ __forceinline__ bf16x8 pack8(const f32x16& v, int s) { u32x4 w; w.x = pkbf(v[8 * s], v[8 * s + 1]); w.y = pkbf(v[8 * s + 2], v[8 * s + 3]); w.z = pkbf(v[8 * s + 4], v[8 * s + 5]); w.w = pkbf(v[8 * s + 6], v[8 * s + 7]); return __builtin_bit_cast(bf16x8, w); }
__device__ __forceinline__ void rec_load_images(DLAS unsigned char* dst, const unsigned char* src, int t256) {
#pragma unroll
    for (int p = 0; p < 14; p += 7) { u32x4 v[7];
#pragma unroll
        for (int q = 0; q < 7; ++q) v[q] = *(const u32x4*)(src + ((p + q) * 256 + t256) * 16);
#pragma unroll
        for (int q = 0; q < 7; ++q) *(DLAS u32x4*)(dst + ((p + q) * 256 + t256) * 16) = v[q]; }
}
__device__ __forceinline__ void rec_finalize(const DLAS unsigned char* lds, const RecArgs& A, int b, int h, int n, int t256) {
    const int row = t256 >> 2, c0 = (t256 & 3) * 32; const size_t grow = (size_t)b * LP + 64 * n + row;
    const DLAS float* op = (const DLAS float*)(lds + R_OB) + row * 128 + c0; float v[32]; float ss = 0.f;
#pragma unroll
    for (int q = 0; q < 8; ++q) { const f32x4 t = *(const DLAS f32x4*)(op + 4 * q); v[4 * q] = t.x; v[4 * q + 1] = t.y; v[4 * q + 2] = t.z; v[4 * q + 3] = t.w; ss += (t.x * t.x + t.y * t.y) + (t.z * t.z + t.w * t.w); }
    ss += __shfl_xor(ss, 1); ss += __shfl_xor(ss, 2);
    const float rs = rsqrtf(ss * (1.f / 128.f) + EPS);
    const bf16* zp = A.DZ + grow * 512 + h * 128 + c0; bf16* dst = A.OD + grow * 1024 + 512 + h * 128 + c0;
#pragma unroll
    for (int q = 0; q < 4; ++q) { const u32x4 z = *(const u32x4*)(zp + 8 * q); const f32x4 w0 = *(const f32x4*)(A.onw + c0 + 8 * q), w1 = *(const f32x4*)(A.onw + c0 + 8 * q + 4); float zz[8] = {bfl(z.x), bfh(z.x), bfl(z.y), bfh(z.y), bfl(z.z), bfh(z.z), bfl(z.w), bfh(z.w)}; float r[8];
#pragma unroll
        for (int e = 0; e < 8; ++e) { const float wv = e < 4 ? w0[e] : w1[e - 4]; r[e] = v[8 * q + e] * rs * wv * (zz[e] / (1.f + __expf(-zz[e]))); }
        u32x4 o; o.x = pkbf(r[0], r[1]); o.y = pkbf(r[2], r[3]); o.z = pkbf(r[4], r[5]); o.w = pkbf(r[6], r[7]); *(u32x4*)(dst + 8 * q) = o; }
}
__device__ __forceinline__ void rec_chain(DLAS unsigned char* lds, const RecArgs& A, int bh, int wave, int lane) {
    const int b = bh >> 2, h = bh & 3;
    if (wave >= 4) {
        const int t256 = (wave - 4) * 64 + lane;
        rec_load_images(lds + R_IMG1, A.PREP + (size_t)(bh * NCH + 1) * IMG_BYTES, t256);
        DN_BAR();
        for (int n = 1; n < NCH; ++n) {
            if (n + 1 < NCH) rec_load_images(lds + ((n + 1) & 1 ? R_IMG1 : R_IMG0), A.PREP + (size_t)(bh * NCH + n + 1) * IMG_BYTES, t256);
            if (n > 1) rec_finalize(lds, A, b, h, n - 1, t256);
            DN_BAR();
            DN_BAR();
        }
        rec_finalize(lds, A, b, h, NCH - 1, t256);
    } else {
        const int m = lane & 31, hh = lane >> 5;
        f32x16 S[4]; bf16x8 Sb[8];
#pragma unroll
        for (int d = 0; d < 4; ++d) S[d] = f32x16{};
#pragma unroll
        for (int s = 0; s < 8; ++s) Sb[s] = bf16x8{};
        DN_BAR();
        for (int n = 1; n < NCH; ++n) {
            const DLAS unsigned char* img = lds + ((n & 1) ? R_IMG1 : R_IMG0);
            const float* up = A.U + (size_t)(bh * NCH + n) * 8192 + wave * 2048 + lane * 16; const float cd = A.CD[bh * NCH + n];
            f32x16 vn[2], o[2];
#pragma unroll
            for (int t = 0; t < 2; ++t) { const f32x4 a = *(const f32x4*)(up + t * 1024), bq = *(const f32x4*)(up + t * 1024 + 4), c = *(const f32x4*)(up + t * 1024 + 8), d = *(const f32x4*)(up + t * 1024 + 12);
                vn[t] = (f32x16){a.x, a.y, a.z, a.w, bq.x, bq.y, bq.z, bq.w, c.x, c.y, c.z, c.w, d.x, d.y, d.z, d.w}; o[t] = f32x16{}; }
#pragma unroll
            for (int s = 0; s < 8; ++s)
#pragma unroll
                for (int t = 0; t < 2; ++t) { const int row = 32 * t + m; const int off = row * 256 + (((2 * s + hh) ^ (row & 15)) << 4);
                    vn[t] = __builtin_amdgcn_mfma_f32_32x32x16_bf16(*(const DLAS bf16x8*)(img + IMG_W + off), Sb[s], vn[t], 0, 0, 0);
                    o[t] = __builtin_amdgcn_mfma_f32_32x32x16_bf16(*(const DLAS bf16x8*)(img + IMG_Q + off), Sb[s], o[t], 0, 0, 0); }
            bf16x8 vb[4];
#pragma unroll
            for (int t = 0; t < 2; ++t) { vb[2 * t] = pack8(vn[t], 0); vb[2 * t + 1] = pack8(vn[t], 1); }
#pragma unroll
            for (int s = 0; s < 4; ++s)
#pragma unroll
                for (int t = 0; t < 2; ++t) { const int row = 32 * t + m; const int off = row * 128 + (((2 * s + hh) ^ ((row >> 1) & 7)) << 4);
                    o[t] = __builtin_amdgcn_mfma_f32_32x32x16_bf16(*(const DLAS bf16x8*)(img + IMG_A + off), vb[s], o[t], 0, 0, 0); }
#pragma unroll
            for (int d = 0; d < 4; ++d) { S[d] = S[d] * cd;
#pragma unroll
                for (int s = 0; s < 4; ++s) { const int row = 32 * d + m; const int off = row * 128 + (((2 * s + hh) ^ ((row >> 1) & 7)) << 4);
                    S[d] = __builtin_amdgcn_mfma_f32_32x32x16_bf16(*(const DLAS bf16x8*)(img + IMG_K + off), vb[s], S[d], 0, 0, 0); } }
#pragma unroll
            for (int d = 0; d < 4; ++d) { Sb[2 * d] = pack8(S[d], 0); Sb[2 * d + 1] = pack8(S[d], 1); }
            DN_BAR();
            { DLAS float* ob = (DLAS float*)(lds + R_OB) + 32 * wave + m;
#pragma unroll
              for (int t = 0; t < 2; ++t)
#pragma unroll
                  for (int r = 0; r < 16; ++r) ob[(32 * t + (r & 3) + 8 * (r >> 2) + 4 * hh) * 128] = o[t][r]; }
            DN_BAR();
        }
    }
}
}

struct EpiG1 { static constexpr bool PERM = true, AFTER_DRAIN = false;
    bf16 *OD, *FK, *FV, *DQKV, *DZ;
    __device__ __forceinline__ void operator()(const pg8::f32x4 (&acc)[2][2][4][2], const pg8::Unit& u, int wr, int wc, int fr, int fq) const {
        const int pn = u.pn; bf16* base; int ldc, colt; float sc = 1.f;
        if (pn < 2) { base = OD; ldc = 1024; colt = pn * 256; sc = C2; }
        else if (pn < 4) { base = FK; ldc = 512; colt = (pn - 2) * 256; }
        else if (pn < 6) { base = FV; ldc = 512; colt = (pn - 4) * 256; }
        else if (pn < 12) { base = DQKV; ldc = 1536; colt = (pn - 6) * 256; }
        else { base = DZ; ldc = 512; colt = (pn - 12) * 256; }
        const int row0 = u.pm * 256 + wr * 64 + fr, col0 = colt + wc * 32 + 8 * fq;
#pragma unroll
        for (int ai = 0; ai < 2; ++ai)
#pragma unroll
            for (int m = 0; m < 4; ++m) { bf16* rowp = base + (size_t)(row0 + ai * 128 + m * 16) * ldc + col0;
#pragma unroll
                for (int bj = 0; bj < 2; ++bj) { const pg8::f32x4 v0 = acc[ai][bj][m][0] * sc, v1 = acc[ai][bj][m][1] * sc; pg8::u32x4 w;
                    w.x = pg8::cvt_pk_bf16(v0[0], v0[1]); w.y = pg8::cvt_pk_bf16(v0[2], v0[3]); w.z = pg8::cvt_pk_bf16(v1[0], v1[1]); w.w = pg8::cvt_pk_bf16(v1[2], v1[3]);
                    *(pg8::u32x4*)(rowp + bj * 128) = w; } }
    }
};
struct SchedG1 { int c, G; const char* A; const char* B;
    __device__ __forceinline__ bool next(int i, pg8::Unit& u) const { int pm, pn; if (!pg8::static_tile(R / 256, 14, G, c, i, pm, pn)) return false;
        u.pm = pm; u.pn = pn; u.sub = 0; u.nt = 16; u.A = A + (size_t)pm * 256 * 1024 * 2; u.B = B + (size_t)pn * 256 * 1024 * 2; return true; }
    __device__ __forceinline__ void a_ready(const pg8::Unit&) const {}
    __device__ __forceinline__ void done(const pg8::Unit&) const {}
};

#define LAS __attribute__((address_space(3)))
typedef float f32x4 __attribute__((ext_vector_type(4)));
typedef unsigned v4u __attribute__((ext_vector_type(4)));
constexpr int NWAVES = 8, LDS_BYTES = 147456;
#define LDS_WAIT() asm volatile("s_waitcnt lgkmcnt(0)" ::: "memory")
__device__ __forceinline__ unsigned pk2(float lo, float hi) { return f2bf(lo) | (f2bf(hi) << 16); }
__device__ __forceinline__ float wave_sum(float v) {
#pragma unroll
    for (int o = 1; o < 64; o <<= 1) v += __shfl_xor(v, o);
    return v;
}
__device__ __forceinline__ float fsigmoid(float x) { return __builtin_amdgcn_rcpf(1.f + __builtin_amdgcn_exp2f(-LOG2E * x)); }
__device__ __forceinline__ int nat_row0(int pm) { return (pm >> 4) * LP + 128 + (pm & 15) * 256; }
struct EpiBr { static constexpr bool PERM = true, AFTER_DRAIN = false;
    bf16* S; bf16* Y;
    __device__ __forceinline__ void operator()(const pg8::f32x4 (&acc)[2][2][4][2], const pg8::Unit& u, int wr, int wc, int fr, int fq) const {
        v4u* Sg = (v4u*)S + ((wr * 4 + wc) * 64 + fq * 16 + fr); const int sub = u.sub;
        const int row0 = u.pm * 256 + wr * 64 + fr, col0 = u.pn * 256 + wc * 32 + 8 * fq;
#pragma unroll
        for (int ai = 0; ai < 2; ++ai)
#pragma unroll
            for (int m = 0; m < 4; ++m)
#pragma unroll
                for (int bj = 0; bj < 2; ++bj) { const int idx = ((ai * 4 + m) * 2 + bj) * 512; const pg8::f32x4 v0 = acc[ai][bj][m][0], v1 = acc[ai][bj][m][1];
                    if ((sub & 1) == 0) { v4u w; w.x = pg8::cvt_pk_bf16(fsigmoid(v0[0]), fsigmoid(v0[1])); w.y = pg8::cvt_pk_bf16(fsigmoid(v0[2]), fsigmoid(v0[3]));
                        w.z = pg8::cvt_pk_bf16(fsigmoid(v1[0]), fsigmoid(v1[1])); w.w = pg8::cvt_pk_bf16(fsigmoid(v1[2]), fsigmoid(v1[3])); Sg[idx] = w; }
                    else { const v4u s = Sg[idx]; bf16* yp = Y + (size_t)(row0 + ai * 128 + m * 16) * 1024 + col0 + bj * 128;
                        float t[8]; t[0] = __builtin_bit_cast(float, s.x << 16) * v0[0]; t[1] = __builtin_bit_cast(float, s.x & 0xffff0000u) * v0[1]; t[2] = __builtin_bit_cast(float, s.y << 16) * v0[2]; t[3] = __builtin_bit_cast(float, s.y & 0xffff0000u) * v0[3];
                        t[4] = __builtin_bit_cast(float, s.z << 16) * v1[0]; t[5] = __builtin_bit_cast(float, s.z & 0xffff0000u) * v1[1]; t[6] = __builtin_bit_cast(float, s.w << 16) * v1[2]; t[7] = __builtin_bit_cast(float, s.w & 0xffff0000u) * v1[3];
                        if (sub == 3) { const v4u y = *(const v4u*)yp; t[0] += __builtin_bit_cast(float, y.x << 16); t[1] += __builtin_bit_cast(float, y.x & 0xffff0000u); t[2] += __builtin_bit_cast(float, y.y << 16); t[3] += __builtin_bit_cast(float, y.y & 0xffff0000u);
                            t[4] += __builtin_bit_cast(float, y.z << 16); t[5] += __builtin_bit_cast(float, y.z & 0xffff0000u); t[6] += __builtin_bit_cast(float, y.w << 16); t[7] += __builtin_bit_cast(float, y.w & 0xffff0000u); }
                        v4u w; w.x = pg8::cvt_pk_bf16(t[0], t[1]); w.y = pg8::cvt_pk_bf16(t[2], t[3]); w.z = pg8::cvt_pk_bf16(t[4], t[5]); w.w = pg8::cvt_pk_bf16(t[6], t[7]); *(v4u*)yp = w; } }
    }
};
struct SchedBr { int c, G; const char *HN, *OD, *WG, *WB;
    __device__ __forceinline__ bool next(int i, pg8::Unit& u) const { int pm, pn; if (!pg8::static_tile(64, 4, G, c, i >> 2, pm, pn)) return false;
        const int sub = i & 3; u.pm = pm; u.pn = pn; u.sub = sub; const size_t arow = (size_t)nat_row0(pm) * 2048;
        if ((sub & 1) == 0) { u.nt = 16; u.A = HN + arow; u.B = WG + (size_t)((sub >> 1) * 1024 + pn * 256) * 2048; }
        else { u.nt = 8; u.A = OD + arow + (sub >> 1) * 1024; u.B = WB + (size_t)(pn * 256) * 2048 + (sub >> 1) * 1024; }
        return true; }
    __device__ __forceinline__ void a_ready(const pg8::Unit&) const {}
    __device__ __forceinline__ void done(const pg8::Unit&) const {}
};
struct SchedStd { int c, G, nM, nN, nt; const char* A; const char* B; size_t astep, bstep;
    __device__ __forceinline__ bool next(int i, pg8::Unit& u) const { int pm, pn; if (!pg8::static_tile(nM, nN, G, c, i, pm, pn)) return false;
        u.pm = pm; u.pn = pn; u.sub = 0; u.nt = nt; u.A = A + (size_t)pm * astep; u.B = B + (size_t)pn * bstep; return true; }
    __device__ __forceinline__ void a_ready(const pg8::Unit&) const {}
    __device__ __forceinline__ void done(const pg8::Unit&) const {}
};
struct EpiRes { static constexpr bool PERM = false, AFTER_DRAIN = true;
    const float* base; float* out; bf16* HB; float* SS;
    __device__ __forceinline__ void fused(pg8::f32x4 (&acc)[2][2][4][2], const pg8::Unit& u, int wr, int wc, int fr, int fq, PG8_LAS unsigned char* lds, int wid, int lane) const {
        LAS float* P = (LAS float*)lds; const int col0 = u.pn * 256 + wc * 32 + 4 * fq;
#pragma unroll
        for (int ai = 0; ai < 2; ++ai)
#pragma unroll
            for (int m = 0; m < 4; ++m) { const int r = ai * 128 + wr * 64 + m * 16 + fr; const size_t off = (size_t)(u.pm * 256 + r) * 1024 + col0; float s = 0.f;
#pragma unroll
                for (int bj = 0; bj < 2; ++bj)
#pragma unroll
                    for (int n = 0; n < 2; ++n) { const pg8::f32x4 h = *(const pg8::f32x4*)(base + off + bj * 128 + n * 16) + acc[ai][bj][m][n];
                        *(pg8::f32x4*)(out + off + bj * 128 + n * 16) = h; s += (h[0] * h[0] + h[1] * h[1]) + (h[2] * h[2] + h[3] * h[3]);
                        if (HB) { unsigned long long w = (unsigned long long)pg8::cvt_pk_bf16(h[0], h[1]) | ((unsigned long long)pg8::cvt_pk_bf16(h[2], h[3]) << 32); *(unsigned long long*)(HB + off + bj * 128 + n * 16) = w; } }
                s += __shfl_xor(s, 16); s += __shfl_xor(s, 32);
                if (fq == 0) P[r * 4 + wc] = s; }
        asm volatile("s_waitcnt lgkmcnt(0)" ::: "memory"); __builtin_amdgcn_s_barrier(); asm volatile("" ::: "memory");
        const int t = wid * 64 + lane; if (t < 256) SS[(size_t)u.pn * RT + u.pm * 256 + t] = (P[t * 4] + P[t * 4 + 1]) + (P[t * 4 + 2] + P[t * 4 + 3]);
    }
};
struct EpiGU { static constexpr bool PERM = true, AFTER_DRAIN = false;
    const float* SS; bf16* HID;
    __device__ __forceinline__ void operator()(const pg8::f32x4 (&acc)[2][2][4][2], const pg8::Unit& u, int wr, int wc, int fr, int fq) const {
        const int row0 = u.pm * 256 + wr * 64 + fr, col0 = u.pn * 128 + wc * 32 + 8 * fq;
#pragma unroll
        for (int ai = 0; ai < 2; ++ai)
#pragma unroll
            for (int m = 0; m < 4; ++m) { const int row = row0 + ai * 128 + m * 16;
                const float rs = rsqrtf(((SS[row] + SS[RT + row]) + (SS[2 * RT + row] + SS[3 * RT + row])) * (1.f / DM) + EPS); float h[8];
#pragma unroll
                for (int n = 0; n < 2; ++n)
#pragma unroll
                    for (int e = 0; e < 4; ++e) { const float g = acc[ai][0][m][n][e] * rs, up = acc[ai][1][m][n][e] * rs; h[4 * n + e] = g * fsigmoid(g) * up; }
                v4u w; w.x = pg8::cvt_pk_bf16(h[0], h[1]); w.y = pg8::cvt_pk_bf16(h[2], h[3]); w.z = pg8::cvt_pk_bf16(h[4], h[5]); w.w = pg8::cvt_pk_bf16(h[6], h[7]);
                *(v4u*)(HID + (size_t)row * DFF + col0) = w; }
    }
};
struct Args { const float* in[17]; float* out; unsigned char* ws; int ph_lo, ph_hi; };

__device__ __forceinline__ void p0_transpose_item(const float* __restrict__ W, int srcN, int col0, int k0, bf16* __restrict__ WT, int drow0, int ldk, int koff, const float* __restrict__ scale, LAS float* scr, int lane) {
#pragma unroll 8
    for (int i = 0; i < 32; ++i) { const int kk = 2 * i + (lane >> 5); float v = W[(size_t)(k0 + kk) * srcN + col0 + (lane & 31)]; if (scale) v *= scale[k0 + kk]; scr[kk * 33 + (lane & 31)] = v; }
    LDS_WAIT(); asm volatile("" ::: "memory");
    const int c = lane & 7;
#pragma unroll
    for (int j = 0; j < 4; ++j) { const int n = (lane >> 3) + 8 * j; const LAS float* s = scr + (8 * c) * 33 + n;
        v4u o; o.x = pk2(s[0 * 33], s[1 * 33]); o.y = pk2(s[2 * 33], s[3 * 33]); o.z = pk2(s[4 * 33], s[5 * 33]); o.w = pk2(s[6 * 33], s[7 * 33]);
        *(v4u*)(WT + (size_t)(drow0 + n) * ldk + koff + k0 + 8 * c) = o; }
    LDS_WAIT(); asm volatile("" ::: "memory");
}
__device__ __forceinline__ bool p0_mat(int& r, const float* W, int srcN, int col0, int Ncols, int K, bf16* WT, int drow0, int ldk, int koff, const float* scale, int rowmode, LAS float* scr, int lane) {
    const int nblk = Ncols / 32, nitems = (K / 64) * nblk;
    if (r >= nitems) { r -= nitems; return false; }
    const int kb = r / nblk, nb = r % nblk, n0 = 32 * nb;
    const int dr = rowmode == 0 ? drow0 + n0 : ((n0 >> 7) * 256 + (n0 & 127) + (rowmode == 2 ? 128 : 0));
    p0_transpose_item(W, srcN, col0 + n0, 64 * kb, WT, dr, ldk, koff, scale, scr, lane); return true;
}

__global__ void __launch_bounds__(NWAVES * 64, 2) mega(Args args) {
    extern __shared__ __attribute__((aligned(16))) unsigned char lds_raw[];
    cg::grid_group grid = cg::this_grid();
    LAS unsigned char* lds = (LAS unsigned char*)lds_raw;
#define FRESH_TID() int lane = lane_id(); asm volatile("" : "+v"(lane)); const int wave = wave_s, tid = wave * 64 + lane; (void)tid
    const int wave_s = __builtin_amdgcn_readfirstlane((int)threadIdx.x >> 6);
    const int G = gridDim.x, bx = blockIdx.x;
    const int vcu = (G % 8 == 0) ? (bx % 8) * (G / 8) + bx / 8 : bx;
    unsigned char* ws = args.ws;
    const float* x = args.in[0]; const float* meta = args.in[1]; const float* mix_nw = args.in[2]; const float* w_in = args.in[3];
    const float* fbias = args.in[4]; const float* a_log = args.in[6]; const float* dt_bias = args.in[7];
    const float* wbf = args.in[9]; const float* wbd = args.in[10]; const float* wout = args.in[11];
    const float* ffn_nw = args.in[12]; const float* wg = args.in[13]; const float* wu = args.in[14]; const float* wd = args.in[15];
    float *CQ = (float*)(ws + WS_CQ), *GG = (float*)(ws + WS_GG), *BT = (float*)(ws + WS_BT), *LF = (float*)(ws + WS_LF);
    bf16 *WIN = (bf16*)(ws + WS_WIN), *WG = (bf16*)(ws + WS_WG), *WB = (bf16*)(ws + WS_WB), *WOUT = (bf16*)(ws + WS_WOUT), *WGU = (bf16*)(ws + WS_WGU), *WDN = (bf16*)(ws + WS_WDN);
    bf16 *HN = (bf16*)(ws + WS_HN), *OD = (bf16*)(ws + WS_OD), *FK = (bf16*)(ws + WS_FK), *FV = (bf16*)(ws + WS_FV), *DQKV = (bf16*)(ws + WS_DQKV), *DZ = (bf16*)(ws + WS_DZ), *Y = (bf16*)(ws + WS_Y), *HID = (bf16*)(ws + WS_HID), *H1B = HN;
    float *SS1 = (float*)(ws + WS_SS1), *SS2 = (float*)(ws + WS_SS2);
    const int lo = args.ph_lo, hi = args.ph_hi;
#define IN(k) (lo <= (k) && (k) < hi)
#define BOTH(k) (IN(k) && IN((k) + 1))

    if (IN(0)) {
        FRESH_TID();
        const int gw = vcu * NWAVES + wave, NGW = G * NWAVES;
        { LAS float* scr = (LAS float*)(lds + wave * 16384);
          constexpr int NITEMS = 16 * 112 + 16 * 64 + 2 * 8 * 32 + 16 * 32 + 2 * 16 * 88 + 44 * 32;
          for (int it = gw; it < NITEMS; it += NGW) { int r = it;
            if (p0_mat(r, w_in, DIN, 0, 1536, 1024, WIN, 0, 1024, 0, nullptr, 0, scr, lane)) continue;
            if (p0_mat(r, w_in, DIN, 1544, 1536, 1024, WIN, 1536, 1024, 0, nullptr, 0, scr, lane)) continue;
            if (p0_mat(r, w_in, DIN, 3088, 512, 1024, WIN, 3072, 1024, 0, nullptr, 0, scr, lane)) continue;
            if (p0_mat(r, w_in, DIN, 3600, 2048, 1024, WG, 0, 1024, 0, nullptr, 0, scr, lane)) continue;
            if (p0_mat(r, wbf, 1024, 0, 1024, 512, WB, 0, 1024, 0, nullptr, 0, scr, lane)) continue;
            if (p0_mat(r, wbd, 1024, 0, 1024, 512, WB, 0, 1024, 512, nullptr, 0, scr, lane)) continue;
            if (p0_mat(r, wout, 1024, 0, 1024, 1024, WOUT, 0, 1024, 0, nullptr, 0, scr, lane)) continue;
            if (p0_mat(r, wg, DFF, 0, DFF, 1024, WGU, 0, 1024, 0, ffn_nw, 1, scr, lane)) continue;
            if (p0_mat(r, wu, DFF, 0, DFF, 1024, WGU, 0, 1024, 0, ffn_nw, 2, scr, lane)) continue;
            p0_mat(r, wd, 1024, 0, 1024, DFF, WDN, 0, DFF, 0, nullptr, 0, scr, lane);
          } }
        __syncthreads();
        LAS float* W16 = (LAS float*)lds;
#pragma unroll 2
        for (int i = tid; i < 1024 * 4; i += NWAVES * 64) { const int k = i >> 2, q = i & 3;
            const f32x4 v = *(const f32x4*)(w_in + (size_t)k * DIN + (q < 2 ? 1536 + 4 * q : 3080 + 4 * (q - 2)));
            *(LAS f32x4*)(W16 + ((k & 3) * 256 + (k >> 2)) * 20 + 4 * q) = v; }
        __syncthreads();
        for (int r = gw; r < R; r += NGW) {
            const int b = r / LP, pos = r % LP;
            const float* src = pos < NPAD ? nullptr : (pos < 128 ? meta + (size_t)(pos - NPAD) * DM : x + ((size_t)b * SEQ + (pos - 128)) * DM);
            f32x4 v[4]; float ss = 0.f;
#pragma unroll
            for (int j = 0; j < 4; ++j) { v[j] = src ? ((const f32x4*)src)[lane + 64 * j] : (f32x4){0.f, 0.f, 0.f, 0.f}; ss += (v[j].x * v[j].x + v[j].y * v[j].y) + (v[j].z * v[j].z + v[j].w * v[j].w); }
            const float rs = rsqrtf(wave_sum(ss) * (1.f / DM) + EPS);
            unsigned long long* o8 = (unsigned long long*)(HN + (size_t)r * DM) + lane;
            float acc[16];
#pragma unroll
            for (int c = 0; c < 16; ++c) acc[c] = 0.f;
#pragma unroll
            for (int j = 0; j < 4; ++j) { asm volatile("" ::: "memory");
                const f32x4 nwv = ((const f32x4*)mix_nw)[lane + 64 * j]; const f32x4 hn = v[j] * rs * nwv;
                o8[64 * j] = (unsigned long long)pk2(hn.x, hn.y) | ((unsigned long long)pk2(hn.z, hn.w) << 32);
#pragma unroll
                for (int e = 0; e < 4; ++e) { const LAS float* wr_ = W16 + (e * 256 + lane + 64 * j) * 20; const float he = hn[e];
#pragma unroll
                    for (int q = 0; q < 4; ++q) { const f32x4 w = *(const LAS f32x4*)(wr_ + 4 * q); acc[4 * q] += he * w.x; acc[4 * q + 1] += he * w.y; acc[4 * q + 2] += he * w.z; acc[4 * q + 3] += he * w.w; } } }
            float mine = 0.f;
#pragma unroll
            for (int c = 0; c < 16; ++c) { const float t = wave_sum(acc[c]); mine = (lane == c) ? t : mine; }
            if (lane < 16) { const bool valid = pos >= NPAD; const int j = lane;
                if (j < 8) { const float z = mine + fbias[j]; LF[(size_t)(b * 8 + j) * LP + pos] = fminf(z, 0.f) - log1pf(expf(-fabsf(z))); }
                else if (j < 12) { const int h = j - 8; BT[(size_t)(b * 4 + h) * LP + pos] = valid ? sigmoidf_(mine) : 0.f; }
                else { const int h = j - 12; const float z = mine + dt_bias[h]; const float sp = fmaxf(z, 0.f) + log1pf(expf(-fabsf(z))); GG[(size_t)(b * 4 + h) * LP + pos] = valid ? -expf(a_log[h]) * sp : 0.f; } }
        }
        if (BOTH(0)) grid.sync();
    }
    if (IN(1)) {
        __syncthreads();
        { pg8::Gemm g{1024, 1024}; SchedG1 S{bx, G, (const char*)HN, (const char*)WIN}; EpiG1 E{OD, FK, FV, DQKV, DZ};
          pg8::gemm_phase<EpiG1, SchedG1, true, true>(lds, g, S, E, wave_s); }
        if (bx >= G - 32) {
            FRESH_TID();
            __syncthreads();
            const int bh = bx - (G - 32); LAS float* part = (LAS float*)lds;
            const float* lf = LF + (size_t)bh * LP; float* cq = CQ + (size_t)bh * LP;
            float v[9]; float run = 0.f;
#pragma unroll
            for (int e = 0; e < 9; ++e) { const int i = tid * 9 + e; const float t = (i < LP && i >= NPAD) ? lf[i] : 0.f; run += t; v[e] = run; }
            float incl = run;
#pragma unroll
            for (int o = 1; o < 64; o <<= 1) { const float t = __shfl_up(incl, o); if (lane >= o) incl += t; }
            if (lane == 63) part[wave] = incl;
            __syncthreads();
            float base = incl - run;
            for (int w = 0; w < wave; ++w) base += part[w];
#pragma unroll
            for (int e = 0; e < 9; ++e) { const int i = tid * 9 + e; if (i < LP) cq[i] = i >= NPAD ? (base + v[e]) * LOG2E : 1e30f; }
        }
        if (BOTH(1)) grid.sync();
    }
    if (IN(2)) {
        FRESH_TID();
        __syncthreads();
        { const dn::PrepArgs P{DQKV, args.in[5], GG, BT, (unsigned char*)args.out, (float*)(ws + WS_U), (float*)(ws + WS_CD)};
          for (int it = bx; it < dn::NITEM; it += G) dn::prep_item(lds, P, it / 65, 1 + it % 65, wave, lane); }
        if (BOTH(2)) grid.sync();
    }
    if (IN(3)) {
        __syncthreads();
        { const attn_body::AttnTensors AT{(const attn_body::bf16*)OD, (const attn_body::bf16*)FK, (const attn_body::bf16*)FV, (attn_body::bf16*)OD, CQ};
          const attn_body::StaticOrder S(G, bx);
          attn_body::attn_phase<attn_body::StaticOrder>((char*)lds_raw, AT, S, wave_s); }
        if (bx < 16) { FRESH_TID(); __syncthreads();
            const dn::RecArgs A{(const unsigned char*)args.out, (const float*)(ws + WS_U), (const float*)(ws + WS_CD), DZ, args.in[8], OD};
            dn::rec_chain(lds, A, bx, wave, lane); }
        if (BOTH(3)) grid.sync();
    }
    if (IN(4)) {
        __syncthreads();
        { pg8::Gemm g{1024, 1024}; SchedBr S{bx, G, (const char*)HN, (const char*)OD, (const char*)WG, (const char*)WB}; EpiBr E{(bf16*)args.out + (size_t)bx * 65536, Y};
          pg8::gemm_phase<EpiBr, SchedBr, true, true>(lds, g, S, E, wave_s); }
        if (BOTH(4)) grid.sync();
    }
    if (IN(5)) {
        __syncthreads();
        { pg8::Gemm g{1024, 1024}; SchedStd S{bx, G, 64, 4, 16, (const char*)Y, (const char*)WOUT, (size_t)256 * 1024 * 2, (size_t)256 * 1024 * 2}; EpiRes E{x, args.out, H1B, SS1};
          pg8::gemm_phase<EpiRes, SchedStd, false, true>(lds, g, S, E, wave_s); }
        if (BOTH(5)) grid.sync();
    }
    if (IN(6)) {
        __syncthreads();
        { pg8::Gemm g{1024, 1024}; SchedStd S{bx, G, 64, 22, 16, (const char*)H1B, (const char*)WGU, (size_t)256 * 1024 * 2, (size_t)256 * 1024 * 2}; EpiGU E{SS1, HID};
          pg8::gemm_phase<EpiGU, SchedStd, true, true>(lds, g, S, E, wave_s); }
        if (BOTH(6)) grid.sync();
    }
    if (IN(7)) {
        __syncthreads();
        { pg8::Gemm g{DFF, DFF}; SchedStd S{bx, G, 64, 4, 44, (const char*)HID, (const char*)WDN, (size_t)256 * DFF * 2, (size_t)256 * DFF * 2}; EpiRes E{args.out, args.out, nullptr, SS2};
          pg8::gemm_phase<EpiRes, SchedStd, false, true>(lds, g, S, E, wave_s); }
        if (BOTH(7)) grid.sync();
    }
    if (IN(8)) {
        FRESH_TID();
        const int gw = vcu * NWAVES + wave, NGW = G * NWAVES; const float* fnw = args.in[16];
        for (int m = gw; m < RT; m += NGW) { f32x4* o = (f32x4*)(args.out + (size_t)m * DM) + lane;
            const float rs = rsqrtf(((SS2[m] + SS2[RT + m]) + (SS2[2 * RT + m] + SS2[3 * RT + m])) * (1.f / DM) + EPS);
#pragma unroll
            for (int j = 0; j < 4; ++j) o[64 * j] = o[64 * j] * rs * ((const f32x4*)fnw)[lane + 64 * j]; }
    }
#undef IN
#undef BOTH
}
extern "C" void kernel_launch(void* const* d_in, const int* in_sizes, int n_in, void* d_out, int out_size, void* d_ws, size_t ws_size, hipStream_t stream) {
    if (n_in != 17 || ws_size < WS_END || out_size != RT * DM) { fprintf(stderr, "kernel_launch: unexpected shapes (n_in %d, ws %zu, out %d)\n", n_in, ws_size, out_size); return; }
    static int grid = 0;
    if (grid == 0) {
        int dev = 0, cus = 0, per_cu = 0; (void)hipGetDevice(&dev); (void)hipDeviceGetAttribute(&cus, hipDeviceAttributeMultiprocessorCount, dev);
        if (hipFuncSetAttribute((const void*)mega, hipFuncAttributeMaxDynamicSharedMemorySize, LDS_BYTES) != hipSuccess) { fprintf(stderr, "kernel_launch: hipFuncSetAttribute failed\n"); grid = -1; return; }
        if (hipOccupancyMaxActiveBlocksPerMultiprocessor(&per_cu, (const void*)mega, NWAVES * 64, LDS_BYTES) != hipSuccess || per_cu < 1) { fprintf(stderr, "kernel_launch: occupancy query says %d\n", per_cu); per_cu = 1; }
        (void)hipGetLastError();
        grid = cus;
        if (grid != 256) fprintf(stderr, "kernel_launch: %d CUs (built for 256)\n", grid);
    }
    if (grid < 0) return;
    unsigned char* ws = (unsigned char*)d_ws; float* out = (float*)d_out;
    Args a{}; for (int i = 0; i < 17; ++i) a.in[i] = (const float*)d_in[i]; a.out = out; a.ws = ws; a.ph_lo = 0; a.ph_hi = 9;
    { void* params[] = {&a}; hipError_t e = hipLaunchCooperativeKernel((const void*)mega, dim3(grid), dim3(NWAVES * 64), params, LDS_BYTES, stream);
      if (e != hipSuccess) { fprintf(stderr, "kernel_launch: cooperative launch failed: %s\n", hipGetErrorString(e)); return; } }
}
```

```cpp
#include <hip/hip_runtime.h>
#include <hip/hip_cooperative_groups.h>
#include <hip/hip_bf16.h>
#include <cmath>
#include <cstdint>
#include <cstdio>

namespace cg = cooperative_groups;
typedef unsigned short bf16;
constexpr int NB = 4, SEQ = 4096, DM = 1024, LP = 4224, R = NB * LP, RT = NB * SEQ, DIN = 5648, DFF = 2816;
constexpr int NPAD = 112;
constexpr float EPS = 1e-6f;
constexpr float LOG2E = 1.4426950408889634f;
constexpr float C2 = 0.125f * LOG2E;

constexpr size_t MiB = 1u << 20;
constexpr size_t WS_BAR = 0;
constexpr size_t WS_LG = 1 * MiB;
constexpr size_t WS_CQ = 2 * MiB + 256 * 1024;
constexpr size_t WS_GG = 2 * MiB + 896 * 1024;
constexpr size_t WS_BT = 3 * MiB + 256 * 1024;
constexpr size_t WS_SS1 = 3 * MiB + 512 * 1024;
constexpr size_t WS_SS2 = 3 * MiB + 768 * 1024;
constexpr size_t WS_LF = 4 * MiB;
constexpr size_t WS_WIN = 5 * MiB;
constexpr size_t WS_WG = 12 * MiB;
constexpr size_t WS_WB = 16 * MiB;
constexpr size_t WS_WOUT = 18 * MiB;
constexpr size_t WS_WGU = 20 * MiB;
constexpr size_t WS_WDN = 31 * MiB;
constexpr size_t WS_HN = 37 * MiB;
constexpr size_t WS_OD = 70 * MiB;
constexpr size_t WS_FK = 103 * MiB;
constexpr size_t WS_FV = 119 * MiB + 512 * 1024;
constexpr size_t WS_DQKV = 136 * MiB;
constexpr size_t WS_DZ = 185 * MiB + 512 * 1024;
constexpr size_t WS_CD = 1 * MiB;
constexpr size_t WS_U = 202 * MiB;
constexpr size_t WS_Y = 202 * MiB;
constexpr size_t WS_HID = 70 * MiB;
constexpr size_t WS_END = 256 * MiB;

__device__ __forceinline__ unsigned f2bf(float f) { unsigned u = __builtin_bit_cast(unsigned, f); return (u + 0x7fffu + ((u >> 16) & 1u)) >> 16; }
__device__ __forceinline__ float bf2f(bf16 b) { return __builtin_bit_cast(float, (unsigned)b << 16); }
__device__ __forceinline__ float sigmoidf_(float x) { return 1.f / (1.f + expf(-x)); }
__device__ __forceinline__ float siluf_(float x) { return x / (1.f + expf(-x)); }
__device__ __forceinline__ int lane_id() { return (int)__builtin_amdgcn_mbcnt_hi(~0u, __builtin_amdgcn_mbcnt_lo(~0u, 0u)); }
__device__ __forceinline__ int nat_row(int m) { return (m >> 12) * LP + 128 + (m & 4095); }

namespace pg8 {
#define PG8_LAS __attribute__((address_space(3)))
typedef unsigned short bf16_t;
typedef short bf16x8 __attribute__((ext_vector_type(8)));
typedef float f32x4 __attribute__((ext_vector_type(4)));
typedef unsigned u32x4 __attribute__((ext_vector_type(4)));
constexpr int BM = 256, BK = 64, HALF = 128, HTB = HALF * BK * 2  , STAGE_BYTES = 8 * HTB, NXCD = 8, WGM = 8;
__host__ __device__ __forceinline__ int lds_byte(int r, int c) { const int st = (r >> 4) * 2 + (c >> 5), rr = r & 15, cc = c & 31, ob = rr * 64 + cc * 2; return st * 1024 + (ob ^ (((ob >> 9) & 1) << 5)); }
__host__ __device__ __forceinline__ void stage_rc(int b, int& R, int& C) { const int st = b / 1024, sb = b % 1024, swz = sb ^ (((sb >> 9) & 1) << 5); R = (st >> 1) * 16 + swz / 64; C = (st & 1) * 32 + (swz % 64) / 2; }
__host__ __device__ __forceinline__ int perm32(int rho) { const int n = rho >> 4, i = rho & 15; return 8 * (i >> 2) + 4 * n + (i & 3); }
struct Unit { const char* A; const char* B; int nt; int pm, pn, sub; };
struct Gemm { int lda, ldb; };
__device__ __forceinline__ bool static_tile(int nM, int nN, int G, int c, int i, int& pm, int& pn) {
    const int nwg = nM * nN; const long L = (long)i * G + c; if (L >= nwg) return false;
    int wgid = (int)L; { const int q = nwg / NXCD, r = nwg % NXCD, xcd = wgid % NXCD, off = wgid / NXCD; wgid = (xcd < r ? xcd * (q + 1) : r * (q + 1) + (xcd - r) * q) + off; }
    const int nig = WGM * nN, gid = wgid / nig, fm = gid * WGM, gsz = (nM - fm) < WGM ? (nM - fm) : WGM;
    pm = fm + ((wgid % nig) % gsz); pn = (wgid % nig) / gsz; return true;
}
__device__ __forceinline__ unsigned cvt_pk_bf16(float lo, float hi) { unsigned r; asm volatile("v_cvt_pk_bf16_f32 %0, %1, %2" : "=v"(r) : "v"(lo), "v"(hi)); return r; }
template <class Epi, class Sched, bool ALIGN_EPI = false, bool SP2 = false>
__device__ __forceinline__ void gemm_phase(PG8_LAS unsigned char* lds, const Gemm g, const Sched& S, const Epi& E, const int wave_s) {
    int lane = lane_id(); asm volatile("" : "+v"(lane)); const int wid = wave_s, tid = wid * 64 + lane, wr = wid >> 2, wc = wid & 3, fr = lane & 15, fq = lane >> 4;
    const int lda = g.lda, ldb = g.ldb;
    unsigned voffA[2], voffB[2];
#pragma unroll
    for (int i = 0; i < 2; ++i) { int R, C; stage_rc(tid * 16 + i * 8192, R, C); const int Rb = Epi::PERM ? ((R & ~31) + perm32(R & 31)) : R;
        voffA[i] = (unsigned)(R * lda + C) * 2u; voffB[i] = (unsigned)(Rb * ldb + C) * 2u; }
    const size_t kstep = (size_t)(BK * 2);
    const size_t hstepA = (size_t)HALF * lda * 2, hstepB = (size_t)HALF * ldb * 2;
    const unsigned ldsw = (unsigned)wid * 1024u;
    const int aoff = lds_byte(wr * 64 + fr, fq * 8), boff = lds_byte(wc * 32 + fr, fq * 8);
#define PG8_SA(b, h) (((b) * 2 + (h)) * HTB)
#define PG8_SB(b, h) ((4 + (b) * 2 + (h)) * HTB)
#define PG8_STAGE(bufoff, gbase, voff) do { _Pragma("unroll") for (int _i = 0; _i < 2; ++_i) \
        __builtin_amdgcn_global_load_lds((const unsigned*)((const char*)(gbase) + (voff)[_i]), (PG8_LAS unsigned*)(lds + (bufoff) + ldsw + _i * 8192), 16, 0, 0); } while (0)
#define PG8_LDA(dst, b, h) do { _Pragma("unroll") for (int m = 0; m < 4; ++m) _Pragma("unroll") for (int k = 0; k < 2; ++k) dst[m][k] = *(const PG8_LAS bf16x8*)(lds + PG8_SA(b, h) + aoff + m * 2048 + k * 1024); } while (0)
#define PG8_LDB(dst, b, h) do { _Pragma("unroll") for (int n = 0; n < 2; ++n) _Pragma("unroll") for (int k = 0; k < 2; ++k) dst[n][k] = *(const PG8_LAS bf16x8*)(lds + PG8_SB(b, h) + boff + n * 2048 + k * 1024); } while (0)
#define PG8_MMA(ai, bj, At, Bt) do { __builtin_amdgcn_s_setprio(1); _Pragma("unroll") for (int m = 0; m < 4; ++m) _Pragma("unroll") for (int n = 0; n < 2; ++n) _Pragma("unroll") for (int k = 0; k < 2; ++k) \
        acc[ai][bj][m][n] = __builtin_amdgcn_mfma_f32_16x16x32_bf16(Bt[n][k], At[m][k], acc[ai][bj][m][n], 0, 0, 0); __builtin_amdgcn_s_setprio(0); } while (0)
#define PG8_WAIT_V(n) asm volatile("s_waitcnt vmcnt(" #n ")" ::: "memory")
#define PG8_WAIT_L(n) asm volatile("s_waitcnt lgkmcnt(" #n ")" ::: "memory")
#define PG8_BAR __builtin_amdgcn_s_barrier()
#define PG8_SCHED __builtin_amdgcn_sched_barrier(0)
    Unit cur, nxt; int ui = 0;
    if (!S.next(0, cur)) return;
    f32x4 acc[2][2][4][2];
#pragma unroll
    for (int a = 0; a < 2; ++a)
#pragma unroll
        for (int b = 0; b < 2; ++b)
#pragma unroll
            for (int m = 0; m < 4; ++m)
#pragma unroll
                for (int n = 0; n < 2; ++n) acc[a][b][m][n] = (f32x4){0.f, 0.f, 0.f, 0.f};
    bf16x8 At[4][2], B0[2][2], B1[2][2];
    const char* cA = cur.A; const char* cB = cur.B;
    S.a_ready(cur);
    if constexpr (SP2) {
        PG8_STAGE(PG8_SB(0, 0), cB, voffB); PG8_STAGE(PG8_SB(0, 1), cB + hstepB, voffB); PG8_STAGE(PG8_SA(0, 0), cA, voffA); PG8_STAGE(PG8_SA(0, 1), cA + hstepA, voffA);
        if (wr == 1) PG8_BAR;
        PG8_WAIT_V(2); PG8_BAR;
        PG8_STAGE(PG8_SB(1, 0), cB + kstep, voffB); PG8_STAGE(PG8_SA(1, 0), cA + kstep, voffA); PG8_STAGE(PG8_SB(1, 1), cB + hstepB + kstep, voffB);
        PG8_WAIT_V(6); PG8_BAR;
    } else {
        PG8_STAGE(PG8_SB(0, 0), cB, voffB); PG8_STAGE(PG8_SA(0, 0), cA, voffA); PG8_STAGE(PG8_SB(0, 1), cB + hstepB, voffB); PG8_STAGE(PG8_SA(0, 1), cA + hstepA, voffA);
        if (wr == 1) PG8_BAR;
        PG8_WAIT_V(4); PG8_BAR;
        PG8_STAGE(PG8_SB(1, 0), cB + kstep, voffB); PG8_STAGE(PG8_SA(1, 0), cA + kstep, voffA); PG8_STAGE(PG8_SB(1, 1), cB + hstepB + kstep, voffB);
        PG8_WAIT_V(6); PG8_BAR;
    }
    for (;;) {
        const bool has_next = S.next(ui + 1, nxt);
        const char* nA = has_next ? nxt.A : cA; const char* nB = has_next ? nxt.B : cB;
        const int nt = cur.nt;
        for (int t = 0; t < nt; t += 2) {
            const bool last = (t == nt - 2);
            const char* a1 = cA + (size_t)(t + 1) * kstep;
            const char* a2 = last ? nA : cA + (size_t)(t + 2) * kstep; const char* b2 = last ? nB : cB + (size_t)(t + 2) * kstep;
            const char* a3 = a2 + kstep; const char* b3 = b2 + kstep;
            if (last && has_next) S.a_ready(nxt);
            if constexpr (SP2) {
            PG8_LDB(B0, 0, 0); PG8_LDB(B1, 0, 1); PG8_SCHED; PG8_LDA(At, 0, 0); PG8_STAGE(PG8_SA(1, 1), a1 + hstepA, voffA);
            PG8_WAIT_V(8); PG8_WAIT_L(0); PG8_BAR; PG8_MMA(0, 0, At, B0); PG8_MMA(0, 1, At, B1); PG8_BAR; PG8_SCHED;
            PG8_LDA(At, 0, 1); PG8_STAGE(PG8_SB(0, 0), b2, voffB); PG8_STAGE(PG8_SB(0, 1), b2 + hstepB, voffB); PG8_STAGE(PG8_SA(0, 0), a2, voffA);
            PG8_WAIT_V(8); PG8_WAIT_L(0); PG8_BAR; PG8_MMA(1, 0, At, B0); PG8_MMA(1, 1, At, B1); PG8_BAR; PG8_SCHED;
            PG8_LDB(B0, 1, 0); PG8_LDB(B1, 1, 1); PG8_SCHED; PG8_LDA(At, 1, 0); PG8_STAGE(PG8_SA(0, 1), a2 + hstepA, voffA);
            PG8_WAIT_V(8); PG8_WAIT_L(0); PG8_BAR; PG8_MMA(0, 0, At, B0); PG8_MMA(0, 1, At, B1); PG8_BAR; PG8_SCHED;
            PG8_LDA(At, 1, 1); PG8_STAGE(PG8_SB(1, 0), b3, voffB); PG8_STAGE(PG8_SB(1, 1), b3 + hstepB, voffB); PG8_STAGE(PG8_SA(1, 0), a3, voffA);
            PG8_WAIT_V(8); PG8_WAIT_L(0); PG8_BAR; PG8_MMA(1, 0, At, B0); PG8_MMA(1, 1, At, B1); PG8_BAR; PG8_SCHED;
            } else {
            PG8_LDB(B0, 0, 0); PG8_SCHED; PG8_LDA(At, 0, 0); PG8_STAGE(PG8_SA(1, 1), a1 + hstepA, voffA);
            PG8_WAIT_L(8); PG8_BAR; PG8_WAIT_L(0); PG8_MMA(0, 0, At, B0); PG8_BAR; PG8_SCHED;
            PG8_LDB(B1, 0, 1); PG8_STAGE(PG8_SB(0, 0), b2, voffB);
            PG8_BAR; PG8_WAIT_L(0); PG8_MMA(0, 1, At, B1); PG8_BAR;
            PG8_LDA(At, 0, 1); PG8_STAGE(PG8_SA(0, 0), a2, voffA);
            PG8_BAR; PG8_WAIT_L(0); PG8_MMA(1, 0, At, B0); PG8_BAR; PG8_SCHED;
            PG8_STAGE(PG8_SB(0, 1), b2 + hstepB, voffB);
            PG8_WAIT_V(6); PG8_BAR; PG8_MMA(1, 1, At, B1); PG8_BAR;
            PG8_LDB(B0, 1, 0); PG8_SCHED; PG8_LDA(At, 1, 0); PG8_STAGE(PG8_SA(0, 1), a2 + hstepA, voffA);
            PG8_WAIT_L(8); PG8_BAR; PG8_WAIT_L(0); PG8_MMA(0, 0, At, B0); PG8_BAR; PG8_SCHED;
            PG8_LDB(B1, 1, 1); PG8_STAGE(PG8_SB(1, 0), b3, voffB);
            PG8_BAR; PG8_WAIT_L(0); PG8_MMA(0, 1, At, B1); PG8_BAR;
            PG8_LDA(At, 1, 1); PG8_STAGE(PG8_SA(1, 0), a3, voffA);
            PG8_BAR; PG8_WAIT_L(0); PG8_MMA(1, 0, At, B0); PG8_BAR; PG8_SCHED;
            PG8_STAGE(PG8_SB(1, 1), b3 + hstepB, voffB);
            PG8_WAIT_V(6); PG8_BAR; PG8_MMA(1, 1, At, B1); PG8_BAR;
            }
        }
        if constexpr (ALIGN_EPI) { if (wr == 0) PG8_BAR; }
        if constexpr (!Epi::AFTER_DRAIN) { E(acc, cur, wr, wc, fr, fq); S.done(cur); }
        if (!has_next) break;
#pragma unroll
        for (int a = 0; a < 2; ++a)
#pragma unroll
            for (int b = 0; b < 2; ++b)
#pragma unroll
                for (int m = 0; m < 4; ++m)
#pragma unroll
                    for (int n = 0; n < 2; ++n) acc[a][b][m][n] = (f32x4){0.f, 0.f, 0.f, 0.f};
        cur = nxt; cA = nA; cB = nB; ++ui;
        if constexpr (ALIGN_EPI) { if (wr == 1) PG8_BAR; }
    }
    PG8_WAIT_V(0);
    if constexpr (!ALIGN_EPI) { if (wr == 0) PG8_BAR; }
    PG8_BAR;
    if constexpr (Epi::AFTER_DRAIN) { E.fused(acc, cur, wr, wc, fr, fq, lds, wid, lane); S.done(cur); }
#undef PG8_SA
#undef PG8_SB
#undef PG8_STAGE
#undef PG8_LDA
#undef PG8_LDB
#undef PG8_MMA
#undef PG8_WAIT_V
#undef PG8_WAIT_L
#undef PG8_BAR
#undef PG8_SCHED
}
}

namespace attn_body {
using bf16=__hip_bfloat16;
using bf16x8=__attribute__((ext_vector_type(8)))short;
using s16x4=__attribute__((ext_vector_type(4)))short;
using f32x16=__attribute__((ext_vector_type(16)))float;
using u32x4=__attribute__((ext_vector_type(4)))unsigned;
constexpr int BATCH=4,NHEAD=8,SEQ=4224,D=64,QP=1024,KP=512;
constexpr int NW=8,QBLK=32,QB=QBLK*NW,KVBLK=64,NQB=16;
constexpr int ATTN_UNIT_ROWS=QB;
__device__ __forceinline__ int crow(int r,int hi){return (r&3)+8*(r>>2)+4*hi;}
#define SBAR() __builtin_amdgcn_sched_barrier(0)
__device__ __forceinline__ void cmask(f32x16&p0,f32x16&p1,int jb,int qrel,int hi){
  const float NEG=-INFINITY; int kb=64*jb+4*hi;
  #pragma unroll
  for(int r=0;r<16;++r){int kv=kb+(r&3)+8*(r>>2); if(kv>qrel)p0[r]=NEG; if(kv+32>qrel)p1[r]=NEG;}
}

constexpr int NSLOT=3, SLOTB=8192;
constexpr int LDS_K=0, LDS_V=NSLOT*SLOTB, LDS_WS=2*NSLOT*SLOTB, LDS_OST=LDS_WS+NW*64*4, LDS_CT=LDS_OST+NW*4096+2048, LDS_BYTES=LDS_CT+SEQ*4;
constexpr float C2=0.125f*1.4426950408889634f;
__device__ __forceinline__ void glds16(const void*gsrc,unsigned lds_dst){unsigned keep;
  asm volatile("s_mov_b32 %0, m0\n\ts_mov_b32 m0, %2\n\ts_nop 0\n\tglobal_load_lds_dwordx4 %1, off\n\ts_mov_b32 m0, %0":"=&s"(keep):"v"(gsrc),"s"(lds_dst):"memory");}
__device__ __forceinline__ float max3f(float a,float b,float c){float r;asm("v_max3_f32 %0, %1, %2, %3":"=v"(r):"v"(a),"v"(b),"v"(c));return r;}
__device__ __forceinline__ float max2f(float a,float b){float r;asm("v_max_f32_e32 %0, %1, %2":"=v"(r):"v"(a),"v"(b));return r;}
__device__ __forceinline__ float fadd_s(float a,float b){float r;asm("v_add_f32_e32 %0, %1, %2":"=v"(r):"v"(a),"v"(b));return r;}
__device__ __forceinline__ float fsub_s(float a,float b){float r;asm("v_sub_f32_e32 %0, %1, %2":"=v"(r):"v"(a),"v"(b));return r;}
typedef float f32x2_t __attribute__((ext_vector_type(2))); typedef float f32x4_t __attribute__((ext_vector_type(4))); typedef __bf16 bf16x2_t __attribute__((ext_vector_type(2)));
__device__ __forceinline__ unsigned cvtpk_s(float lo,float hi){f32x2_t v={lo,hi};bf16x2_t b=__builtin_convertvector(v,bf16x2_t);return __builtin_bit_cast(unsigned,b);}
#define WAIT_BAR(N) asm volatile("s_waitcnt vmcnt(" #N ") lgkmcnt(0)\n\ts_barrier":::"memory")

__device__ __forceinline__ void qkt(f32x16&p0,f32x16&p1,const char*Kslot,const bf16x8*qr,const f32x16&negm,int r32,int hi){
  const char*kb=Kslot+hi*1024+r32*16;
  #pragma unroll
  for(int d0=0;d0<4;++d0){
    const bf16x8 b0=*reinterpret_cast<const bf16x8*>(kb+d0*2048);
    const bf16x8 b1=*reinterpret_cast<const bf16x8*>(kb+d0*2048+512);
    if(d0==0){p0=__builtin_amdgcn_mfma_f32_32x32x16_bf16(b0,qr[0],negm,0,0,0);p1=__builtin_amdgcn_mfma_f32_32x32x16_bf16(b1,qr[0],negm,0,0,0);}
    else{p0=__builtin_amdgcn_mfma_f32_32x32x16_bf16(b0,qr[d0],p0,0,0,0);p1=__builtin_amdgcn_mfma_f32_32x32x16_bf16(b1,qr[d0],p1,0,0,0);}}
}
typedef __attribute__((address_space(3))) const char* lds_cptr;
typedef short v4i16_t __attribute__((ext_vector_type(4)));
__device__ __forceinline__ void kload8(bf16x8*kf,lds_cptr kp){
  kf[0]=*(const __attribute__((address_space(3))) bf16x8*)(kp);      kf[1]=*(const __attribute__((address_space(3))) bf16x8*)(kp+512);
  kf[2]=*(const __attribute__((address_space(3))) bf16x8*)(kp+2048); kf[3]=*(const __attribute__((address_space(3))) bf16x8*)(kp+2560);
  kf[4]=*(const __attribute__((address_space(3))) bf16x8*)(kp+4096); kf[5]=*(const __attribute__((address_space(3))) bf16x8*)(kp+4608);
  kf[6]=*(const __attribute__((address_space(3))) bf16x8*)(kp+6144); kf[7]=*(const __attribute__((address_space(3))) bf16x8*)(kp+6656);
}
__device__ __forceinline__ void kload2(bf16x8*kf,lds_cptr kp,int j){ kf[2*j]=*(const __attribute__((address_space(3))) bf16x8*)(kp+j*2048); kf[2*j+1]=*(const __attribute__((address_space(3))) bf16x8*)(kp+j*2048+512); }
__device__ __forceinline__ s16x4 vtr(lds_cptr p){ return __builtin_bit_cast(s16x4,__builtin_amdgcn_ds_read_tr16_b64_v4i16((__attribute__((address_space(3))) v4i16_t*)p)); }
__device__ __forceinline__ float rowmax(const f32x16&p0,const f32x16&p1){
  float a=max3f(p0[0],p0[1],p1[0]),b=max3f(p0[2],p0[3],p1[1]);a=max3f(a,p1[2],p1[3]);
  #pragma unroll
  for(int r=4;r<16;r+=4){a=max3f(a,p0[r],p0[r+1]);b=max3f(b,p0[r+2],p0[r+3]);a=max3f(a,p1[r],p1[r+1]);b=max3f(b,p1[r+2],p1[r+3]);}
  const float m=max2f(a,b);
  auto rr=__builtin_amdgcn_permlane32_swap(__float_as_uint(m),__float_as_uint(m),false,false);
  return max2f(__uint_as_float(rr[0]),__uint_as_float(rr[1]));
}
__device__ __forceinline__ void pv(f32x16*o,int vb,bf16x8 pa0,bf16x8 pa1,bf16x8 pa2,bf16x8 pa3){
  #pragma unroll
  for(int d0=0;d0<2;++d0){s16x4 lo[4],hi[4];
    #pragma unroll
    for(int ks=0;ks<4;++ks){
      asm volatile("ds_read_b64_tr_b16 %0,%1 offset:%c2":"=&v"(lo[ks]):"v"(vb),"i"(d0*4096+ks*1024):"memory");
      asm volatile("ds_read_b64_tr_b16 %0,%1 offset:%c2":"=&v"(hi[ks]):"v"(vb),"i"(d0*4096+ks*1024+512):"memory");}
    asm volatile("s_waitcnt lgkmcnt(0)":::"memory");SBAR();
    #define PK(k) (bf16x8){lo[k][0],lo[k][1],lo[k][2],lo[k][3],hi[k][0],hi[k][1],hi[k][2],hi[k][3]}
    o[d0]=__builtin_amdgcn_mfma_f32_32x32x16_bf16(pa0,PK(0),o[d0],0,0,0);
    o[d0]=__builtin_amdgcn_mfma_f32_32x32x16_bf16(pa1,PK(1),o[d0],0,0,0);
    o[d0]=__builtin_amdgcn_mfma_f32_32x32x16_bf16(pa2,PK(2),o[d0],0,0,0);
    o[d0]=__builtin_amdgcn_mfma_f32_32x32x16_bf16(pa3,PK(3),o[d0],0,0,0);
    #undef PK
  }
}

#ifndef ATTN_STORE16
#define ATTN_STORE16(p,v) (*(u32x4*)(p)=(v))
#endif
template<int THRL> __device__ __forceinline__ void attn_unit(int b,int h,int qb,const bf16*Q,const bf16*__restrict__ K,const bf16*__restrict__ V,bf16*O,const float*__restrict__ CQ,char*shm,const int wave_s){
  int lane=lane_id(); asm volatile("":"+v"(lane));
  const int wid=wave_s,tid=wid*64+lane,r32=lane&31,hi=lane>>5;
  const long rowbase=(long)b*SEQ; const int q0=128+qb*QB;
  const bf16*Qw=Q+(rowbase+q0+wid*QBLK)*QP+h*D;
  const bf16*Kh=K+rowbase*KP+h*D,*Vh=V+rowbase*KP+h*D;
  const unsigned lds0=(unsigned)(uintptr_t)shm;
  float*wsf=(float*)(shm+LDS_WS)+wid*64;
  const bf16*ksrc=Kh+(long)lane*KP+wid*8;
  const bf16*vsrc=Vh+(long)(16*(wid&3)+(lane>>2))*KP+(wid>>2)*32+(lane&3)*8;
  const unsigned kdst=lds0+LDS_K+wid*1024, vdst=lds0+LDS_V+wid*1024;
  #define PT(t) (((t)<2)?((t)^1):(t))
  #define DMA_K(t,slot) glds16(ksrc+(long)PT(t)*KVBLK*KP,(unsigned)__builtin_amdgcn_readfirstlane(kdst+(slot)))
  #define DMA_V(t,slot) glds16(vsrc+(long)PT(t)*KVBLK*KP,(unsigned)__builtin_amdgcn_readfirstlane(vdst+(slot)))
  const int vb0=(int)(lds0+LDS_V)+((lane>>4)&1)*32+(lane&3)*8+(4*hi+((lane&15)>>2))*64;
  const char*Kbase=shm+LDS_K; bf16x8 kf[8];
  const lds_cptr shm3=(lds_cptr)shm; const lds_cptr kp0=shm3+LDS_K+hi*1024+r32*16; const lds_cptr vp0=shm3+LDS_V+((lane>>4)&1)*32+(lane&3)*8+(4*hi+((lane&15)>>2))*64;
  const int NT=(q0+QB)/KVBLK;
  DMA_K(0,0);DMA_V(0,0);DMA_K(1,SLOTB);
  bf16x8 qr[4];
  #pragma unroll
  for(int d0=0;d0<4;++d0)qr[d0]=*reinterpret_cast<const bf16x8*>(&Qw[(long)r32*QP+d0*16+hi*8]);
  { const float*cg=CQ+(long)(b*NHEAD+h)*SEQ; __attribute__((address_space(3))) float*ct=(__attribute__((address_space(3))) float*)((lds_cptr)shm+LDS_CT); const int ncp=q0+QB;
    for(int i=tid;i<ncp;i+=NW*64)ct[i]=cg[i]; }
  const lds_cptr ctp=(lds_cptr)shm+LDS_CT+hi*16;
  float mhat=0.f,l_reg=0.f;f32x16 o[2];o[0]=f32x16{};o[1]=f32x16{};
  const float cqp=CQ[(long)(b*NHEAD+h)*SEQ+q0+wid*QBLK+r32];
  const f32x16 negm=f32x16{};
  float base=cqp;
  const int qrel=wid*QBLK+r32;
  #define CMASK(P0,P1,t) do{int jb_=(t)-(NT-4); if(jb_>=0)cmask(P0,P1,jb_,qrel,hi);}while(0)
  bool resc=false;
  #define START(P0,P1) do{ const float rm=rowmax(P0,P1); resc=false; \
    { const float dl=rm; mhat=fadd_s(mhat,dl); \
      _Pragma("unroll") for(int r=0;r<16;++r){P0[r]=fsub_s(P0[r],dl);P1[r]=fsub_s(P1[r],dl);} \
      base=cqp-mhat; } \
    _Pragma("unroll") for(int r=0;r<16;++r)P0[r]=__builtin_amdgcn_exp2f(P0[r]); }while(0)
  #define RESC() do{ if(resc){ asm volatile("s_waitcnt lgkmcnt(0)":::"memory"); \
      _Pragma("unroll") for(int d_=0;d_<2;++d_) _Pragma("unroll") for(int r=0;r<16;++r)o[d_][r]*=wsf[crow(r,hi)]; } }while(0)
  #define CKSUB(C0,C1,t) do{ const lds_cptr cp_=ctp+256*PT(t); \
    const f32x2_t b2_={base,base}; \
    _Pragma("unroll") for(int g_=0;g_<4;++g_){ const f32x4_t a_=*(const __attribute__((address_space(3))) f32x4_t*)(cp_+32*g_); \
      f32x2_t x_={C0[4*g_],C0[4*g_+1]},y_={C0[4*g_+2],C0[4*g_+3]}; x_=(x_-(f32x2_t){a_[0],a_[1]})+b2_; y_=(y_-(f32x2_t){a_[2],a_[3]})+b2_; \
      C0[4*g_]=x_[0];C0[4*g_+1]=x_[1];C0[4*g_+2]=y_[0];C0[4*g_+3]=y_[1]; } SBAR(); \
    _Pragma("unroll") for(int g_=0;g_<4;++g_){ const f32x4_t a_=*(const __attribute__((address_space(3))) f32x4_t*)(cp_+128+32*g_); \
      f32x2_t x_={C1[4*g_],C1[4*g_+1]},y_={C1[4*g_+2],C1[4*g_+3]}; x_=(x_-(f32x2_t){a_[0],a_[1]})+b2_; y_=(y_-(f32x2_t){a_[2],a_[3]})+b2_; \
      C1[4*g_]=x_[0];C1[4*g_+1]=x_[1];C1[4*g_+2]=y_[0];C1[4*g_+3]=y_[1]; } SBAR(); }while(0)
  f32x16 pA0,pA1,pB0,pB1;
  int sl_prev=0,sl_cur=0,sl_next=SLOTB;
  #define ROT() do{sl_prev=sl_cur;sl_cur=sl_next;sl_next=(sl_next==(NSLOT-1)*SLOTB)?0:sl_next+SLOTB;}while(0)
  DMA_K(2,2*SLOTB);
  WAIT_BAR(3);
  qkt(pA0,pA1,Kbase,qr,negm,r32,hi);asm volatile("s_nop 15\n\ts_nop 7":"+v"(pA0),"+v"(pA1));CKSUB(pA0,pA1,0);CMASK(pA0,pA1,0);
  START(pA0,pA1);
  _Pragma("unroll") for(int r=0;r<16;++r)pA1[r]=__builtin_amdgcn_exp2f(pA1[r]);
  WAIT_BAR(0);
  DMA_K(3,0);DMA_V(1,SLOTB);
  ROT();
  kload8(kf,kp0+sl_cur);
  WAIT_BAR(2);
  s16x4 vlo[8],vhi[8]; u32x4 pw0,pw1,pw2,pw3;
  #define PKW(P,B) cvtpk_s(P[B],P[B+1])
  #define PAF(k) __builtin_bit_cast(bf16x8,pw##k)
  #define VFR(i) (bf16x8){vlo[i][0],vlo[i][1],vlo[i][2],vlo[i][3],vhi[i][0],vhi[i][1],vhi[i][2],vhi[i][3]}
  #define PIN(x) asm volatile("":"+v"(x))
  #define MX3(a,b,c) __builtin_fmaxf(__builtin_fmaxf((a),(b)),(c))
  #define GAPA(MF,A0,A1,A2,A3,W0,W1,PW) do{ MF; sacc+=A0; sacc+=A1; sacc+=A2; sacc+=A3; PIN(sacc); W0; W1; PIN(PW); SBAR(); }while(0)
  #define EX(v) __builtin_amdgcn_exp2f(v)
  #define GAPB(MF,X,B) do{ MF; X[B]=EX(X[B]); X[B+1]=EX(X[B+1]); X[B+2]=EX(X[B+2]); X[B+3]=EX(X[B+3]); PIN(X); SBAR(); }while(0)
  #define VRD(i) do{ vlo[i]=vtr(vp_+(((i)>>2)*4096+((i)&3)*1024)); vhi[i]=vtr(vp_+(((i)>>2)*4096+((i)&3)*1024+512)); }while(0)
  #define KRD(G,j) do{ if(G){ kload2(kf,kp0+sl_next,j); SBAR(); } }while(0)
  #define STEP(C0,C1,P0,P1,t,GK,GV,GL) do{ SBAR(); \
    const lds_cptr vp_=vp0+sl_prev; \
    VRD(0); SBAR(); float sacc=(P0[0]+P0[1]); \
    GAPA(C0=__builtin_amdgcn_mfma_f32_32x32x16_bf16(kf[0],qr[0],negm,0,0,0), P0[2],P0[3],P0[4],P0[5],     pw0[0]=PKW(P0,0), pw0[1]=PKW(P0,2), pw0); \
    VRD(4); SBAR(); GAPA(C1=__builtin_amdgcn_mfma_f32_32x32x16_bf16(kf[1],qr[0],negm,0,0,0), P0[6],P0[7],P0[8],P0[9],     pw0[2]=PKW(P0,4), pw0[3]=PKW(P0,6), pw0); \
    VRD(1); SBAR(); GAPA(C0=__builtin_amdgcn_mfma_f32_32x32x16_bf16(kf[2],qr[1],C0,0,0,0),   P0[10],P0[11],P0[12],P0[13], pw1[0]=PKW(P0,8), pw1[1]=PKW(P0,10), pw1); \
    VRD(5); SBAR(); GAPA(C1=__builtin_amdgcn_mfma_f32_32x32x16_bf16(kf[3],qr[1],C1,0,0,0),   P0[14],P0[15],P1[0],P1[1],   pw1[2]=PKW(P0,12),pw1[3]=PKW(P0,14), pw1); \
    VRD(2); SBAR(); GAPA(C0=__builtin_amdgcn_mfma_f32_32x32x16_bf16(kf[4],qr[2],C0,0,0,0),   P1[2],P1[3],P1[4],P1[5],     pw2[0]=PKW(P1,0), pw2[1]=PKW(P1,2), pw2); \
    VRD(6); SBAR(); GAPA(C1=__builtin_amdgcn_mfma_f32_32x32x16_bf16(kf[5],qr[2],C1,0,0,0),   P1[6],P1[7],P1[8],P1[9],     pw2[2]=PKW(P1,4), pw2[3]=PKW(P1,6), pw2); \
    VRD(3); SBAR(); GAPA(C0=__builtin_amdgcn_mfma_f32_32x32x16_bf16(kf[6],qr[3],C0,0,0,0),   P1[10],P1[11],P1[12],P1[13], pw3[0]=PKW(P1,8), pw3[1]=PKW(P1,10), pw3); \
    VRD(7); SBAR(); GAPA(C1=__builtin_amdgcn_mfma_f32_32x32x16_bf16(kf[7],qr[3],C1,0,0,0),   P1[14],P1[15],0.f,0.f,       pw3[2]=PKW(P1,12),pw3[3]=PKW(P1,14), pw3); \
    l_reg+=sacc; \
    if(GK){DMA_K((t)+3,sl_cur);} if(GV){DMA_V((t)+1,sl_next);} \
    CKSUB(C0,C1,t); CMASK(C0,C1,t); \
    { float a=MX3(C0[0],C0[1],C1[0]),b=MX3(C0[2],C0[3],C1[1]); a=MX3(a,C1[2],C1[3]); \
      _Pragma("unroll") for(int r=4;r<16;r+=4){a=MX3(a,C0[r],C0[r+1]);b=MX3(b,C0[r+2],C0[r+3]);a=MX3(a,C1[r],C1[r+1]);b=MX3(b,C1[r+2],C1[r+3]);} \
      float rm=__builtin_fmaxf(a,b); { auto rr=__builtin_amdgcn_permlane32_swap(__float_as_uint(rm),__float_as_uint(rm),false,false); rm=__builtin_fmaxf(__uint_as_float(rr[0]),__uint_as_float(rr[1])); } \
      resc=false; \
      if(__builtin_expect(__any(rm>(float)THRL),0)){ const float dl=__builtin_fmaxf(rm,0.f); mhat+=dl; \
        _Pragma("unroll") for(int r=0;r<16;++r){C0[r]-=dl;C1[r]-=dl;} \
        base=cqp-mhat; \
        const float f=__builtin_amdgcn_exp2f(-dl); l_reg*=f; if(hi==0)wsf[r32]=f; resc=true; } } \
    SBAR(); \
    GAPB(o[0]=__builtin_amdgcn_mfma_f32_32x32x16_bf16(PAF(0),VFR(0),o[0],0,0,0), C0,0); \
    GAPB(o[1]=__builtin_amdgcn_mfma_f32_32x32x16_bf16(PAF(0),VFR(4),o[1],0,0,0), C0,4); \
    KRD(GL,0); GAPB(o[0]=__builtin_amdgcn_mfma_f32_32x32x16_bf16(PAF(1),VFR(1),o[0],0,0,0), C0,8); \
    KRD(GL,1); GAPB(o[1]=__builtin_amdgcn_mfma_f32_32x32x16_bf16(PAF(1),VFR(5),o[1],0,0,0), C0,12); \
    KRD(GL,2); GAPB(o[0]=__builtin_amdgcn_mfma_f32_32x32x16_bf16(PAF(2),VFR(2),o[0],0,0,0), C1,0); \
    KRD(GL,3); GAPB(o[1]=__builtin_amdgcn_mfma_f32_32x32x16_bf16(PAF(2),VFR(6),o[1],0,0,0), C1,4); \
    GAPB(o[0]=__builtin_amdgcn_mfma_f32_32x32x16_bf16(PAF(3),VFR(3),o[0],0,0,0), C1,8); \
    GAPB(o[1]=__builtin_amdgcn_mfma_f32_32x32x16_bf16(PAF(3),VFR(7),o[1],0,0,0), C1,12); \
    }while(0)
  int t=1;
  #undef CMASK
  #define CMASK(P0,P1,t) do{}while(0)
  for(;t+5<NT;t+=2){
    STEP(pB0,pB1,pA0,pA1,t,true,true,true);     WAIT_BAR(2); RESC(); ROT();
    STEP(pA0,pA1,pB0,pB1,t+1,true,true,true);   WAIT_BAR(2); RESC(); ROT();
  }
  #undef CMASK
  #define CMASK(P0,P1,t) do{int jb_=(t)-(NT-4); if(jb_>=0)cmask(P0,P1,jb_,qrel,hi);}while(0)
  #define ENDW(tt) do{ if((tt)+3<NT){WAIT_BAR(2);} else if((tt)+2<NT){WAIT_BAR(1);} else {WAIT_BAR(0);} }while(0)
  for(;t+1<NT;t+=2){
    STEP(pB0,pB1,pA0,pA1,t,(t+3<NT),(t+1<NT),(t+1<NT));       ENDW(t);   RESC(); ROT();
    STEP(pA0,pA1,pB0,pB1,t+1,(t+4<NT),(t+2<NT),(t+2<NT));     ENDW(t+1); RESC(); ROT();
  }
  STEP(pB0,pB1,pA0,pA1,NT-1,false,false,false); RESC();
  { float sacc=pB0[0]+pB0[1]; _Pragma("unroll") for(int r=2;r<16;++r)sacc+=pB0[r]; _Pragma("unroll") for(int r=0;r<16;++r)sacc+=pB1[r]; l_reg+=sacc;
    pw0=(u32x4){PKW(pB0,0),PKW(pB0,2),PKW(pB0,4),PKW(pB0,6)};pw1=(u32x4){PKW(pB0,8),PKW(pB0,10),PKW(pB0,12),PKW(pB0,14)};pw2=(u32x4){PKW(pB1,0),PKW(pB1,2),PKW(pB1,4),PKW(pB1,6)};pw3=(u32x4){PKW(pB1,8),PKW(pB1,10),PKW(pB1,12),PKW(pB1,14)};
    SBAR(); pv(o,vb0+sl_cur,PAF(0),PAF(1),PAF(2),PAF(3)); }
  #undef PKW
  #undef PAF
  #undef VFR
  #undef PIN
  #undef MX3
  #undef GAPA
  #undef GAPB
  #undef EX
  #undef VRD
  #undef KRD
  #undef STEP
  #undef ENDW
  {auto rr=__builtin_amdgcn_permlane32_swap(__float_as_uint(l_reg),__float_as_uint(l_reg),false,false);l_reg=__uint_as_float(rr[0])+__uint_as_float(rr[1]);}
  int lane_e=lane_id(); asm volatile("":"+v"(lane_e));
  const int r32e=lane_e&31,hie=lane_e>>5; float*wsfe=(float*)(shm+LDS_WS)+wid*64;
  if(hie==0)wsfe[32+r32e]=l_reg;asm volatile("s_waitcnt lgkmcnt(0)":::"memory");
  float rli[16];
  #pragma unroll
  for(int r=0;r<16;++r)rli[r]=__builtin_amdgcn_rcpf(wsfe[32+crow(r,hie)]);
  bf16*Ow=O+(rowbase+q0+wid*QBLK)*QP+h*D;
  { bf16*stg=(bf16*)(shm+LDS_OST)+wid*2048;
    #pragma unroll
    for(int r=0;r<16;++r){const int orow=crow(r,hie);
      #pragma unroll
      for(int d0=0;d0<2;++d0)stg[orow*64+d0*32+r32e]=__float2bfloat16(o[d0][r]*rli[r]);}
    asm volatile("s_waitcnt lgkmcnt(0)":::"memory");
    #pragma unroll
    for(int i=0;i<4;++i){const int row=i*8+(lane_e>>3),ch=lane_e&7; const u32x4 v=*(const u32x4*)(stg+row*64+ch*8); ATTN_STORE16(Ow+(long)row*QP+ch*8,v);} }
  asm volatile("s_waitcnt lgkmcnt(0)\n\ts_barrier":::"memory");
  #undef DMA_K
  #undef PT
  #undef CKSUB
  #undef DMA_V
  #undef CMASK
  #undef START
  #undef RESC
  #undef ROT
}
constexpr int ATTN_LDS_BYTES=LDS_BYTES;
struct AttnTensors { const bf16* Q; const bf16* K; const bf16* V; bf16* O; const float* CQ; };
struct AttnUnit { int bh; int qb; };
struct StaticOrder {
  int vcu;
  __device__ __forceinline__ explicit StaticOrder(int grid,int block):vcu((block%8)*(grid/8)+block/8){}
  __device__ __forceinline__ bool next(int i,AttnUnit&u)const{ if(i>=2)return false; const int s=vcu&7; u.bh=vcu>>3; u.qb=(i==0)?s:15-s; return true; }
  __device__ __forceinline__ void a_ready(const AttnUnit&)const{}
  __device__ __forceinline__ void done(const AttnUnit&)const{}
};
template<class Sched,int THRL=8> __device__ __forceinline__ void attn_phase(char*lds,const AttnTensors&T,const Sched&S,const int wave_s){
  AttnUnit u;
  for(int i=0;S.next(i,u);++i){ S.a_ready(u); attn_unit<THRL>(u.bh/NHEAD,u.bh%NHEAD,u.qb,T.Q,T.K,T.V,T.O,T.CQ,lds,wave_s); S.done(u); }
}
#undef SBAR
#undef WAIT_BAR
}

namespace dn {
typedef short bf16x8 __attribute__((ext_vector_type(8)));
typedef float f32x16 __attribute__((ext_vector_type(16)));
typedef float f32x4 __attribute__((ext_vector_type(4)));
typedef float f32x2 __attribute__((ext_vector_type(2)));
typedef unsigned u32x4 __attribute__((ext_vector_type(4)));
typedef unsigned u32x2 __attribute__((ext_vector_type(2)));
#define DLAS __attribute__((address_space(3)))
constexpr int NCH = 66, NITEM = 16 * 65;
constexpr int IMG_W = 0, IMG_Q = 16384, IMG_K = 32768, IMG_A = 49152, IMG_BYTES = 57344;
constexpr float QSCALE = 0.08838834764831845f;
__device__ __forceinline__ int img_off128(int m, int k) { const int ch = 2 * (k >> 4) + ((k >> 2) & 1), pos = 4 * ((k >> 3) & 1) + (k & 3); return m * 256 + ((ch ^ (m & 15)) << 4) + pos * 2; }
__device__ __forceinline__ int img_off64(int m, int k)  { const int ch = 2 * (k >> 4) + ((k >> 2) & 1), pos = 4 * ((k >> 3) & 1) + (k & 3); return m * 128 + ((ch ^ ((m >> 1) & 7)) << 4) + pos * 2; }
__device__ __forceinline__ float bfl(unsigned w) { return __builtin_bit_cast(float, w << 16); }
__device__ __forceinline__ float bfh(unsigned w) { return __builtin_bit_cast(float, w & 0xffff0000u); }
typedef __bf16 bf16x2_t __attribute__((ext_vector_type(2)));
__device__ __forceinline__ unsigned pkbf(float lo, float hi) { const f32x2 v = {lo, hi}; return __builtin_bit_cast(unsigned, __builtin_convertvector(v, bf16x2_t)); }
__device__ __forceinline__ float wsum(float v) {
#pragma unroll
    for (int o = 1; o < 64; o <<= 1) v += __shfl_xor(v, o);
    return v;
}
struct PrepArgs { const bf16* DQKV; const float* cw; const float* GG; const float* BT; unsigned char* PREP; float* U; float* CD; };
constexpr int L_QB = 0, L_KB = 17408, L_RHS = 34816, L_AM = 100352, L_AIMG = 117760, L_SC = 125952, L_IMG = L_RHS;

#define DN_FRESH_LANE() asm volatile("" : "+v"(lane))
__device__ __forceinline__ void prep_item(DLAS unsigned char* lds, const PrepArgs& P, int bh, int n, int wave, int lane) {
    DN_FRESH_LANE();
    const int b = bh >> 2, h = bh & 3; const size_t rowbase = (size_t)b * LP + 64 * n; const int item = bh * NCH + n;
    int vz = 0; asm volatile("" : "+v"(vz));
    DLAS float* SCf = (DLAS float*)(lds + L_SC + vz);
    if (wave == 0) { const float g = P.GG[(size_t)bh * LP + 64 * n + lane], be = P.BT[(size_t)bh * LP + 64 * n + lane]; float gc = g;
#pragma unroll
        for (int o = 1; o < 64; o <<= 1) { const float t = __shfl_up(gc, o); if (lane >= o) gc += t; }
        const float gl = __shfl(gc, 63);
        SCf[lane] = gc; SCf[64 + lane] = be; SCf[128 + lane] = __expf(gc); SCf[192 + lane] = __expf(gl - gc);
        if (lane == 63) P.CD[item] = __expf(gc); }
    { const int r0 = 8 * wave;
#pragma unroll 1
      for (int which = 0; which < 3; ++which) { const int col = which * 512 + h * 128 + 2 * lane;
        float w0[4], w1[4];
#pragma unroll
        for (int i = 0; i < 4; ++i) { const f32x2 wv = *(const f32x2*)(P.cw + i * 1536 + col); w0[i] = wv.x; w1[i] = wv.y; }
        unsigned u[11];
#pragma unroll
        for (int rr = 0; rr < 11; ++rr) u[rr] = *(const unsigned*)(P.DQKV + (rowbase + r0 - 3 + rr) * 1536 + col);
#pragma unroll
        for (int r = 0; r < 8; ++r) { float a0 = 0.f, a1 = 0.f;
#pragma unroll
            for (int i = 0; i < 4; ++i) { a0 += w0[i] * bfl(u[r + i]); a1 += w1[i] * bfh(u[r + i]); }
            a0 = a0 / (1.f + __expf(-a0)); a1 = a1 / (1.f + __expf(-a1));
            const int row = r0 + r;
            if (which < 2) { const float rs = rsqrtf(wsum(a0 * a0 + a1 * a1) + EPS); a0 *= rs; a1 *= rs;
                *(DLAS unsigned*)(lds + (which == 0 ? L_QB : L_KB) + row * 272 + 4 * lane) = pkbf(a0, a1);
                if (which == 1) *(DLAS f32x2*)(lds + L_RHS + row * 1024 + 512 + 8 * lane) = (f32x2){a0, a1}; }
            else *(DLAS f32x2*)(lds + L_RHS + row * 1024 + 8 * lane) = (f32x2){a0, a1}; } } }
    __syncthreads();
    DN_FRESH_LANE();
    { const int which = wave >> 2, ti = (wave >> 1) & 1, tj = wave & 1, m = lane & 31, hh = lane >> 5;
      const DLAS unsigned char* ap = lds + (which == 0 ? L_KB : L_QB) + (32 * ti + m) * 272 + hh * 16; const DLAS unsigned char* bp = lds + L_KB + (32 * tj + m) * 272 + hh * 16;
      f32x16 acc = f32x16{};
#pragma unroll
      for (int s = 0; s < 8; ++s) acc = __builtin_amdgcn_mfma_f32_32x32x16_bf16(*(const DLAS bf16x8*)(ap + 32 * s), *(const DLAS bf16x8*)(bp + 32 * s), acc, 0, 0, 0);
      const int col = 32 * tj + m; const float gcc = SCf[col];
#pragma unroll
      for (int r = 0; r < 16; ++r) { const int row = 32 * ti + (r & 3) + 8 * (r >> 2) + 4 * hh; const float d = __expf(fminf(SCf[row] - gcc, 0.f));
          if (which == 0) { *(DLAS float*)(lds + L_AM + (row * 68 + col) * 4) = col < row ? SCf[64 + row] * acc[r] * d : 0.f; }
          else { const float v = col <= row ? acc[r] * QSCALE * d : 0.f; *(DLAS unsigned short*)(lds + L_AIMG + img_off64(row, col)) = (unsigned short)(pkbf(v, 0.f) & 0xffffu); } } }
    __syncthreads();
    DN_FRESH_LANE();
    if (wave < 4) {
        const int c = 64 * wave + lane; float x[64];
#pragma unroll
        for (int i = 0; i < 64; ++i) { const float sc = (c < 128) ? SCf[64 + i] : SCf[64 + i] * SCf[128 + i]; x[i] = *(const DLAS float*)(lds + L_RHS + (i * 256 + c) * 4) * sc; }
        __syncthreads();
#pragma unroll
        for (int i = 1; i < 64; ++i) { float s0 = 0.f, s1 = 0.f, s2 = 0.f, s3 = 0.f;
#pragma unroll
            for (int j4 = 0; j4 < (i + 3) / 4; ++j4) { const f32x4 a = *(const DLAS f32x4*)(lds + vz + L_AM + (i * 68 + 4 * j4) * 4);
                s0 += a.x * x[4 * j4]; s1 += a.y * x[4 * j4 + 1]; s2 += a.z * x[4 * j4 + 2]; s3 += a.w * x[4 * j4 + 3]; }
            x[i] -= (s0 + s1) + (s2 + s3); __builtin_amdgcn_sched_barrier(0); }
        if (c < 128) {
            float* up = P.U + (size_t)item * 8192 + (size_t)(c >> 5) * 2048 + (c & 31) * 16;
#pragma unroll
            for (int t = 0; t < 2; ++t)
#pragma unroll
                for (int hi = 0; hi < 2; ++hi)
#pragma unroll
                    for (int q = 0; q < 4; ++q) { const int rb = 32 * t + 8 * q + 4 * hi; *(f32x4*)(up + t * 1024 + hi * 512 + 4 * q) = (f32x4){x[rb], x[rb + 1], x[rb + 2], x[rb + 3]}; }
        } else { const int dk = c - 128;
#pragma unroll
            for (int i = 0; i < 64; ++i) *(DLAS unsigned short*)(lds + L_IMG + IMG_W + img_off128(i, dk)) = (unsigned short)(pkbf(-x[i], 0.f) & 0xffffu); }
    } else {
        __syncthreads();
        const int t = (wave - 4) * 64 + lane;
        { const int i = t >> 2, d0 = (t & 3) * 32; const float sc = QSCALE * SCf[128 + i];
#pragma unroll
          for (int g8 = 0; g8 < 4; ++g8) { const u32x4 qv = *(const DLAS u32x4*)(lds + L_QB + i * 272 + (d0 + 8 * g8) * 2);
              u32x2 lo, hi2; lo.x = pkbf(bfl(qv.x) * sc, bfh(qv.x) * sc); lo.y = pkbf(bfl(qv.y) * sc, bfh(qv.y) * sc); hi2.x = pkbf(bfl(qv.z) * sc, bfh(qv.z) * sc); hi2.y = pkbf(bfl(qv.w) * sc, bfh(qv.w) * sc);
              *(DLAS u32x2*)(lds + L_IMG + IMG_Q + img_off128(i, d0 + 8 * g8)) = lo; *(DLAS u32x2*)(lds + L_IMG + IMG_Q + img_off128(i, d0 + 8 * g8 + 4)) = hi2; } }
        { const int d = t >> 1, g0 = (t & 1) * 8;
#pragma unroll
          for (int g = 0; g < 8; ++g) { const int c0 = 4 * (g0 + g); float v[4];
#pragma unroll
              for (int e = 0; e < 4; ++e) v[e] = bfl((unsigned)*(const DLAS unsigned short*)(lds + L_KB + (c0 + e) * 272 + d * 2)) * SCf[192 + c0 + e];
              u32x2 w; w.x = pkbf(v[0], v[1]); w.y = pkbf(v[2], v[3]); *(DLAS u32x2*)(lds + L_IMG + IMG_K + img_off64(d, c0)) = w; } }
    }
    __syncthreads();
    DN_FRESH_LANE();
    { const int t = wave * 64 + lane; unsigned char* dst = P.PREP + (size_t)item * IMG_BYTES;
#pragma unroll
      for (int p = 0; p < 6; ++p) *(u32x4*)(dst + (p * 512 + t) * 16) = *(const DLAS u32x4*)(lds + L_IMG + (p * 512 + t) * 16);
      *(u32x4*)(dst + IMG_A + t * 16) = *(const DLAS u32x4*)(lds + L_AIMG + t * 16); }
    __syncthreads();
}
struct RecArgs { const unsigned char* PREP; const float* U; const float* CD; const bf16* DZ; const float* onw; bf16* OD; };
constexpr int R_IMG0 = 0, R_IMG1 = IMG_BYTES, R_OB = 2 * IMG_BYTES, R_BYTES = R_OB + 64 * 128 * 4;
#define DN_BAR() do { asm volatile("s_waitcnt vmcnt(0) lgkmcnt(0)" ::: "memory"); __builtin_amdgcn_s_barrier(); asm volatile("" ::: "memory"); } while (0)
__device__ __forceinline__ bf16x8 pack8(const f32x16& v, int s) { u32x4 w; w.x = pkbf(v[8 * s], v[8 * s + 1]); w.y = pkbf(v[8 * s + 2], v[8 * s + 3]); w.z = pkbf(v[8 * s + 4], v[8 * s + 5]); w.w = pkbf(v[8 * s + 6], v[8 * s + 7]); return __builtin_bit_cast(bf16x8, w); }
__device__ __forceinline__ void rec_load_images(DLAS unsigned char* dst, const unsigned char* src, int t256) {
#pragma unroll
    for (int p = 0; p < 14; p += 7) { u32x4 v[7];
#pragma unroll
        for (int q = 0; q < 7; ++q) v[q] = *(const u32x4*)(src + ((p + q) * 256 + t256) * 16);
#pragma unroll
        for (int q = 0; q < 7; ++q) *(DLAS u32x4*)(dst + ((p + q) * 256 + t256) * 16) = v[q]; }
}
__device__ __forceinline__ void rec_finalize(const DLAS unsigned char* lds, const RecArgs& A, int b, int h, int n, int t256) {
    const int row = t256 >> 2, c0 = (t256 & 3) * 32; const size_t grow = (size_t)b * LP + 64 * n + row;
    const DLAS float* op = (const DLAS float*)(lds + R_OB) + row * 128 + c0; float v[32]; float ss = 0.f;
#pragma unroll
    for (int q = 0; q < 8; ++q) { const f32x4 t = *(const DLAS f32x4*)(op + 4 * q); v[4 * q] = t.x; v[4 * q + 1] = t.y; v[4 * q + 2] = t.z; v[4 * q + 3] = t.w; ss += (t.x * t.x + t.y * t.y) + (t.z * t.z + t.w * t.w); }
    ss += __shfl_xor(ss, 1); ss += __shfl_xor(ss, 2);
    const float rs = rsqrtf(ss * (1.f / 128.f) + EPS);
    const bf16* zp = A.DZ + grow * 512 + h * 128 + c0; bf16* dst = A.OD + grow * 1024 + 512 + h * 128 + c0;
#pragma unroll
    for (int q = 0; q < 4; ++q) { const u32x4 z = *(const u32x4*)(zp + 8 * q); const f32x4 w0 = *(const f32x4*)(A.onw + c0 + 8 * q), w1 = *(const f32x4*)(A.onw + c0 + 8 * q + 4); float zz[8] = {bfl(z.x), bfh(z.x), bfl(z.y), bfh(z.y), bfl(z.z), bfh(z.z), bfl(z.w), bfh(z.w)}; float r[8];
#pragma unroll
        for (int e = 0; e < 8; ++e) { const float wv = e < 4 ? w0[e] : w1[e - 4]; r[e] = v[8 * q + e] * rs * wv * (zz[e] / (1.f + __expf(-zz[e]))); }
        u32x4 o; o.x = pkbf(r[0], r[1]); o.y = pkbf(r[2], r[3]); o.z = pkbf(r[4], r[5]); o.w = pkbf(r[6], r[7]); *(u32x4*)(dst + 8 * q) = o; }
}
__device__ __forceinline__ void rec_chain(DLAS unsigned char* lds, const RecArgs& A, int bh, int wave, int lane) {
    const int b = bh >> 2, h = bh & 3;
    if (wave >= 4) {
        const int t256 = (wave - 4) * 64 + lane;
        rec_load_images(lds + R_IMG1, A.PREP + (size_t)(bh * NCH + 1) * IMG_BYTES, t256);
        DN_BAR();
        for (int n = 1; n < NCH; ++n) {
            if (n + 1 < NCH) rec_load_images(lds + ((n + 1) & 1 ? R_IMG1 : R_IMG0), A.PREP + (size_t)(bh * NCH + n + 1) * IMG_BYTES, t256);
            if (n > 1) rec_finalize(lds, A, b, h, n - 1, t256);
            DN_BAR();
            DN_BAR();
        }
        rec_finalize(lds, A, b, h, NCH - 1, t256);
    } else {
        const int m = lane & 31, hh = lane >> 5;
        f32x16 S[4]; bf16x8 Sb[8];
#pragma unroll
        for (int d = 0; d < 4; ++d) S[d] = f32x16{};
#pragma unroll
        for (int s = 0; s < 8; ++s) Sb[s] = bf16x8{};
        DN_BAR();
        for (int n = 1; n < NCH; ++n) {
            const DLAS unsigned char* img = lds + ((n & 1) ? R_IMG1 : R_IMG0);
            const float* up = A.U + (size_t)(bh * NCH + n) * 8192 + wave * 2048 + lane * 16; const float cd = A.CD[bh * NCH + n];
            f32x16 vn[2], o[2];
#pragma unroll
            for (int t = 0; t < 2; ++t) { const f32x4 a = *(const f32x4*)(up + t * 1024), bq = *(const f32x4*)(up + t * 1024 + 4), c = *(const f32x4*)(up + t * 1024 + 8), d = *(const f32x4*)(up + t * 1024 + 12);
                vn[t] = (f32x16){a.x, a.y, a.z, a.w, bq.x, bq.y, bq.z, bq.w, c.x, c.y, c.z, c.w, d.x, d.y, d.z, d.w}; o[t] = f32x16{}; }
#pragma unroll
            for (int s = 0; s < 8; ++s)
#pragma unroll
                for (int t = 0; t < 2; ++t) { const int row = 32 * t + m; const int off = row * 256 + (((2 * s + hh) ^ (row & 15)) << 4);
                    vn[t] = __builtin_amdgcn_mfma_f32_32x32x16_bf16(*(const DLAS bf16x8*)(img + IMG_W + off), Sb[s], vn[t], 0, 0, 0);
                    o[t] = __builtin_amdgcn_mfma_f32_32x32x16_bf16(*(const DLAS bf16x8*)(img + IMG_Q + off), Sb[s], o[t], 0, 0, 0); }
            bf16x8 vb[4];
#pragma unroll
            for (int t = 0; t < 2; ++t) { vb[2 * t] = pack8(vn[t], 0); vb[2 * t + 1] = pack8(vn[t], 1); }
#pragma unroll
            for (int s = 0; s < 4; ++s)
#pragma unroll
                for (int t = 0; t < 2; ++t) { const int row = 32 * t + m; const int off = row * 128 + (((2 * s + hh) ^ ((row >> 1) & 7)) << 4);
                    o[t] = __builtin_amdgcn_mfma_f32_32x32x16_bf16(*(const DLAS bf16x8*)(img + IMG_A + off), vb[s], o[t], 0, 0, 0); }
#pragma unroll
            for (int d = 0; d < 4; ++d) { S[d] = S[d] * cd;
#pragma unroll
                for (int s = 0; s < 4; ++s) { const int row = 32 * d + m; const int off = row * 128 + (((2 * s + hh) ^ ((row >> 1) & 7)) << 4);
                    S[d] = __builtin_amdgcn_mfma_f32_32x32x16_bf16(*(const DLAS bf16x8*)(img + IMG_K + off), vb[s], S[d], 0, 0, 0); } }
#pragma unroll
            for (int d = 0; d < 4; ++d) { Sb[2 * d] = pack8(S[d], 0); Sb[2 * d + 1] = pack8(S[d], 1); }
            DN_BAR();
            { DLAS float* ob = (DLAS float*)(lds + R_OB) + 32 * wave + m;
#pragma unroll
              for (int t = 0; t < 2; ++t)
#pragma unroll
                  for (int r = 0; r < 16; ++r) ob[(32 * t + (r & 3) + 8 * (r >> 2) + 4 * hh) * 128] = o[t][r]; }
            DN_BAR();
        }
    }
}
}

struct EpiG1 { static constexpr bool PERM = true, AFTER_DRAIN = false;
    bf16 *OD, *FK, *FV, *DQKV, *DZ;
    __device__ __forceinline__ void operator()(const pg8::f32x4 (&acc)[2][2][4][2], const pg8::Unit& u, int wr, int wc, int fr, int fq) const {
        const int pn = u.pn; bf16* base; int ldc, colt; float sc = 1.f;
        if (pn < 2) { base = OD; ldc = 1024; colt = pn * 256; sc = C2; }
        else if (pn < 4) { base = FK; ldc = 512; colt = (pn - 2) * 256; }
        else if (pn < 6) { base = FV; ldc = 512; colt = (pn - 4) * 256; }
        else if (pn < 12) { base = DQKV; ldc = 1536; colt = (pn - 6) * 256; }
        else { base = DZ; ldc = 512; colt = (pn - 12) * 256; }
        const int row0 = u.pm * 256 + wr * 64 + fr, col0 = colt + wc * 32 + 8 * fq;
#pragma unroll
        for (int ai = 0; ai < 2; ++ai)
#pragma unroll
            for (int m = 0; m < 4; ++m) { bf16* rowp = base + (size_t)(row0 + ai * 128 + m * 16) * ldc + col0;
#pragma unroll
                for (int bj = 0; bj < 2; ++bj) { const pg8::f32x4 v0 = acc[ai][bj][m][0] * sc, v1 = acc[ai][bj][m][1] * sc; pg8::u32x4 w;
                    w.x = pg8::cvt_pk_bf16(v0[0], v0[1]); w.y = pg8::cvt_pk_bf16(v0[2], v0[3]); w.z = pg8::cvt_pk_bf16(v1[0], v1[1]); w.w = pg8::cvt_pk_bf16(v1[2], v1[3]);
                    *(pg8::u32x4*)(rowp + bj * 128) = w; } }
    }
};
struct SchedG1 { int c, G; const char* A; const char* B;
    __device__ __forceinline__ bool next(int i, pg8::Unit& u) const { int pm, pn; if (!pg8::static_tile(R / 256, 14, G, c, i, pm, pn)) return false;
        u.pm = pm; u.pn = pn; u.sub = 0; u.nt = 16; u.A = A + (size_t)pm * 256 * 1024 * 2; u.B = B + (size_t)pn * 256 * 1024 * 2; return true; }
    __device__ __forceinline__ void a_ready(const pg8::Unit&) const {}
    __device__ __forceinline__ void done(const pg8::Unit&) const {}
};

#define LAS __attribute__((address_space(3)))
typedef float f32x4 __attribute__((ext_vector_type(4)));
typedef unsigned v4u __attribute__((ext_vector_type(4)));
constexpr int NWAVES = 8, MISC_OFF = 147456, LDS_BYTES = MISC_OFF + 256;
#ifndef PROBE_SYNC
#define PROBE_SYNC 0
#endif
#ifndef PROBE_REP
#define PROBE_REP 0
#endif
#define LDS_WAIT() asm volatile("s_waitcnt lgkmcnt(0)" ::: "memory")
__device__ __forceinline__ unsigned pk2(float lo, float hi) { return f2bf(lo) | (f2bf(hi) << 16); }
__device__ __forceinline__ float wave_sum(float v) {
#pragma unroll
    for (int o = 1; o < 64; o <<= 1) v += __shfl_xor(v, o);
    return v;
}
__device__ __forceinline__ float fsigmoid(float x) { return __builtin_amdgcn_rcpf(1.f + __builtin_amdgcn_exp2f(-LOG2E * x)); }
__device__ __forceinline__ int nat_row0(int pm) { return (pm >> 4) * LP + 128 + (pm & 15) * 256; }
struct EpiBr { static constexpr bool PERM = true, AFTER_DRAIN = false;
    bf16* S; bf16* Y;
    __device__ __forceinline__ void operator()(const pg8::f32x4 (&acc)[2][2][4][2], const pg8::Unit& u, int wr, int wc, int fr, int fq) const {
        v4u* Sg = (v4u*)S + ((wr * 4 + wc) * 64 + fq * 16 + fr); const int sub = u.sub;
        const int row0 = u.pm * 256 + wr * 64 + fr, col0 = u.pn * 256 + wc * 32 + 8 * fq;
#pragma unroll
        for (int ai = 0; ai < 2; ++ai)
#pragma unroll
            for (int m = 0; m < 4; ++m)
#pragma unroll
                for (int bj = 0; bj < 2; ++bj) { const int idx = ((ai * 4 + m) * 2 + bj) * 512; const pg8::f32x4 v0 = acc[ai][bj][m][0], v1 = acc[ai][bj][m][1];
                    if ((sub & 1) == 0) { v4u w; w.x = pg8::cvt_pk_bf16(fsigmoid(v0[0]), fsigmoid(v0[1])); w.y = pg8::cvt_pk_bf16(fsigmoid(v0[2]), fsigmoid(v0[3]));
                        w.z = pg8::cvt_pk_bf16(fsigmoid(v1[0]), fsigmoid(v1[1])); w.w = pg8::cvt_pk_bf16(fsigmoid(v1[2]), fsigmoid(v1[3])); Sg[idx] = w; }
                    else { const v4u s = Sg[idx]; bf16* yp = Y + (size_t)(row0 + ai * 128 + m * 16) * 1024 + col0 + bj * 128;
                        float t[8]; t[0] = __builtin_bit_cast(float, s.x << 16) * v0[0]; t[1] = __builtin_bit_cast(float, s.x & 0xffff0000u) * v0[1]; t[2] = __builtin_bit_cast(float, s.y << 16) * v0[2]; t[3] = __builtin_bit_cast(float, s.y & 0xffff0000u) * v0[3];
                        t[4] = __builtin_bit_cast(float, s.z << 16) * v1[0]; t[5] = __builtin_bit_cast(float, s.z & 0xffff0000u) * v1[1]; t[6] = __builtin_bit_cast(float, s.w << 16) * v1[2]; t[7] = __builtin_bit_cast(float, s.w & 0xffff0000u) * v1[3];
                        if (sub == 3) { const v4u y = *(const v4u*)yp; t[0] += __builtin_bit_cast(float, y.x << 16); t[1] += __builtin_bit_cast(float, y.x & 0xffff0000u); t[2] += __builtin_bit_cast(float, y.y << 16); t[3] += __builtin_bit_cast(float, y.y & 0xffff0000u);
                            t[4] += __builtin_bit_cast(float, y.z << 16); t[5] += __builtin_bit_cast(float, y.z & 0xffff0000u); t[6] += __builtin_bit_cast(float, y.w << 16); t[7] += __builtin_bit_cast(float, y.w & 0xffff0000u); }
                        v4u w; w.x = pg8::cvt_pk_bf16(t[0], t[1]); w.y = pg8::cvt_pk_bf16(t[2], t[3]); w.z = pg8::cvt_pk_bf16(t[4], t[5]); w.w = pg8::cvt_pk_bf16(t[6], t[7]); *(v4u*)yp = w; } }
    }
};
struct SchedBr { int c, G; const char *HN, *OD, *WG, *WB;
    __device__ __forceinline__ bool next(int i, pg8::Unit& u) const { int pm, pn; if (!pg8::static_tile(64, 4, G, c, i >> 2, pm, pn)) return false;
        const int sub = i & 3; u.pm = pm; u.pn = pn; u.sub = sub; const size_t arow = (size_t)nat_row0(pm) * 2048;
        if ((sub & 1) == 0) { u.nt = 16; u.A = HN + arow; u.B = WG + (size_t)((sub >> 1) * 1024 + pn * 256) * 2048; }
        else { u.nt = 8; u.A = OD + arow + (sub >> 1) * 1024; u.B = WB + (size_t)(pn * 256) * 2048 + (sub >> 1) * 1024; }
        return true; }
    __device__ __forceinline__ void a_ready(const pg8::Unit&) const {}
    __device__ __forceinline__ void done(const pg8::Unit&) const {}
};
struct SchedStd { int c, G, nM, nN, nt; const char* A; const char* B; size_t astep, bstep;
    __device__ __forceinline__ bool next(int i, pg8::Unit& u) const { int pm, pn; if (!pg8::static_tile(nM, nN, G, c, i, pm, pn)) return false;
        u.pm = pm; u.pn = pn; u.sub = 0; u.nt = nt; u.A = A + (size_t)pm * astep; u.B = B + (size_t)pn * bstep; return true; }
    __device__ __forceinline__ void a_ready(const pg8::Unit&) const {}
    __device__ __forceinline__ void done(const pg8::Unit&) const {}
};
struct EpiRes { static constexpr bool PERM = false, AFTER_DRAIN = true;
    const float* base; float* out; bf16* HB; float* SS;
    __device__ __forceinline__ void fused(pg8::f32x4 (&acc)[2][2][4][2], const pg8::Unit& u, int wr, int wc, int fr, int fq, PG8_LAS unsigned char* lds, int wid, int lane) const {
        LAS float* P = (LAS float*)lds; const int col0 = u.pn * 256 + wc * 32 + 4 * fq;
#pragma unroll
        for (int ai = 0; ai < 2; ++ai)
#pragma unroll
            for (int m = 0; m < 4; ++m) { const int r = ai * 128 + wr * 64 + m * 16 + fr; const size_t off = (size_t)(u.pm * 256 + r) * 1024 + col0; float s = 0.f;
#pragma unroll
                for (int bj = 0; bj < 2; ++bj)
#pragma unroll
                    for (int n = 0; n < 2; ++n) { const pg8::f32x4 h = *(const pg8::f32x4*)(base + off + bj * 128 + n * 16) + acc[ai][bj][m][n];
                        *(pg8::f32x4*)(out + off + bj * 128 + n * 16) = h; s += (h[0] * h[0] + h[1] * h[1]) + (h[2] * h[2] + h[3] * h[3]);
                        if (HB) { unsigned long long w = (unsigned long long)pg8::cvt_pk_bf16(h[0], h[1]) | ((unsigned long long)pg8::cvt_pk_bf16(h[2], h[3]) << 32); *(unsigned long long*)(HB + off + bj * 128 + n * 16) = w; } }
                s += __shfl_xor(s, 16); s += __shfl_xor(s, 32);
                if (fq == 0) P[r * 4 + wc] = s; }
        asm volatile("s_waitcnt lgkmcnt(0)" ::: "memory"); __builtin_amdgcn_s_barrier(); asm volatile("" ::: "memory");
        const int t = wid * 64 + lane; if (t < 256) SS[(size_t)u.pn * RT + u.pm * 256 + t] = (P[t * 4] + P[t * 4 + 1]) + (P[t * 4 + 2] + P[t * 4 + 3]);
    }
};
struct EpiGU { static constexpr bool PERM = true, AFTER_DRAIN = false;
    const float* SS; bf16* HID;
    __device__ __forceinline__ void operator()(const pg8::f32x4 (&acc)[2][2][4][2], const pg8::Unit& u, int wr, int wc, int fr, int fq) const {
        const int row0 = u.pm * 256 + wr * 64 + fr, col0 = u.pn * 128 + wc * 32 + 8 * fq;
#pragma unroll
        for (int ai = 0; ai < 2; ++ai)
#pragma unroll
            for (int m = 0; m < 4; ++m) { const int row = row0 + ai * 128 + m * 16;
                const float rs = rsqrtf(((SS[row] + SS[RT + row]) + (SS[2 * RT + row] + SS[3 * RT + row])) * (1.f / DM) + EPS); float h[8];
#pragma unroll
                for (int n = 0; n < 2; ++n)
#pragma unroll
                    for (int e = 0; e < 4; ++e) { const float g = acc[ai][0][m][n][e] * rs, up = acc[ai][1][m][n][e] * rs; h[4 * n + e] = g * fsigmoid(g) * up; }
                v4u w; w.x = pg8::cvt_pk_bf16(h[0], h[1]); w.y = pg8::cvt_pk_bf16(h[2], h[3]); w.z = pg8::cvt_pk_bf16(h[4], h[5]); w.w = pg8::cvt_pk_bf16(h[6], h[7]);
                *(v4u*)(HID + (size_t)row * DFF + col0) = w; }
    }
};
#define XB_TMO      128
#define XB_XCNT(j)  (256  + 64 * (j))
#define XB_XSUB(j)  (1280 + 64 * (j))
#define XB_XGEN(j)  (2304 + 64 * (j))
#define XB_TOP      3328
#define XB_TOPGEN   3392
#define XCD_BAR_WORDS 3456
#define XB_SPIN_CAP (1u << 18)

__device__ __forceinline__ unsigned xb_ld(unsigned* p)              { return __hip_atomic_load(p, __ATOMIC_RELAXED, __HIP_MEMORY_SCOPE_AGENT); }
__device__ __forceinline__ unsigned xb_add(unsigned* p, unsigned v) { return __hip_atomic_fetch_add(p, v, __ATOMIC_RELAXED, __HIP_MEMORY_SCOPE_AGENT); }
__device__ __forceinline__ unsigned xb_xcc_id() { return (unsigned)__builtin_amdgcn_s_getreg((3 << 11) | 20) & 0xFu; }
#define XB_SPIN(cond, bar) do { unsigned _sp = 0; while (cond) { __builtin_amdgcn_s_sleep(1); \
    if ((++_sp & 255u) == 0u) { if (xb_ld(&(bar)[XB_TMO])) break; if (_sp > XB_SPIN_CAP) { atomicAdd(&(bar)[XB_TMO], 1u); break; } } } } while (0)

struct XcdBarrier {
    unsigned* bar; unsigned x;
    volatile LAS unsigned* st;
};

__device__ __forceinline__ XcdBarrier xcd_barrier_post(unsigned* bar, volatile LAS unsigned* st, bool t0) {
    XcdBarrier b; b.bar = bar; b.x = xb_xcc_id(); b.st = st;
    if (t0) (void)xb_add(&bar[XB_XCNT(b.x)], 1u);
    return b;
}
__device__ __forceinline__ void xcd_barrier_complete(unsigned* bar, unsigned x, unsigned& nloc, unsigned& nx) {
    const unsigned G = gridDim.x * gridDim.y * gridDim.z;
    unsigned sum, cnt, mine, sp = 0u;
    for (;;) {
        sum = 0u; cnt = 0u; mine = 0u;
#pragma unroll
        for (unsigned j = 0; j < 16; ++j) { const unsigned c = xb_ld(&bar[XB_XCNT(j)]); sum += c; cnt += (c > 0u) ? 1u : 0u; mine = (j == x) ? c : mine; }
        if (sum == G) break;
        __builtin_amdgcn_s_sleep(1);
        if ((++sp & 255u) == 0u) { if (xb_ld(&bar[XB_TMO])) break; if (sp > XB_SPIN_CAP) { atomicAdd(&bar[XB_TMO], 1u); break; } }
    }
    nloc = mine > 0u ? mine : 1u; nx = cnt > 0u ? cnt : 1u;
}

__device__ __forceinline__ void xcd_barrier(const XcdBarrier& b, bool t0) {
    asm volatile("s_waitcnt vmcnt(0)" ::: "memory");
    __syncthreads();
    if (t0) {
        unsigned* bar = b.bar;
        __builtin_amdgcn_s_waitcnt(0);
        unsigned nloc = b.st[0], nx = b.st[1];
        if (nloc == 0u) { xcd_barrier_complete(bar, b.x, nloc, nx); b.st[0] = nloc; b.st[1] = nx; }
        const unsigned old = xb_add(&bar[XB_XSUB(b.x)], 1u);
        const unsigned gen = old / nloc;
        if (old + 1u == (gen + 1u) * nloc) {
            __builtin_amdgcn_fence(__ATOMIC_RELEASE, "agent");
            asm volatile("s_waitcnt vmcnt(0)" ::: "memory");
            const unsigned og = xb_add(&bar[XB_TOP], 1u);
            const unsigned tg = og / nx;
            if (og + 1u == (tg + 1u) * nx) xb_add(&bar[XB_TOPGEN], 1u);
            else XB_SPIN(xb_ld(&bar[XB_TOPGEN]) == tg, bar);
            __builtin_amdgcn_fence(__ATOMIC_ACQUIRE, "agent");
            xb_add(&bar[XB_XGEN(b.x)], 1u);
            asm volatile("s_waitcnt vmcnt(0)" ::: "memory");
        } else {
            XB_SPIN(xb_ld(&bar[XB_XGEN(b.x)]) == gen, bar);
            __builtin_amdgcn_fence(__ATOMIC_ACQUIRE, "agent");
            asm volatile("s_waitcnt vmcnt(0)" ::: "memory");
        }
    }
    __syncthreads();
}


struct Args { const float* in[17]; float* out; unsigned char* ws; int ph_lo, ph_hi; };

__device__ __forceinline__ void p0_transpose_item(const float* __restrict__ W, int srcN, int col0, int k0, bf16* __restrict__ WT, int drow0, int ldk, int koff, const float* __restrict__ scale, LAS float* scr, int lane) {
#pragma unroll 8
    for (int i = 0; i < 32; ++i) { const int kk = 2 * i + (lane >> 5); float v = W[(size_t)(k0 + kk) * srcN + col0 + (lane & 31)]; if (scale) v *= scale[k0 + kk]; scr[kk * 33 + (lane & 31)] = v; }
    LDS_WAIT(); asm volatile("" ::: "memory");
    const int c = lane & 7;
#pragma unroll
    for (int j = 0; j < 4; ++j) { const int n = (lane >> 3) + 8 * j; const LAS float* s = scr + (8 * c) * 33 + n;
        v4u o; o.x = pk2(s[0 * 33], s[1 * 33]); o.y = pk2(s[2 * 33], s[3 * 33]); o.z = pk2(s[4 * 33], s[5 * 33]); o.w = pk2(s[6 * 33], s[7 * 33]);
        *(v4u*)(WT + (size_t)(drow0 + n) * ldk + koff + k0 + 8 * c) = o; }
    LDS_WAIT(); asm volatile("" ::: "memory");
}
__device__ __forceinline__ bool p0_mat(int& r, const float* W, int srcN, int col0, int Ncols, int K, bf16* WT, int drow0, int ldk, int koff, const float* scale, int rowmode, LAS float* scr, int lane) {
    const int nblk = Ncols / 32, nitems = (K / 64) * nblk;
    if (r >= nitems) { r -= nitems; return false; }
    const int kb = r / nblk, nb = r % nblk, n0 = 32 * nb;
    const int dr = rowmode == 0 ? drow0 + n0 : ((n0 >> 7) * 256 + (n0 & 127) + (rowmode == 2 ? 128 : 0));
    p0_transpose_item(W, srcN, col0 + n0, 64 * kb, WT, dr, ldk, koff, scale, scr, lane); return true;
}

__global__ void __launch_bounds__(NWAVES * 64, 2) mega(Args args) {
    extern __shared__ __attribute__((aligned(16))) unsigned char lds_raw[];
    cg::grid_group grid = cg::this_grid();
    LAS unsigned char* lds = (LAS unsigned char*)lds_raw;
#define FRESH_TID() int lane = lane_id(); asm volatile("" : "+v"(lane)); const int wave = wave_s, tid = wave * 64 + lane; (void)tid
    const int wave_s = __builtin_amdgcn_readfirstlane((int)threadIdx.x >> 6);
    const int G = gridDim.x, bx = blockIdx.x;
    const int vcu = (G % 8 == 0) ? (bx % 8) * (G / 8) + bx / 8 : bx;
    unsigned char* ws = args.ws;
    const float* x = args.in[0]; const float* meta = args.in[1]; const float* mix_nw = args.in[2]; const float* w_in = args.in[3];
    const float* fbias = args.in[4]; const float* a_log = args.in[6]; const float* dt_bias = args.in[7];
    const float* wbf = args.in[9]; const float* wbd = args.in[10]; const float* wout = args.in[11];
    const float* ffn_nw = args.in[12]; const float* wg = args.in[13]; const float* wu = args.in[14]; const float* wd = args.in[15];
    float *CQ = (float*)(ws + WS_CQ), *GG = (float*)(ws + WS_GG), *BT = (float*)(ws + WS_BT), *LF = (float*)(ws + WS_LF);
    bf16 *WIN = (bf16*)(ws + WS_WIN), *WG = (bf16*)(ws + WS_WG), *WB = (bf16*)(ws + WS_WB), *WOUT = (bf16*)(ws + WS_WOUT), *WGU = (bf16*)(ws + WS_WGU), *WDN = (bf16*)(ws + WS_WDN);
    bf16 *HN = (bf16*)(ws + WS_HN), *OD = (bf16*)(ws + WS_OD), *FK = (bf16*)(ws + WS_FK), *FV = (bf16*)(ws + WS_FV), *DQKV = (bf16*)(ws + WS_DQKV), *DZ = (bf16*)(ws + WS_DZ), *Y = (bf16*)(ws + WS_Y), *HID = (bf16*)(ws + WS_HID), *H1B = HN;
    float *SS1 = (float*)(ws + WS_SS1), *SS2 = (float*)(ws + WS_SS2);
    const int lo = args.ph_lo, hi = args.ph_hi;
    if (hi < 0) grid.sync();
    { int l0 = lane_id(); if (wave_s == 0 && l0 < 64) ((volatile LAS unsigned*)(lds + MISC_OFF))[l0] = 0u; }
    __syncthreads();
    const XcdBarrier xbar = xcd_barrier_post((unsigned*)(ws + WS_BAR), (volatile LAS unsigned*)(lds + MISC_OFF), wave_s == 0 && lane_id() == 0);
#define GRID_SYNC() xcd_barrier(xbar, wave_s == 0 && lane_id() == 0)
#define IN(k) (lo <= (k) && (k) < hi)
#define BOTH(k) (IN(k) && IN((k) + 1))

    if (IN(0)) {
        FRESH_TID();
        const int gw = vcu * NWAVES + wave, NGW = G * NWAVES;
        { LAS float* scr = (LAS float*)(lds + wave * 16384);
          constexpr int NITEMS = 16 * 112 + 16 * 64 + 2 * 8 * 32 + 16 * 32 + 2 * 16 * 88 + 44 * 32;
          for (int it = gw; it < NITEMS; it += NGW) { int r = it;
            if (p0_mat(r, w_in, DIN, 0, 1536, 1024, WIN, 0, 1024, 0, nullptr, 0, scr, lane)) continue;
            if (p0_mat(r, w_in, DIN, 1544, 1536, 1024, WIN, 1536, 1024, 0, nullptr, 0, scr, lane)) continue;
            if (p0_mat(r, w_in, DIN, 3088, 512, 1024, WIN, 3072, 1024, 0, nullptr, 0, scr, lane)) continue;
            if (p0_mat(r, w_in, DIN, 3600, 2048, 1024, WG, 0, 1024, 0, nullptr, 0, scr, lane)) continue;
            if (p0_mat(r, wbf, 1024, 0, 1024, 512, WB, 0, 1024, 0, nullptr, 0, scr, lane)) continue;
            if (p0_mat(r, wbd, 1024, 0, 1024, 512, WB, 0, 1024, 512, nullptr, 0, scr, lane)) continue;
            if (p0_mat(r, wout, 1024, 0, 1024, 1024, WOUT, 0, 1024, 0, nullptr, 0, scr, lane)) continue;
            if (p0_mat(r, wg, DFF, 0, DFF, 1024, WGU, 0, 1024, 0, ffn_nw, 1, scr, lane)) continue;
            if (p0_mat(r, wu, DFF, 0, DFF, 1024, WGU, 0, 1024, 0, ffn_nw, 2, scr, lane)) continue;
            p0_mat(r, wd, 1024, 0, 1024, DFF, WDN, 0, DFF, 0, nullptr, 0, scr, lane);
          } }
        __syncthreads();
        LAS float* W16 = (LAS float*)lds;
#pragma unroll 2
        for (int i = tid; i < 1024 * 4; i += NWAVES * 64) { const int k = i >> 2, q = i & 3;
            const f32x4 v = *(const f32x4*)(w_in + (size_t)k * DIN + (q < 2 ? 1536 + 4 * q : 3080 + 4 * (q - 2)));
            *(LAS f32x4*)(W16 + ((k & 3) * 256 + (k >> 2)) * 20 + 4 * q) = v; }
        __syncthreads();
        for (int r = gw; r < R; r += NGW) {
            const int b = r / LP, pos = r % LP;
            const float* src = pos < NPAD ? nullptr : (pos < 128 ? meta + (size_t)(pos - NPAD) * DM : x + ((size_t)b * SEQ + (pos - 128)) * DM);
            f32x4 v[4]; float ss = 0.f;
#pragma unroll
            for (int j = 0; j < 4; ++j) { v[j] = src ? ((const f32x4*)src)[lane + 64 * j] : (f32x4){0.f, 0.f, 0.f, 0.f}; ss += (v[j].x * v[j].x + v[j].y * v[j].y) + (v[j].z * v[j].z + v[j].w * v[j].w); }
            const float rs = rsqrtf(wave_sum(ss) * (1.f / DM) + EPS);
            unsigned long long* o8 = (unsigned long long*)(HN + (size_t)r * DM) + lane;
            float acc[16];
#pragma unroll
            for (int c = 0; c < 16; ++c) acc[c] = 0.f;
#pragma unroll
            for (int j = 0; j < 4; ++j) { asm volatile("" ::: "memory");
                const f32x4 nwv = ((const f32x4*)mix_nw)[lane + 64 * j]; const f32x4 hn = v[j] * rs * nwv;
                o8[64 * j] = (unsigned long long)pk2(hn.x, hn.y) | ((unsigned long long)pk2(hn.z, hn.w) << 32);
#pragma unroll
                for (int e = 0; e < 4; ++e) { const LAS float* wr_ = W16 + (e * 256 + lane + 64 * j) * 20; const float he = hn[e];
#pragma unroll
                    for (int q = 0; q < 4; ++q) { const f32x4 w = *(const LAS f32x4*)(wr_ + 4 * q); acc[4 * q] += he * w.x; acc[4 * q + 1] += he * w.y; acc[4 * q + 2] += he * w.z; acc[4 * q + 3] += he * w.w; } } }
            float mine = 0.f;
#pragma unroll
            for (int c = 0; c < 16; ++c) { const float t = wave_sum(acc[c]); mine = (lane == c) ? t : mine; }
            if (lane < 16) { const bool valid = pos >= NPAD; const int j = lane;
                if (j < 8) { const float z = mine + fbias[j]; LF[(size_t)(b * 8 + j) * LP + pos] = fminf(z, 0.f) - log1pf(expf(-fabsf(z))); }
                else if (j < 12) { const int h = j - 8; BT[(size_t)(b * 4 + h) * LP + pos] = valid ? sigmoidf_(mine) : 0.f; }
                else { const int h = j - 12; const float z = mine + dt_bias[h]; const float sp = fmaxf(z, 0.f) + log1pf(expf(-fabsf(z))); GG[(size_t)(b * 4 + h) * LP + pos] = valid ? -expf(a_log[h]) * sp : 0.f; } }
        }
        if (BOTH(0)) { GRID_SYNC(); for (int e_ = 0; e_ < PROBE_SYNC; ++e_) GRID_SYNC(); }
    }
    if (IN(1)) {
        __syncthreads();
        { pg8::Gemm g{1024, 1024}; SchedG1 S{bx, G, (const char*)HN, (const char*)WIN}; EpiG1 E{OD, FK, FV, DQKV, DZ};
          pg8::gemm_phase<EpiG1, SchedG1, true, true>(lds, g, S, E, wave_s); }
        if (bx >= G - 32) {
            FRESH_TID();
            __syncthreads();
            const int bh = bx - (G - 32); LAS float* part = (LAS float*)lds;
            const float* lf = LF + (size_t)bh * LP; float* cq = CQ + (size_t)bh * LP;
            float v[9]; float run = 0.f;
#pragma unroll
            for (int e = 0; e < 9; ++e) { const int i = tid * 9 + e; const float t = (i < LP && i >= NPAD) ? lf[i] : 0.f; run += t; v[e] = run; }
            float incl = run;
#pragma unroll
            for (int o = 1; o < 64; o <<= 1) { const float t = __shfl_up(incl, o); if (lane >= o) incl += t; }
            if (lane == 63) part[wave] = incl;
            __syncthreads();
            float base = incl - run;
            for (int w = 0; w < wave; ++w) base += part[w];
#pragma unroll
            for (int e = 0; e < 9; ++e) { const int i = tid * 9 + e; if (i < LP) cq[i] = i >= NPAD ? (base + v[e]) * LOG2E : 1e30f; }
        }
        if (BOTH(1)) { GRID_SYNC(); for (int e_ = 0; e_ < PROBE_SYNC; ++e_) GRID_SYNC(); }
    }
    if (IN(2)) {
        FRESH_TID();
        __syncthreads();
        { const dn::PrepArgs P{DQKV, args.in[5], GG, BT, (unsigned char*)args.out, (float*)(ws + WS_U), (float*)(ws + WS_CD)};
          for (int it = bx; it < dn::NITEM; it += G) dn::prep_item(lds, P, it / 65, 1 + it % 65, wave, lane); }
        if (BOTH(2)) { GRID_SYNC(); for (int e_ = 0; e_ < PROBE_SYNC; ++e_) GRID_SYNC(); }
    }
    if (IN(3)) {
        __syncthreads();
        { const attn_body::AttnTensors AT{(const attn_body::bf16*)OD, (const attn_body::bf16*)FK, (const attn_body::bf16*)FV, (attn_body::bf16*)OD, CQ};
          const attn_body::StaticOrder S(G, bx);
          attn_body::attn_phase<attn_body::StaticOrder>((char*)lds_raw, AT, S, wave_s); }
        if (bx < 16) { FRESH_TID(); __syncthreads();
            const dn::RecArgs A{(const unsigned char*)args.out, (const float*)(ws + WS_U), (const float*)(ws + WS_CD), DZ, args.in[8], OD};
            dn::rec_chain(lds, A, bx, wave, lane); }
        if (BOTH(3)) { GRID_SYNC(); for (int e_ = 0; e_ < PROBE_SYNC; ++e_) GRID_SYNC(); }
    }
    if (IN(4)) {
        __syncthreads();
        { pg8::Gemm g{1024, 1024}; SchedBr S{bx, G, (const char*)HN, (const char*)OD, (const char*)WG, (const char*)WB}; EpiBr E{(bf16*)args.out + (size_t)bx * 65536, Y};
          pg8::gemm_phase<EpiBr, SchedBr, true, true>(lds, g, S, E, wave_s); }
        if (BOTH(4)) { GRID_SYNC(); for (int e_ = 0; e_ < PROBE_SYNC; ++e_) GRID_SYNC(); }
    }
    if (IN(5)) {
        __syncthreads();
        { pg8::Gemm g{1024, 1024}; SchedStd S{bx, G, 64, 4, 16, (const char*)Y, (const char*)WOUT, (size_t)256 * 1024 * 2, (size_t)256 * 1024 * 2}; EpiRes E{x, args.out, H1B, SS1};
          pg8::gemm_phase<EpiRes, SchedStd, false, true>(lds, g, S, E, wave_s); }
        if (BOTH(5)) { GRID_SYNC(); for (int e_ = 0; e_ < PROBE_SYNC; ++e_) GRID_SYNC(); }
    }
    if (IN(6)) {
        __syncthreads();
        { pg8::Gemm g{1024, 1024}; SchedStd S{bx, G, 64, 22, 16, (const char*)H1B, (const char*)WGU, (size_t)256 * 1024 * 2, (size_t)256 * 1024 * 2}; EpiGU E{SS1, HID};
          pg8::gemm_phase<EpiGU, SchedStd, true, true>(lds, g, S, E, wave_s); }
        if (BOTH(6)) { GRID_SYNC(); for (int e_ = 0; e_ < PROBE_SYNC; ++e_) GRID_SYNC(); }
    }
    if (IN(7)) {
        __syncthreads();
        { pg8::Gemm g{DFF, DFF}; SchedStd S{bx, G, 64, 4, 44, (const char*)HID, (const char*)WDN, (size_t)256 * DFF * 2, (size_t)256 * DFF * 2}; EpiRes E{args.out, args.out, nullptr, SS2};
          pg8::gemm_phase<EpiRes, SchedStd, false, true>(lds, g, S, E, wave_s); }
        if (BOTH(7)) { GRID_SYNC(); for (int e_ = 0; e_ < PROBE_SYNC; ++e_) GRID_SYNC(); }
    }
    if (IN(8)) {
        FRESH_TID();
        const int gw = vcu * NWAVES + wave, NGW = G * NWAVES; const float* fnw = args.in[16];
        for (int m = gw; m < RT; m += NGW) { f32x4* o = (f32x4*)(args.out + (size_t)m * DM) + lane;
            const float rs = rsqrtf(((SS2[m] + SS2[RT + m]) + (SS2[2 * RT + m] + SS2[3 * RT + m])) * (1.f / DM) + EPS);
#pragma unroll
            for (int j = 0; j < 4; ++j) o[64 * j] = o[64 * j] * rs * ((const f32x4*)fnw)[lane + 64 * j]; }
    }
#undef IN
#undef BOTH
}
extern "C" void kernel_launch(void* const* d_in, const int* in_sizes, int n_in, void* d_out, int out_size, void* d_ws, size_t ws_size, hipStream_t stream) {
    if (n_in != 17 || ws_size < WS_END || out_size != RT * DM) { fprintf(stderr, "kernel_launch: unexpected shapes (n_in %d, ws %zu, out %d)\n", n_in, ws_size, out_size); return; }
    static int grid = 0;
    if (grid == 0) {
        int dev = 0, cus = 0, per_cu = 0; (void)hipGetDevice(&dev); (void)hipDeviceGetAttribute(&cus, hipDeviceAttributeMultiprocessorCount, dev);
        if (hipFuncSetAttribute((const void*)mega, hipFuncAttributeMaxDynamicSharedMemorySize, LDS_BYTES) != hipSuccess) { fprintf(stderr, "kernel_launch: hipFuncSetAttribute failed\n"); grid = -1; return; }
        if (hipOccupancyMaxActiveBlocksPerMultiprocessor(&per_cu, (const void*)mega, NWAVES * 64, LDS_BYTES) != hipSuccess || per_cu < 1) { fprintf(stderr, "kernel_launch: occupancy query says %d\n", per_cu); per_cu = 1; }
        (void)hipGetLastError();
        grid = cus;
        if (grid != 256) fprintf(stderr, "kernel_launch: %d CUs (built for 256)\n", grid);
    }
    if (grid < 0) return;
    unsigned char* ws = (unsigned char*)d_ws; float* out = (float*)d_out;
    if (hipMemsetAsync((char*)d_ws + WS_BAR, 0, 16384, stream) != hipSuccess) { fprintf(stderr, "kernel_launch: memset failed\n"); return; }
    Args a{}; for (int i = 0; i < 17; ++i) a.in[i] = (const float*)d_in[i]; a.out = out; a.ws = ws; a.ph_lo = 0; a.ph_hi = 9;
    { void* params[] = {&a}; hipError_t e = hipLaunchCooperativeKernel((const void*)mega, dim3(grid), dim3(NWAVES * 64), params, LDS_BYTES, stream);
      if (e != hipSuccess) { fprintf(stderr, "kernel_launch: cooperative launch failed: %s\n", hipGetErrorString(e)); return; } }
}
```

```cpp
#include <hip/hip_runtime.h>
#include <hip/hip_cooperative_groups.h>
#include <hip/hip_bf16.h>
#include <cmath>
#include <cstdint>
#include <cstdio>

namespace cg = cooperative_groups;
typedef unsigned short bf16;
constexpr int NB = 4, SEQ = 4096, DM = 1024, LP = 4224, R = NB * LP, RT = NB * SEQ, DIN = 5648, DFF = 2816;
constexpr int NPAD = 112;
constexpr float EPS = 1e-6f;
constexpr float LOG2E = 1.4426950408889634f;
constexpr float C2 = 0.125f * LOG2E;

#ifndef PROBE_SYNC
#define PROBE_SYNC 0
#endif
#ifndef PROBE_REP
#define PROBE_REP 0
#endif
#ifndef PROBE_TS
#define PROBE_TS 0
#endif
constexpr size_t MiB = 1u << 20;
constexpr size_t WS_BAR = 0;
constexpr size_t WS_LG = 1 * MiB;
constexpr size_t WS_CQ = 2 * MiB + 256 * 1024;
constexpr size_t WS_GG = 2 * MiB + 896 * 1024;
constexpr size_t WS_BT = 3 * MiB + 256 * 1024;
constexpr size_t WS_SS1 = 3 * MiB + 512 * 1024;
constexpr size_t WS_SS2 = 3 * MiB + 768 * 1024;
constexpr size_t WS_LF = 4 * MiB;
constexpr size_t WS_WIN = 5 * MiB;
constexpr size_t WS_WG = 12 * MiB;
constexpr size_t WS_WB = 16 * MiB;
constexpr size_t WS_WOUT = 18 * MiB;
constexpr size_t WS_WGU = 20 * MiB;
constexpr size_t WS_WDN = 31 * MiB;
constexpr size_t WS_HN = 37 * MiB;
constexpr size_t WS_OD = 70 * MiB;
constexpr size_t WS_FK = 103 * MiB;
constexpr size_t WS_FV = 119 * MiB + 512 * 1024;
constexpr size_t WS_DQKV = 136 * MiB;
constexpr size_t WS_DZ = 185 * MiB + 512 * 1024;
constexpr size_t WS_CD = 1 * MiB;
constexpr size_t WS_U = 202 * MiB;
constexpr size_t WS_Y = 202 * MiB;
constexpr size_t WS_HID = 70 * MiB;
constexpr size_t WS_END = 256 * MiB;

__device__ __forceinline__ unsigned f2bf(float f) { unsigned u = __builtin_bit_cast(unsigned, f); return (u + 0x7fffu + ((u >> 16) & 1u)) >> 16; }
__device__ __forceinline__ float bf2f(bf16 b) { return __builtin_bit_cast(float, (unsigned)b << 16); }
__device__ __forceinline__ float sigmoidf_(float x) { return 1.f / (1.f + expf(-x)); }
__device__ __forceinline__ float siluf_(float x) { return x / (1.f + expf(-x)); }
__device__ __forceinline__ int lane_id() { int l; asm volatile("v_mbcnt_lo_u32_b32 %0, -1, 0\n\tv_mbcnt_hi_u32_b32 %0, -1, %0" : "=v"(l)); return l; }
__device__ __forceinline__ int nat_row(int m) { return (m >> 12) * LP + 128 + (m & 4095); }

namespace pg8 {
#define PG8_LAS __attribute__((address_space(3)))
typedef unsigned short bf16_t;
typedef short bf16x8 __attribute__((ext_vector_type(8)));
typedef float f32x4 __attribute__((ext_vector_type(4)));
typedef unsigned u32x4 __attribute__((ext_vector_type(4)));
constexpr int BM = 256, BK = 64, HALF = 128, HTB = HALF * BK * 2  , STAGE_BYTES = 8 * HTB, NXCD = 8, WGM = 8;
__host__ __device__ __forceinline__ int lds_byte(int r, int c) { const int st = (r >> 4) * 2 + (c >> 5), rr = r & 15, cc = c & 31, ob = rr * 64 + cc * 2; return st * 1024 + (ob ^ (((ob >> 9) & 1) << 5)); }
__host__ __device__ __forceinline__ void stage_rc(int b, int& R, int& C) { const int st = b / 1024, sb = b % 1024, swz = sb ^ (((sb >> 9) & 1) << 5); R = (st >> 1) * 16 + swz / 64; C = (st & 1) * 32 + (swz % 64) / 2; }
__host__ __device__ __forceinline__ int perm32(int rho) { const int n = rho >> 4, i = rho & 15; return 8 * (i >> 2) + 4 * n + (i & 3); }
struct Unit { const char* A; const char* B; int nt; int pm, pn, sub; };
struct Gemm { int lda, ldb; };
__device__ __forceinline__ bool static_tile(int nM, int nN, int G, int c, int i, int& pm, int& pn) {
    const int nwg = nM * nN; const long L = (long)i * G + c; if (L >= nwg) return false;
    int wgid = (int)L; { const int q = nwg / NXCD, r = nwg % NXCD, xcd = wgid % NXCD, off = wgid / NXCD; wgid = (xcd < r ? xcd * (q + 1) : r * (q + 1) + (xcd - r) * q) + off; }
    const int nig = WGM * nN, gid = wgid / nig, fm = gid * WGM, gsz = (nM - fm) < WGM ? (nM - fm) : WGM;
    pm = fm + ((wgid % nig) % gsz); pn = (wgid % nig) / gsz; return true;
}
__device__ __forceinline__ unsigned cvt_pk_bf16(float lo, float hi) { unsigned r; asm volatile("v_cvt_pk_bf16_f32 %0, %1, %2" : "=v"(r) : "v"(lo), "v"(hi)); return r; }
template <class Epi, class Sched, bool ALIGN_EPI = false, bool SP2 = false>
__device__ __forceinline__ void gemm_phase(PG8_LAS unsigned char* lds, const Gemm g, const Sched& S, const Epi& E, const int wave_s) {
    int lane = lane_id(); asm volatile("" : "+v"(lane)); const int wid = wave_s, tid = wid * 64 + lane, wr = wid >> 2, wc = wid & 3, fr = lane & 15, fq = lane >> 4;
    const int lda = g.lda, ldb = g.ldb;
    unsigned voffA[2], voffB[2];
#pragma unroll
    for (int i = 0; i < 2; ++i) { int R, C; stage_rc(tid * 16 + i * 8192, R, C); const int Rb = Epi::PERM ? ((R & ~31) + perm32(R & 31)) : R;
        voffA[i] = (unsigned)(R * lda + C) * 2u; voffB[i] = (unsigned)(Rb * ldb + C) * 2u; }
    const size_t kstep = (size_t)(BK * 2);
    const size_t hstepA = (size_t)HALF * lda * 2, hstepB = (size_t)HALF * ldb * 2;
    const unsigned ldsw = (unsigned)wid * 1024u;
    const int aoff = lds_byte(wr * 64 + fr, fq * 8), boff = lds_byte(wc * 32 + fr, fq * 8);
#define PG8_SA(b, h) (((b) * 2 + (h)) * HTB)
#define PG8_SB(b, h) ((4 + (b) * 2 + (h)) * HTB)
#define PG8_STAGE(bufoff, gbase, voff) do { _Pragma("unroll") for (int _i = 0; _i < 2; ++_i) \
        __builtin_amdgcn_global_load_lds((const unsigned*)((const char*)(gbase) + (voff)[_i]), (PG8_LAS unsigned*)(lds + (bufoff) + ldsw + _i * 8192), 16, 0, 0); } while (0)
#define PG8_LDA(dst, b, h) do { _Pragma("unroll") for (int m = 0; m < 4; ++m) _Pragma("unroll") for (int k = 0; k < 2; ++k) dst[m][k] = *(const PG8_LAS bf16x8*)(lds + PG8_SA(b, h) + aoff + m * 2048 + k * 1024); } while (0)
#define PG8_LDB(dst, b, h) do { _Pragma("unroll") for (int n = 0; n < 2; ++n) _Pragma("unroll") for (int k = 0; k < 2; ++k) dst[n][k] = *(const PG8_LAS bf16x8*)(lds + PG8_SB(b, h) + boff + n * 2048 + k * 1024); } while (0)
#define PG8_MMA(ai, bj, At, Bt) do { __builtin_amdgcn_s_setprio(1); _Pragma("unroll") for (int m = 0; m < 4; ++m) _Pragma("unroll") for (int n = 0; n < 2; ++n) _Pragma("unroll") for (int k = 0; k < 2; ++k) \
        acc[ai][bj][m][n] = __builtin_amdgcn_mfma_f32_16x16x32_bf16(Bt[n][k], At[m][k], acc[ai][bj][m][n], 0, 0, 0); __builtin_amdgcn_s_setprio(0); } while (0)
#define PG8_WAIT_V(n) asm volatile("s_waitcnt vmcnt(" #n ")" ::: "memory")
#define PG8_WAIT_L(n) asm volatile("s_waitcnt lgkmcnt(" #n ")" ::: "memory")
#define PG8_BAR __builtin_amdgcn_s_barrier()
#define PG8_SCHED __builtin_amdgcn_sched_barrier(0)
    Unit cur, nxt; int ui = 0;
    if (!S.next(0, cur)) return;
    f32x4 acc[2][2][4][2];
#pragma unroll
    for (int a = 0; a < 2; ++a)
#pragma unroll
        for (int b = 0; b < 2; ++b)
#pragma unroll
            for (int m = 0; m < 4; ++m)
#pragma unroll
                for (int n = 0; n < 2; ++n) acc[a][b][m][n] = (f32x4){0.f, 0.f, 0.f, 0.f};
    bf16x8 At[4][2], B0[2][2], B1[2][2];
    const char* cA = cur.A; const char* cB = cur.B;
    S.a_ready(cur);
    if constexpr (SP2) {
        PG8_STAGE(PG8_SB(0, 0), cB, voffB); PG8_STAGE(PG8_SB(0, 1), cB + hstepB, voffB); PG8_STAGE(PG8_SA(0, 0), cA, voffA); PG8_STAGE(PG8_SA(0, 1), cA + hstepA, voffA);
        if (wr == 1) PG8_BAR;
        PG8_WAIT_V(2); PG8_BAR;
        PG8_STAGE(PG8_SB(1, 0), cB + kstep, voffB); PG8_STAGE(PG8_SA(1, 0), cA + kstep, voffA); PG8_STAGE(PG8_SB(1, 1), cB + hstepB + kstep, voffB);
        PG8_WAIT_V(6); PG8_BAR;
    } else {
        PG8_STAGE(PG8_SB(0, 0), cB, voffB); PG8_STAGE(PG8_SA(0, 0), cA, voffA); PG8_STAGE(PG8_SB(0, 1), cB + hstepB, voffB); PG8_STAGE(PG8_SA(0, 1), cA + hstepA, voffA);
        if (wr == 1) PG8_BAR;
        PG8_WAIT_V(4); PG8_BAR;
        PG8_STAGE(PG8_SB(1, 0), cB + kstep, voffB); PG8_STAGE(PG8_SA(1, 0), cA + kstep, voffA); PG8_STAGE(PG8_SB(1, 1), cB + hstepB + kstep, voffB);
        PG8_WAIT_V(6); PG8_BAR;
    }
    for (;;) {
        const bool has_next = S.next(ui + 1, nxt);
        const char* nA = has_next ? nxt.A : cA; const char* nB = has_next ? nxt.B : cB;
        const int nt = cur.nt;
        for (int t = 0; t < nt; t += 2) {
            const bool last = (t == nt - 2);
            const char* a1 = cA + (size_t)(t + 1) * kstep;
            const char* a2 = last ? nA : cA + (size_t)(t + 2) * kstep; const char* b2 = last ? nB : cB + (size_t)(t + 2) * kstep;
            const char* a3 = a2 + kstep; const char* b3 = b2 + kstep;
            if (last && has_next) S.a_ready(nxt);
            if constexpr (SP2) {
            PG8_LDB(B0, 0, 0); PG8_LDB(B1, 0, 1); PG8_SCHED; PG8_LDA(At, 0, 0); PG8_STAGE(PG8_SA(1, 1), a1 + hstepA, voffA);
            PG8_WAIT_V(8); PG8_WAIT_L(0); PG8_BAR; PG8_MMA(0, 0, At, B0); PG8_MMA(0, 1, At, B1); PG8_BAR; PG8_SCHED;
            PG8_LDA(At, 0, 1); PG8_STAGE(PG8_SB(0, 0), b2, voffB); PG8_STAGE(PG8_SB(0, 1), b2 + hstepB, voffB); PG8_STAGE(PG8_SA(0, 0), a2, voffA);
            PG8_WAIT_V(8); PG8_WAIT_L(0); PG8_BAR; PG8_MMA(1, 0, At, B0); PG8_MMA(1, 1, At, B1); PG8_BAR; PG8_SCHED;
            PG8_LDB(B0, 1, 0); PG8_LDB(B1, 1, 1); PG8_SCHED; PG8_LDA(At, 1, 0); PG8_STAGE(PG8_SA(0, 1), a2 + hstepA, voffA);
            PG8_WAIT_V(8); PG8_WAIT_L(0); PG8_BAR; PG8_MMA(0, 0, At, B0); PG8_MMA(0, 1, At, B1); PG8_BAR; PG8_SCHED;
            PG8_LDA(At, 1, 1); PG8_STAGE(PG8_SB(1, 0), b3, voffB); PG8_STAGE(PG8_SB(1, 1), b3 + hstepB, voffB); PG8_STAGE(PG8_SA(1, 0), a3, voffA);
            PG8_WAIT_V(8); PG8_WAIT_L(0); PG8_BAR; PG8_MMA(1, 0, At, B0); PG8_MMA(1, 1, At, B1); PG8_BAR; PG8_SCHED;
            } else {
            PG8_LDB(B0, 0, 0); PG8_SCHED; PG8_LDA(At, 0, 0); PG8_STAGE(PG8_SA(1, 1), a1 + hstepA, voffA);
            PG8_WAIT_L(8); PG8_BAR; PG8_WAIT_L(0); PG8_MMA(0, 0, At, B0); PG8_BAR; PG8_SCHED;
            PG8_LDB(B1, 0, 1); PG8_STAGE(PG8_SB(0, 0), b2, voffB);
            PG8_BAR; PG8_WAIT_L(0); PG8_MMA(0, 1, At, B1); PG8_BAR;
            PG8_LDA(At, 0, 1); PG8_STAGE(PG8_SA(0, 0), a2, voffA);
            PG8_BAR; PG8_WAIT_L(0); PG8_MMA(1, 0, At, B0); PG8_BAR; PG8_SCHED;
            PG8_STAGE(PG8_SB(0, 1), b2 + hstepB, voffB);
            PG8_WAIT_V(6); PG8_BAR; PG8_MMA(1, 1, At, B1); PG8_BAR;
            PG8_LDB(B0, 1, 0); PG8_SCHED; PG8_LDA(At, 1, 0); PG8_STAGE(PG8_SA(0, 1), a2 + hstepA, voffA);
            PG8_WAIT_L(8); PG8_BAR; PG8_WAIT_L(0); PG8_MMA(0, 0, At, B0); PG8_BAR; PG8_SCHED;
            PG8_LDB(B1, 1, 1); PG8_STAGE(PG8_SB(1, 0), b3, voffB);
            PG8_BAR; PG8_WAIT_L(0); PG8_MMA(0, 1, At, B1); PG8_BAR;
            PG8_LDA(At, 1, 1); PG8_STAGE(PG8_SA(1, 0), a3, voffA);
            PG8_BAR; PG8_WAIT_L(0); PG8_MMA(1, 0, At, B0); PG8_BAR; PG8_SCHED;
            PG8_STAGE(PG8_SB(1, 1), b3 + hstepB, voffB);
            PG8_WAIT_V(6); PG8_BAR; PG8_MMA(1, 1, At, B1); PG8_BAR;
            }
        }
        if constexpr (ALIGN_EPI) { if (wr == 0) PG8_BAR; }
        if constexpr (!Epi::AFTER_DRAIN) { E(acc, cur, wr, wc, fr, fq); S.done(cur); }
        if (!has_next) break;
#pragma unroll
        for (int a = 0; a < 2; ++a)
#pragma unroll
            for (int b = 0; b < 2; ++b)
#pragma unroll
                for (int m = 0; m < 4; ++m)
#pragma unroll
                    for (int n = 0; n < 2; ++n) acc[a][b][m][n] = (f32x4){0.f, 0.f, 0.f, 0.f};
        cur = nxt; cA = nA; cB = nB; ++ui;
        if constexpr (ALIGN_EPI) { if (wr == 1) PG8_BAR; }
    }
    PG8_WAIT_V(0);
    if constexpr (!ALIGN_EPI) { if (wr == 0) PG8_BAR; }
    PG8_BAR;
    if constexpr (Epi::AFTER_DRAIN) { E.fused(acc, cur, wr, wc, fr, fq, lds, wid, lane); S.done(cur); }
#undef PG8_SA
#undef PG8_SB
#undef PG8_STAGE
#undef PG8_LDA
#undef PG8_LDB
#undef PG8_MMA
#undef PG8_WAIT_V
#undef PG8_WAIT_L
#undef PG8_BAR
#undef PG8_SCHED
}
}

namespace attn_body {
using bf16=__hip_bfloat16;
using bf16x8=__attribute__((ext_vector_type(8)))short;
using s16x4=__attribute__((ext_vector_type(4)))short;
using f32x16=__attribute__((ext_vector_type(16)))float;
using u32x4=__attribute__((ext_vector_type(4)))unsigned;
constexpr int BATCH=4,NHEAD=8,SEQ=4224,D=64,QP=1024,KP=512;
constexpr int NW=8,QBLK=32,QB=QBLK*NW,KVBLK=64,NQB=16;
constexpr int ATTN_UNIT_ROWS=QB;
__device__ __forceinline__ int crow(int r,int hi){return (r&3)+8*(r>>2)+4*hi;}
#define SBAR() __builtin_amdgcn_sched_barrier(0)
__device__ __forceinline__ void cmask(f32x16&p0,f32x16&p1,int jb,int qrel,int hi){
  const float NEG=-INFINITY; int kb=64*jb+4*hi;
  #pragma unroll
  for(int r=0;r<16;++r){int kv=kb+(r&3)+8*(r>>2); if(kv>qrel)p0[r]=NEG; if(kv+32>qrel)p1[r]=NEG;}
}

constexpr int NSLOT=3, SLOTB=8192;
constexpr int LDS_K=0, LDS_V=NSLOT*SLOTB, LDS_WS=2*NSLOT*SLOTB, LDS_OST=LDS_WS+NW*64*4, LDS_CT=LDS_OST+NW*4096+2048, LDS_BYTES=LDS_CT+SEQ*4;
constexpr float C2=0.125f*1.4426950408889634f;
__device__ __forceinline__ void glds16(const void*gsrc,unsigned lds_dst){unsigned keep;
  asm volatile("s_mov_b32 %0, m0\n\ts_mov_b32 m0, %2\n\ts_nop 0\n\tglobal_load_lds_dwordx4 %1, off\n\ts_mov_b32 m0, %0":"=&s"(keep):"v"(gsrc),"s"(lds_dst):"memory");}
__device__ __forceinline__ float max3f(float a,float b,float c){float r;asm("v_max3_f32 %0, %1, %2, %3":"=v"(r):"v"(a),"v"(b),"v"(c));return r;}
__device__ __forceinline__ float max2f(float a,float b){float r;asm("v_max_f32_e32 %0, %1, %2":"=v"(r):"v"(a),"v"(b));return r;}
__device__ __forceinline__ float fadd_s(float a,float b){float r;asm("v_add_f32_e32 %0, %1, %2":"=v"(r):"v"(a),"v"(b));return r;}
__device__ __forceinline__ float fsub_s(float a,float b){float r;asm("v_sub_f32_e32 %0, %1, %2":"=v"(r):"v"(a),"v"(b));return r;}
typedef float f32x2_t __attribute__((ext_vector_type(2))); typedef float f32x4_t __attribute__((ext_vector_type(4))); typedef __bf16 bf16x2_t __attribute__((ext_vector_type(2)));
__device__ __forceinline__ unsigned cvtpk_s(float lo,float hi){f32x2_t v={lo,hi};bf16x2_t b=__builtin_convertvector(v,bf16x2_t);return __builtin_bit_cast(unsigned,b);}
#define WAIT_BAR(N) asm volatile("s_waitcnt vmcnt(" #N ") lgkmcnt(0)\n\ts_barrier":::"memory")

__device__ __forceinline__ void qkt(f32x16&p0,f32x16&p1,const char*Kslot,const bf16x8*qr,const f32x16&negm,int r32,int hi){
  const char*kb=Kslot+hi*1024+r32*16;
  #pragma unroll
  for(int d0=0;d0<4;++d0){
    const bf16x8 b0=*reinterpret_cast<const bf16x8*>(kb+d0*2048);
    const bf16x8 b1=*reinterpret_cast<const bf16x8*>(kb+d0*2048+512);
    if(d0==0){p0=__builtin_amdgcn_mfma_f32_32x32x16_bf16(b0,qr[0],negm,0,0,0);p1=__builtin_amdgcn_mfma_f32_32x32x16_bf16(b1,qr[0],negm,0,0,0);}
    else{p0=__builtin_amdgcn_mfma_f32_32x32x16_bf16(b0,qr[d0],p0,0,0,0);p1=__builtin_amdgcn_mfma_f32_32x32x16_bf16(b1,qr[d0],p1,0,0,0);}}
}
typedef __attribute__((address_space(3))) const char* lds_cptr;
typedef short v4i16_t __attribute__((ext_vector_type(4)));
__device__ __forceinline__ void kload8(bf16x8*kf,lds_cptr kp){
  kf[0]=*(const __attribute__((address_space(3))) bf16x8*)(kp);      kf[1]=*(const __attribute__((address_space(3))) bf16x8*)(kp+512);
  kf[2]=*(const __attribute__((address_space(3))) bf16x8*)(kp+2048); kf[3]=*(const __attribute__((address_space(3))) bf16x8*)(kp+2560);
  kf[4]=*(const __attribute__((address_space(3))) bf16x8*)(kp+4096); kf[5]=*(const __attribute__((address_space(3))) bf16x8*)(kp+4608);
  kf[6]=*(const __attribute__((address_space(3))) bf16x8*)(kp+6144); kf[7]=*(const __attribute__((address_space(3))) bf16x8*)(kp+6656);
}
__device__ __forceinline__ void kload2(bf16x8*kf,lds_cptr kp,int j){ kf[2*j]=*(const __attribute__((address_space(3))) bf16x8*)(kp+j*2048); kf[2*j+1]=*(const __attribute__((address_space(3))) bf16x8*)(kp+j*2048+512); }
__device__ __forceinline__ s16x4 vtr(lds_cptr p){ return __builtin_bit_cast(s16x4,__builtin_amdgcn_ds_read_tr16_b64_v4i16((__attribute__((address_space(3))) v4i16_t*)p)); }
__device__ __forceinline__ float rowmax(const f32x16&p0,const f32x16&p1){
  float a=max3f(p0[0],p0[1],p1[0]),b=max3f(p0[2],p0[3],p1[1]);a=max3f(a,p1[2],p1[3]);
  #pragma unroll
  for(int r=4;r<16;r+=4){a=max3f(a,p0[r],p0[r+1]);b=max3f(b,p0[r+2],p0[r+3]);a=max3f(a,p1[r],p1[r+1]);b=max3f(b,p1[r+2],p1[r+3]);}
  const float m=max2f(a,b);
  auto rr=__builtin_amdgcn_permlane32_swap(__float_as_uint(m),__float_as_uint(m),false,false);
  return max2f(__uint_as_float(rr[0]),__uint_as_float(rr[1]));
}
__device__ __forceinline__ void pv(f32x16*o,int vb,bf16x8 pa0,bf16x8 pa1,bf16x8 pa2,bf16x8 pa3){
  #pragma unroll
  for(int d0=0;d0<2;++d0){s16x4 lo[4],hi[4];
    #pragma unroll
    for(int ks=0;ks<4;++ks){
      asm volatile("ds_read_b64_tr_b16 %0,%1 offset:%c2":"=&v"(lo[ks]):"v"(vb),"i"(d0*4096+ks*1024):"memory");
      asm volatile("ds_read_b64_tr_b16 %0,%1 offset:%c2":"=&v"(hi[ks]):"v"(vb),"i"(d0*4096+ks*1024+512):"memory");}
    asm volatile("s_waitcnt lgkmcnt(0)":::"memory");SBAR();
    #define PK(k) (bf16x8){lo[k][0],lo[k][1],lo[k][2],lo[k][3],hi[k][0],hi[k][1],hi[k][2],hi[k][3]}
    o[d0]=__builtin_amdgcn_mfma_f32_32x32x16_bf16(pa0,PK(0),o[d0],0,0,0);
    o[d0]=__builtin_amdgcn_mfma_f32_32x32x16_bf16(pa1,PK(1),o[d0],0,0,0);
    o[d0]=__builtin_amdgcn_mfma_f32_32x32x16_bf16(pa2,PK(2),o[d0],0,0,0);
    o[d0]=__builtin_amdgcn_mfma_f32_32x32x16_bf16(pa3,PK(3),o[d0],0,0,0);
    #undef PK
  }
}

#ifndef ATTN_STORE16
#define ATTN_STORE16(p,v) (*(u32x4*)(p)=(v))
#endif
template<int THRL> __device__ __forceinline__ void attn_unit(int b,int h,int qb,const bf16*Q,const bf16*__restrict__ K,const bf16*__restrict__ V,bf16*O,const float*__restrict__ CQ,char*shm,const int wave_s){
  int lane=lane_id(); asm volatile("":"+v"(lane));
  const int wid=wave_s,tid=wid*64+lane,r32=lane&31,hi=lane>>5;
  const long rowbase=(long)b*SEQ; const int q0=128+qb*QB;
  const bf16*Qw=Q+(rowbase+q0+wid*QBLK)*QP+h*D;
  const bf16*Kh=K+rowbase*KP+h*D,*Vh=V+rowbase*KP+h*D;
  const unsigned lds0=(unsigned)(uintptr_t)shm;
  float*wsf=(float*)(shm+LDS_WS)+wid*64;
  const bf16*ksrc=Kh+(long)lane*KP+wid*8;
  const bf16*vsrc=Vh+(long)(16*(wid&3)+(lane>>2))*KP+(wid>>2)*32+(lane&3)*8;
  const unsigned kdst=lds0+LDS_K+wid*1024, vdst=lds0+LDS_V+wid*1024;
  #define PT(t) (((t)<2)?((t)^1):(t))
  #define DMA_K(t,slot) glds16(ksrc+(long)PT(t)*KVBLK*KP,(unsigned)__builtin_amdgcn_readfirstlane(kdst+(slot)))
  #define DMA_V(t,slot) glds16(vsrc+(long)PT(t)*KVBLK*KP,(unsigned)__builtin_amdgcn_readfirstlane(vdst+(slot)))
  const int vb0=(int)(lds0+LDS_V)+((lane>>4)&1)*32+(lane&3)*8+(4*hi+((lane&15)>>2))*64;
  const char*Kbase=shm+LDS_K; bf16x8 kf[8];
  const lds_cptr shm3=(lds_cptr)shm; const lds_cptr kp0=shm3+LDS_K+hi*1024+r32*16; const lds_cptr vp0=shm3+LDS_V+((lane>>4)&1)*32+(lane&3)*8+(4*hi+((lane&15)>>2))*64;
  const int NT=(q0+QB)/KVBLK;
  DMA_K(0,0);DMA_V(0,0);DMA_K(1,SLOTB);
  bf16x8 qr[4];
  #pragma unroll
  for(int d0=0;d0<4;++d0)qr[d0]=*reinterpret_cast<const bf16x8*>(&Qw[(long)r32*QP+d0*16+hi*8]);
  { const float*cg=CQ+(long)(b*NHEAD+h)*SEQ; __attribute__((address_space(3))) float*ct=(__attribute__((address_space(3))) float*)((lds_cptr)shm+LDS_CT); const int ncp=q0+QB;
    for(int i=tid;i<ncp;i+=NW*64)ct[i]=cg[i]; }
  const lds_cptr ctp=(lds_cptr)shm+LDS_CT+hi*16;
  float mhat=0.f,l_reg=0.f;f32x16 o[2];o[0]=f32x16{};o[1]=f32x16{};
  const float cqp=CQ[(long)(b*NHEAD+h)*SEQ+q0+wid*QBLK+r32];
  const f32x16 negm=f32x16{};
  float base=cqp;
  const int qrel=wid*QBLK+r32;
  #define CMASK(P0,P1,t) do{int jb_=(t)-(NT-4); if(jb_>=0)cmask(P0,P1,jb_,qrel,hi);}while(0)
  bool resc=false;
  #define START(P0,P1) do{ const float rm=rowmax(P0,P1); resc=false; \
    { const float dl=rm; mhat=fadd_s(mhat,dl); \
      _Pragma("unroll") for(int r=0;r<16;++r){P0[r]=fsub_s(P0[r],dl);P1[r]=fsub_s(P1[r],dl);} \
      base=cqp-mhat; } \
    _Pragma("unroll") for(int r=0;r<16;++r)P0[r]=__builtin_amdgcn_exp2f(P0[r]); }while(0)
  #define RESC() do{ if(resc){ asm volatile("s_waitcnt lgkmcnt(0)":::"memory"); \
      _Pragma("unroll") for(int d_=0;d_<2;++d_) _Pragma("unroll") for(int r=0;r<16;++r)o[d_][r]*=wsf[crow(r,hi)]; } }while(0)
  #define CKSUB(C0,C1,t) do{ const lds_cptr cp_=ctp+256*PT(t); \
    const f32x2_t b2_={base,base}; \
    _Pragma("unroll") for(int g_=0;g_<4;++g_){ const f32x4_t a_=*(const __attribute__((address_space(3))) f32x4_t*)(cp_+32*g_); \
      f32x2_t x_={C0[4*g_],C0[4*g_+1]},y_={C0[4*g_+2],C0[4*g_+3]}; x_=(x_-(f32x2_t){a_[0],a_[1]})+b2_; y_=(y_-(f32x2_t){a_[2],a_[3]})+b2_; \
      C0[4*g_]=x_[0];C0[4*g_+1]=x_[1];C0[4*g_+2]=y_[0];C0[4*g_+3]=y_[1]; } SBAR(); \
    _Pragma("unroll") for(int g_=0;g_<4;++g_){ const f32x4_t a_=*(const __attribute__((address_space(3))) f32x4_t*)(cp_+128+32*g_); \
      f32x2_t x_={C1[4*g_],C1[4*g_+1]},y_={C1[4*g_+2],C1[4*g_+3]}; x_=(x_-(f32x2_t){a_[0],a_[1]})+b2_; y_=(y_-(f32x2_t){a_[2],a_[3]})+b2_; \
      C1[4*g_]=x_[0];C1[4*g_+1]=x_[1];C1[4*g_+2]=y_[0];C1[4*g_+3]=y_[1]; } SBAR(); }while(0)
  f32x16 pA0,pA1,pB0,pB1;
  int sl_prev=0,sl_cur=0,sl_next=SLOTB;
  #define ROT() do{sl_prev=sl_cur;sl_cur=sl_next;sl_next=(sl_next==(NSLOT-1)*SLOTB)?0:sl_next+SLOTB;}while(0)
  DMA_K(2,2*SLOTB);
  WAIT_BAR(3);
  qkt(pA0,pA1,Kbase,qr,negm,r32,hi);asm volatile("s_nop 15\n\ts_nop 7":"+v"(pA0),"+v"(pA1));CKSUB(pA0,pA1,0);CMASK(pA0,pA1,0);
  START(pA0,pA1);
  _Pragma("unroll") for(int r=0;r<16;++r)pA1[r]=__builtin_amdgcn_exp2f(pA1[r]);
  WAIT_BAR(0);
  DMA_K(3,0);DMA_V(1,SLOTB);
  ROT();
  kload8(kf,kp0+sl_cur);
  WAIT_BAR(2);
  s16x4 vlo[8],vhi[8]; u32x4 pw0,pw1,pw2,pw3;
  #define PKW(P,B) cvtpk_s(P[B],P[B+1])
  #define PAF(k) __builtin_bit_cast(bf16x8,pw##k)
  #define VFR(i) (bf16x8){vlo[i][0],vlo[i][1],vlo[i][2],vlo[i][3],vhi[i][0],vhi[i][1],vhi[i][2],vhi[i][3]}
  #define PIN(x) asm volatile("":"+v"(x))
  #define MX3(a,b,c) __builtin_fmaxf(__builtin_fmaxf((a),(b)),(c))
  #define GAPA(MF,A0,A1,A2,A3,W0,W1,PW) do{ MF; sacc+=A0; sacc+=A1; sacc+=A2; sacc+=A3; PIN(sacc); W0; W1; PIN(PW); SBAR(); }while(0)
  #define EX(v) __builtin_amdgcn_exp2f(v)
  #define GAPB(MF,X,B) do{ MF; X[B]=EX(X[B]); X[B+1]=EX(X[B+1]); X[B+2]=EX(X[B+2]); X[B+3]=EX(X[B+3]); PIN(X); SBAR(); }while(0)
  #define VRD(i) do{ vlo[i]=vtr(vp_+(((i)>>2)*4096+((i)&3)*1024)); vhi[i]=vtr(vp_+(((i)>>2)*4096+((i)&3)*1024+512)); }while(0)
  #define KRD(G,j) do{ if(G){ kload2(kf,kp0+sl_next,j); SBAR(); } }while(0)
  #define STEP(C0,C1,P0,P1,t,GK,GV,GL) do{ SBAR(); \
    const lds_cptr vp_=vp0+sl_prev; \
    VRD(0); SBAR(); float sacc=(P0[0]+P0[1]); \
    GAPA(C0=__builtin_amdgcn_mfma_f32_32x32x16_bf16(kf[0],qr[0],negm,0,0,0), P0[2],P0[3],P0[4],P0[5],     pw0[0]=PKW(P0,0), pw0[1]=PKW(P0,2), pw0); \
    VRD(4); SBAR(); GAPA(C1=__builtin_amdgcn_mfma_f32_32x32x16_bf16(kf[1],qr[0],negm,0,0,0), P0[6],P0[7],P0[8],P0[9],     pw0[2]=PKW(P0,4), pw0[3]=PKW(P0,6), pw0); \
    VRD(1); SBAR(); GAPA(C0=__builtin_amdgcn_mfma_f32_32x32x16_bf16(kf[2],qr[1],C0,0,0,0),   P0[10],P0[11],P0[12],P0[13], pw1[0]=PKW(P0,8), pw1[1]=PKW(P0,10), pw1); \
    VRD(5); SBAR(); GAPA(C1=__builtin_amdgcn_mfma_f32_32x32x16_bf16(kf[3],qr[1],C1,0,0,0),   P0[14],P0[15],P1[0],P1[1],   pw1[2]=PKW(P0,12),pw1[3]=PKW(P0,14), pw1); \
    VRD(2); SBAR(); GAPA(C0=__builtin_amdgcn_mfma_f32_32x32x16_bf16(kf[4],qr[2],C0,0,0,0),   P1[2],P1[3],P1[4],P1[5],     pw2[0]=PKW(P1,0), pw2[1]=PKW(P1,2), pw2); \
    VRD(6); SBAR(); GAPA(C1=__builtin_amdgcn_mfma_f32_32x32x16_bf16(kf[5],qr[2],C1,0,0,0),   P1[6],P1[7],P1[8],P1[9],     pw2[2]=PKW(P1,4), pw2[3]=PKW(P1,6), pw2); \
    VRD(3); SBAR(); GAPA(C0=__builtin_amdgcn_mfma_f32_32x32x16_bf16(kf[6],qr[3],C0,0,0,0),   P1[10],P1[11],P1[12],P1[13], pw3[0]=PKW(P1,8), pw3[1]=PKW(P1,10), pw3); \
    VRD(7); SBAR(); GAPA(C1=__builtin_amdgcn_mfma_f32_32x32x16_bf16(kf[7],qr[3],C1,0,0,0),   P1[14],P1[15],0.f,0.f,       pw3[2]=PKW(P1,12),pw3[3]=PKW(P1,14), pw3); \
    l_reg+=sacc; \
    if(GK){DMA_K((t)+3,sl_cur);} if(GV){DMA_V((t)+1,sl_next);} \
    CKSUB(C0,C1,t); CMASK(C0,C1,t); \
    { float a=MX3(C0[0],C0[1],C1[0]),b=MX3(C0[2],C0[3],C1[1]); a=MX3(a,C1[2],C1[3]); \
      _Pragma("unroll") for(int r=4;r<16;r+=4){a=MX3(a,C0[r],C0[r+1]);b=MX3(b,C0[r+2],C0[r+3]);a=MX3(a,C1[r],C1[r+1]);b=MX3(b,C1[r+2],C1[r+3]);} \
      float rm=__builtin_fmaxf(a,b); { auto rr=__builtin_amdgcn_permlane32_swap(__float_as_uint(rm),__float_as_uint(rm),false,false); rm=__builtin_fmaxf(__uint_as_float(rr[0]),__uint_as_float(rr[1])); } \
      resc=false; \
      if(__builtin_expect(__any(rm>(float)THRL),0)){ const float dl=__builtin_fmaxf(rm,0.f); mhat+=dl; \
        _Pragma("unroll") for(int r=0;r<16;++r){C0[r]-=dl;C1[r]-=dl;} \
        base=cqp-mhat; \
        const float f=__builtin_amdgcn_exp2f(-dl); l_reg*=f; if(hi==0)wsf[r32]=f; resc=true; } } \
    SBAR(); \
    GAPB(o[0]=__builtin_amdgcn_mfma_f32_32x32x16_bf16(PAF(0),VFR(0),o[0],0,0,0), C0,0); \
    GAPB(o[1]=__builtin_amdgcn_mfma_f32_32x32x16_bf16(PAF(0),VFR(4),o[1],0,0,0), C0,4); \
    KRD(GL,0); GAPB(o[0]=__builtin_amdgcn_mfma_f32_32x32x16_bf16(PAF(1),VFR(1),o[0],0,0,0), C0,8); \
    KRD(GL,1); GAPB(o[1]=__builtin_amdgcn_mfma_f32_32x32x16_bf16(PAF(1),VFR(5),o[1],0,0,0), C0,12); \
    KRD(GL,2); GAPB(o[0]=__builtin_amdgcn_mfma_f32_32x32x16_bf16(PAF(2),VFR(2),o[0],0,0,0), C1,0); \
    KRD(GL,3); GAPB(o[1]=__builtin_amdgcn_mfma_f32_32x32x16_bf16(PAF(2),VFR(6),o[1],0,0,0), C1,4); \
    GAPB(o[0]=__builtin_amdgcn_mfma_f32_32x32x16_bf16(PAF(3),VFR(3),o[0],0,0,0), C1,8); \
    GAPB(o[1]=__builtin_amdgcn_mfma_f32_32x32x16_bf16(PAF(3),VFR(7),o[1],0,0,0), C1,12); \
    }while(0)
  int t=1;
  #undef CMASK
  #define CMASK(P0,P1,t) do{}while(0)
  for(;t+5<NT;t+=2){
    STEP(pB0,pB1,pA0,pA1,t,true,true,true);     WAIT_BAR(2); RESC(); ROT();
    STEP(pA0,pA1,pB0,pB1,t+1,true,true,true);   WAIT_BAR(2); RESC(); ROT();
  }
  #undef CMASK
  #define CMASK(P0,P1,t) do{int jb_=(t)-(NT-4); if(jb_>=0)cmask(P0,P1,jb_,qrel,hi);}while(0)
  #define ENDW(tt) do{ if((tt)+3<NT){WAIT_BAR(2);} else if((tt)+2<NT){WAIT_BAR(1);} else {WAIT_BAR(0);} }while(0)
  for(;t+1<NT;t+=2){
    STEP(pB0,pB1,pA0,pA1,t,(t+3<NT),(t+1<NT),(t+1<NT));       ENDW(t);   RESC(); ROT();
    STEP(pA0,pA1,pB0,pB1,t+1,(t+4<NT),(t+2<NT),(t+2<NT));     ENDW(t+1); RESC(); ROT();
  }
  STEP(pB0,pB1,pA0,pA1,NT-1,false,false,false); RESC();
  { float sacc=pB0[0]+pB0[1]; _Pragma("unroll") for(int r=2;r<16;++r)sacc+=pB0[r]; _Pragma("unroll") for(int r=0;r<16;++r)sacc+=pB1[r]; l_reg+=sacc;
    pw0=(u32x4){PKW(pB0,0),PKW(pB0,2),PKW(pB0,4),PKW(pB0,6)};pw1=(u32x4){PKW(pB0,8),PKW(pB0,10),PKW(pB0,12),PKW(pB0,14)};pw2=(u32x4){PKW(pB1,0),PKW(pB1,2),PKW(pB1,4),PKW(pB1,6)};pw3=(u32x4){PKW(pB1,8),PKW(pB1,10),PKW(pB1,12),PKW(pB1,14)};
    SBAR(); pv(o,vb0+sl_cur,PAF(0),PAF(1),PAF(2),PAF(3)); }
  #undef PKW
  #undef PAF
  #undef VFR
  #undef PIN
  #undef MX3
  #undef GAPA
  #undef GAPB
  #undef EX
  #undef VRD
  #undef KRD
  #undef STEP
  #undef ENDW
  {auto rr=__builtin_amdgcn_permlane32_swap(__float_as_uint(l_reg),__float_as_uint(l_reg),false,false);l_reg=__uint_as_float(rr[0])+__uint_as_float(rr[1]);}
  int lane_e=lane_id(); asm volatile("":"+v"(lane_e));
  const int r32e=lane_e&31,hie=lane_e>>5; float*wsfe=(float*)(shm+LDS_WS)+wid*64;
  if(hie==0)wsfe[32+r32e]=l_reg;asm volatile("s_waitcnt lgkmcnt(0)":::"memory");
  float rli[16];
  #pragma unroll
  for(int r=0;r<16;++r)rli[r]=__builtin_amdgcn_rcpf(wsfe[32+crow(r,hie)]);
  bf16*Ow=O+(rowbase+q0+wid*QBLK)*QP+h*D;
  { bf16*stg=(bf16*)(shm+LDS_OST)+wid*2048;
    #pragma unroll
    for(int r=0;r<16;++r){const int orow=crow(r,hie);
      #pragma unroll
      for(int d0=0;d0<2;++d0)stg[orow*64+d0*32+r32e]=__float2bfloat16(o[d0][r]*rli[r]);}
    asm volatile("s_waitcnt lgkmcnt(0)":::"memory");
    #pragma unroll
    for(int i=0;i<4;++i){const int row=i*8+(lane_e>>3),ch=lane_e&7; const u32x4 v=*(const u32x4*)(stg+row*64+ch*8); ATTN_STORE16(Ow+(long)row*QP+ch*8,v);} }
  asm volatile("s_waitcnt lgkmcnt(0)\n\ts_barrier":::"memory");
  #undef DMA_K
  #undef PT
  #undef CKSUB
  #undef DMA_V
  #undef CMASK
  #undef START
  #undef RESC
  #undef ROT
}
constexpr int ATTN_LDS_BYTES=LDS_BYTES;
struct AttnTensors { const bf16* Q; const bf16* K; const bf16* V; bf16* O; const float* CQ; };
struct AttnUnit { int bh; int qb; };
struct StaticOrder {
  int vcu;
  __device__ __forceinline__ explicit StaticOrder(int grid,int block):vcu((block%8)*(grid/8)+block/8){}
  __device__ __forceinline__ bool next(int i,AttnUnit&u)const{ if(i>=2)return false; const int s=vcu&7; u.bh=vcu>>3; u.qb=(i==0)?s:15-s; return true; }
  __device__ __forceinline__ void a_ready(const AttnUnit&)const{}
  __device__ __forceinline__ void done(const AttnUnit&)const{}
};
struct QueueOrder {
  unsigned* ctr; volatile __attribute__((address_space(3))) unsigned* slot; bool t0;
  __device__ __forceinline__ bool next(int,AttnUnit&u)const{ if(t0)*slot=atomicAdd(ctr,1u); __syncthreads(); const unsigned idx=(unsigned)__builtin_amdgcn_readfirstlane((int)*slot);
    if(idx>=(unsigned)(BATCH*NHEAD*NQB))return false; u.qb=NQB-1-(int)(idx>>5); u.bh=(int)(idx&31); return true; }
  __device__ __forceinline__ void a_ready(const AttnUnit&)const{}
  __device__ __forceinline__ void done(const AttnUnit&)const{}
};
template<class Sched,int THRL=8> __device__ __forceinline__ void attn_phase(char*lds,const AttnTensors&T,const Sched&S,const int wave_s){
  AttnUnit u;
  for(int i=0;S.next(i,u);++i){ S.a_ready(u); attn_unit<THRL>(u.bh/NHEAD,u.bh%NHEAD,u.qb,T.Q,T.K,T.V,T.O,T.CQ,lds,wave_s); S.done(u); }
}
#undef SBAR
#undef WAIT_BAR
}

namespace dn {
typedef short bf16x8 __attribute__((ext_vector_type(8)));
typedef float f32x16 __attribute__((ext_vector_type(16)));
typedef float f32x4 __attribute__((ext_vector_type(4)));
typedef float f32x2 __attribute__((ext_vector_type(2)));
typedef unsigned u32x4 __attribute__((ext_vector_type(4)));
typedef unsigned u32x2 __attribute__((ext_vector_type(2)));
#define DLAS __attribute__((address_space(3)))
constexpr int NCH = 66, NITEM = 16 * 65;
constexpr int IMG_W = 0, IMG_Q = 16384, IMG_K = 32768, IMG_A = 49152, IMG_BYTES = 57344;
constexpr float QSCALE = 0.08838834764831845f;
__device__ __forceinline__ int img_off128(int m, int k) { const int ch = 2 * (k >> 4) + ((k >> 2) & 1), pos = 4 * ((k >> 3) & 1) + (k & 3); return m * 256 + ((ch ^ (m & 15)) << 4) + pos * 2; }
__device__ __forceinline__ int img_off64(int m, int k)  { const int ch = 2 * (k >> 4) + ((k >> 2) & 1), pos = 4 * ((k >> 3) & 1) + (k & 3); return m * 128 + ((ch ^ ((m >> 1) & 7)) << 4) + pos * 2; }
__device__ __forceinline__ float bfl(unsigned w) { return __builtin_bit_cast(float, w << 16); }
__device__ __forceinline__ float bfh(unsigned w) { return __builtin_bit_cast(float, w & 0xffff0000u); }
typedef __bf16 bf16x2_t __attribute__((ext_vector_type(2)));
__device__ __forceinline__ unsigned pkbf(float lo, float hi) { const f32x2 v = {lo, hi}; return __builtin_bit_cast(unsigned, __builtin_convertvector(v, bf16x2_t)); }
__device__ __forceinline__ float wsum(float v) {
#pragma unroll
    for (int o = 1; o < 64; o <<= 1) v += __shfl_xor(v, o);
    return v;
}
struct PrepArgs { const bf16* DQKV; const float* cw; const float* GG; const float* BT; unsigned char* PREP; float* U; float* CD; unsigned* FLAG; unsigned* TS; };
constexpr int L_QB = 0, L_KB = 17408, L_RHS = 34816, L_AM = 100352, L_AIMG = 117760, L_SC = 125952, L_IMG = L_RHS;

template <int J> __device__ __forceinline__ void solve2_load(f32x4 (&C)[8], int amt_h) {
#pragma unroll
    for (int g = 0; g < 8; ++g) C[g] = *(const DLAS f32x4*)((const DLAS unsigned char*)(size_t)0 + amt_h + (J * 68 + 4 * g) * 4);
}
template <int J> __device__ __forceinline__ float solve2_xj(const float (&x)[32]) {
    const float own = x[J & 31]; const auto rr = __builtin_amdgcn_permlane32_swap(__float_as_uint(own), __float_as_uint(own), false, false);
    return J < 32 ? __uint_as_float(rr[0]) : __uint_as_float(rr[1]);
}
template <int J> __device__ __forceinline__ void solve2_apply(float (&x)[32], const f32x4 (&C)[8], float xj) {
#pragma unroll
    for (int g = 0; g < 8; ++g) { x[4 * g] -= C[g].x * xj; x[4 * g + 1] -= C[g].y * xj; x[4 * g + 2] -= C[g].z * xj; x[4 * g + 3] -= C[g].w * xj; }
}
template <int J> __device__ __forceinline__ void solve2_rows(float (&x)[32], f32x4 (&CA)[8], f32x4 (&CB)[8], int amt_h) {
    if constexpr (J < 63) {
        const float xj = solve2_xj<J>(x);
        if constexpr (J + 1 < 63) { asm volatile("" : "+v"(amt_h) : "v"(xj)); solve2_load<J + 1>(CB, amt_h); }
        solve2_apply<J>(x, CA, xj);
        solve2_rows<J + 1>(x, CB, CA, amt_h);
    }
}
#define DN_FRESH_LANE() asm volatile("" : "+v"(lane))
#define PSTAMP(i) do { if (PROBE_TS && P.TS && wave == 0 && lane == 0) __hip_atomic_store(P.TS + (i), (unsigned)__builtin_amdgcn_s_memrealtime(), __ATOMIC_RELAXED, __HIP_MEMORY_SCOPE_AGENT); } while (0)
__device__ __forceinline__ void prep_item(DLAS unsigned char* lds, const PrepArgs& P, int bh, int n, int wave, int lane) {
    DN_FRESH_LANE(); PSTAMP(0);
    const int b = bh >> 2, h = bh & 3; const size_t rowbase = (size_t)b * LP + 64 * n; const int item = bh * NCH + n;
    int vz = 0; asm volatile("" : "+v"(vz));
    DLAS float* SCf = (DLAS float*)(lds + L_SC + vz);
    if (wave == 0) { const float g = P.GG[(size_t)bh * LP + 64 * n + lane], be = P.BT[(size_t)bh * LP + 64 * n + lane]; float gc = g;
#pragma unroll
        for (int o = 1; o < 64; o <<= 1) { const float t = __shfl_up(gc, o); if (lane >= o) gc += t; }
        const float gl = __shfl(gc, 63);
        SCf[lane] = gc; SCf[64 + lane] = be; SCf[128 + lane] = __expf(gc); SCf[192 + lane] = __expf(gl - gc); SCf[256 + lane] = be * __expf(gc);
        if (lane == 63) P.CD[item] = __expf(gc); }
    { const int r0 = 8 * wave;
      unsigned u[3][11]; float w0[3][4], w1[3][4];
      const unsigned lo4 = 4u * (unsigned)lane, lo8 = 8u * (unsigned)lane;
#pragma unroll
      for (int which = 0; which < 3; ++which) { const int colu = which * 512 + h * 128;
        const unsigned char* wb = (const unsigned char*)(P.cw + colu); const unsigned char* ub = (const unsigned char*)(P.DQKV + (rowbase + r0 - 3) * 1536 + colu);
#pragma unroll
        for (int i = 0; i < 4; ++i) { const f32x2 wv = *(const f32x2*)(wb + (size_t)i * 1536 * 4 + lo8); w0[which][i] = wv.x; w1[which][i] = wv.y; }
#pragma unroll
        for (int rr = 0; rr < 11; ++rr) u[which][rr] = *(const unsigned*)(ub + (size_t)rr * 1536 * 2 + lo4); }
#pragma unroll
      for (int which = 0; which < 3; ++which) { float a0[8], a1[8], ss[8];
#pragma unroll
        for (int r = 0; r < 8; ++r) { float x0 = 0.f, x1 = 0.f;
#pragma unroll
            for (int i = 0; i < 4; ++i) { x0 += w0[which][i] * bfl(u[which][r + i]); x1 += w1[which][i] * bfh(u[which][r + i]); }
            x0 = x0 * __builtin_amdgcn_rcpf(1.f + __expf(-x0)); x1 = x1 * __builtin_amdgcn_rcpf(1.f + __expf(-x1)); a0[r] = x0; a1[r] = x1; ss[r] = x0 * x0 + x1 * x1; }
        if (which < 2) {
#pragma unroll
            for (int o = 1; o < 64; o <<= 1)
#pragma unroll
                for (int r = 0; r < 8; ++r) ss[r] += __shfl_xor(ss[r], o);
#pragma unroll
            for (int r = 0; r < 8; ++r) { const float rs = rsqrtf(ss[r] + EPS); a0[r] *= rs; a1[r] *= rs; } }
#pragma unroll
        for (int r = 0; r < 8; ++r) { const int row = r0 + r;
            if (which < 2) { *(DLAS unsigned*)(lds + (which == 0 ? L_QB : L_KB) + row * 272 + 4 * lane) = pkbf(a0[r], a1[r]);
                if (which == 1) *(DLAS f32x2*)(lds + L_RHS + row * 1024 + 512 + 8 * lane) = (f32x2){a0[r], a1[r]}; }
            else *(DLAS f32x2*)(lds + L_RHS + row * 1024 + 8 * lane) = (f32x2){a0[r], a1[r]}; } } }
    __syncthreads();
    DN_FRESH_LANE(); PSTAMP(1);
    { const int which = wave >> 2, ti = (wave >> 1) & 1, tj = wave & 1, m = lane & 31, hh = lane >> 5;
      const DLAS unsigned char* ap = lds + (which == 0 ? L_KB : L_QB) + (32 * ti + m) * 272 + hh * 16; const DLAS unsigned char* bp = lds + L_KB + (32 * tj + m) * 272 + hh * 16;
      f32x16 acc = f32x16{};
#pragma unroll
      for (int s = 0; s < 8; ++s) acc = __builtin_amdgcn_mfma_f32_32x32x16_bf16(*(const DLAS bf16x8*)(ap + 32 * s), *(const DLAS bf16x8*)(bp + 32 * s), acc, 0, 0, 0);
      const int col = 32 * tj + m; const float gcc = SCf[col];
#pragma unroll
      for (int r = 0; r < 16; ++r) { const int row = 32 * ti + (r & 3) + 8 * (r >> 2) + 4 * hh; const float d = __expf(fminf(SCf[row] - gcc, 0.f));
          if (which == 0) { *(DLAS float*)(lds + L_AM + (row * 68 + col) * 4) = col < row ? SCf[64 + row] * acc[r] * d : 0.f; }
          else { const float v = col <= row ? acc[r] * QSCALE * d : 0.f; *(DLAS unsigned short*)(lds + L_AIMG + img_off64(row, col)) = (unsigned short)(pkbf(v, 0.f) & 0xffffu); } } }
    __syncthreads();
    DN_FRESH_LANE(); PSTAMP(2);
    if (wave < 4) {
        const int c = 64 * wave + lane; float x[64];
#pragma unroll
        for (int i = 0; i < 64; ++i) { const float sc = (c < 128) ? SCf[64 + i] : SCf[64 + i] * SCf[128 + i]; x[i] = *(const DLAS float*)(lds + L_RHS + (i * 256 + c) * 4) * sc; }
        __syncthreads();
#pragma unroll
        for (int i = 1; i < 64; ++i) { float s0 = 0.f, s1 = 0.f, s2 = 0.f, s3 = 0.f;
#pragma unroll
            for (int j4 = 0; j4 < (i + 3) / 4; ++j4) { const f32x4 a = *(const DLAS f32x4*)(lds + vz + L_AM + (i * 68 + 4 * j4) * 4);
                s0 += a.x * x[4 * j4]; s1 += a.y * x[4 * j4 + 1]; s2 += a.z * x[4 * j4 + 2]; s3 += a.w * x[4 * j4 + 3]; }
            x[i] -= (s0 + s1) + (s2 + s3); __builtin_amdgcn_sched_barrier(0); }
        if (c < 128) {
            float* up = P.U + (size_t)item * 8192 + (size_t)(c >> 5) * 2048 + (c & 31) * 16;
#pragma unroll
            for (int t = 0; t < 2; ++t)
#pragma unroll
                for (int hi = 0; hi < 2; ++hi)
#pragma unroll
                    for (int q = 0; q < 4; ++q) { const int rb = 32 * t + 8 * q + 4 * hi; *(f32x4*)(up + t * 1024 + hi * 512 + 4 * q) = (f32x4){x[rb], x[rb + 1], x[rb + 2], x[rb + 3]}; }
        } else { const int dk = c - 128;
#pragma unroll
            for (int i = 0; i < 64; ++i) *(DLAS unsigned short*)(lds + L_IMG + IMG_W + img_off128(i, dk)) = (unsigned short)(pkbf(-x[i], 0.f) & 0xffffu); }
    } else {
        __syncthreads();
        const int t = (wave - 4) * 64 + lane;
        { const int i = t >> 2, d0 = (t & 3) * 32; const float sc = QSCALE * SCf[128 + i];
#pragma unroll
          for (int g8 = 0; g8 < 4; ++g8) { const u32x4 qv = *(const DLAS u32x4*)(lds + L_QB + i * 272 + (d0 + 8 * g8) * 2);
              u32x2 lo, hi2; lo.x = pkbf(bfl(qv.x) * sc, bfh(qv.x) * sc); lo.y = pkbf(bfl(qv.y) * sc, bfh(qv.y) * sc); hi2.x = pkbf(bfl(qv.z) * sc, bfh(qv.z) * sc); hi2.y = pkbf(bfl(qv.w) * sc, bfh(qv.w) * sc);
              *(DLAS u32x2*)(lds + L_IMG + IMG_Q + img_off128(i, d0 + 8 * g8)) = lo; *(DLAS u32x2*)(lds + L_IMG + IMG_Q + img_off128(i, d0 + 8 * g8 + 4)) = hi2; } }
        { const int d = t >> 1, g0 = (t & 1) * 8;
#pragma unroll
          for (int g = 0; g < 8; ++g) { const int c0 = 4 * (g0 + g); float v[4];
#pragma unroll
              for (int e = 0; e < 4; ++e) v[e] = bfl((unsigned)*(const DLAS unsigned short*)(lds + L_KB + (c0 + e) * 272 + d * 2)) * SCf[192 + c0 + e];
              u32x2 w; w.x = pkbf(v[0], v[1]); w.y = pkbf(v[2], v[3]); *(DLAS u32x2*)(lds + L_IMG + IMG_K + img_off64(d, c0)) = w; } }
    }
    __syncthreads();
    DN_FRESH_LANE(); PSTAMP(3);
    { const int t = wave * 64 + lane; unsigned char* dst = P.PREP + (size_t)item * IMG_BYTES;
#pragma unroll
      for (int p = 0; p < 6; ++p) *(u32x4*)(dst + (p * 512 + t) * 16) = *(const DLAS u32x4*)(lds + L_IMG + (p * 512 + t) * 16);
      *(u32x4*)(dst + IMG_A + t * 16) = *(const DLAS u32x4*)(lds + L_AIMG + t * 16); }
    asm volatile("s_waitcnt vmcnt(0)" ::: "memory");
    __syncthreads(); PSTAMP(4);
    if (wave == 0 && lane == 0) { __builtin_amdgcn_fence(__ATOMIC_RELEASE, "agent"); asm volatile("s_waitcnt vmcnt(0)" ::: "memory"); __hip_atomic_store(P.FLAG + item, 1u, __ATOMIC_RELAXED, __HIP_MEMORY_SCOPE_AGENT); }
    PSTAMP(5);
}
struct RecArgs { const unsigned char* PREP; const float* U; const float* CD; const bf16* DZ; const float* onw; bf16* OD; const unsigned* FLAG; unsigned* TS; };
__device__ __forceinline__ void rec_wait_chunk(const unsigned* f) { unsigned sp = 0;
    while (__builtin_amdgcn_readfirstlane((int)__hip_atomic_load(f, __ATOMIC_RELAXED, __HIP_MEMORY_SCOPE_AGENT)) == 0) { __builtin_amdgcn_s_sleep(4); if (++sp > (1u << 22)) break; }
    __builtin_amdgcn_fence(__ATOMIC_ACQUIRE, "agent"); }
constexpr int R_IMG0 = 0, R_IMG1 = IMG_BYTES, R_OB = 2 * IMG_BYTES, R_BYTES = R_OB + 64 * 128 * 4;
#define DN_BAR() do { asm volatile("s_waitcnt vmcnt(0) lgkmcnt(0)" ::: "memory"); __builtin_amdgcn_s_barrier(); asm volatile("" ::: "memory"); } while (0)
__device__ __forceinline__ bf16x8 pack8(const f32x16& v, int s) { u32x4 w; w.x = pkbf(v[8 * s], v[8 * s + 1]); w.y = pkbf(v[8 * s + 2], v[8 * s + 3]); w.z = pkbf(v[8 * s + 4], v[8 * s + 5]); w.w = pkbf(v[8 * s + 6], v[8 * s + 7]); return __builtin_bit_cast(bf16x8, w); }
__device__ __forceinline__ void rec_dma_images(DLAS unsigned char* dst, const unsigned char* src, int w4, int lane) {
    const unsigned char* gp = src + w4 * 1024 + lane * 16; DLAS unsigned char* lp = dst + w4 * 1024;
#pragma unroll 1
    for (int p = 0; p < 14; ++p) { __builtin_amdgcn_global_load_lds((const unsigned*)gp, (DLAS unsigned*)lp, 16, 0, 0); gp += 4096; lp += 4096; }
}
struct ZPre { u32x4 z[4]; };
__device__ __forceinline__ void rec_load_z(ZPre& Z, const RecArgs& A, int b, int h, int n, int t256) {
    const int row = t256 >> 2, c0 = (t256 & 3) * 32; const bf16* zp = A.DZ + ((size_t)b * LP + 64 * n + row) * 512 + h * 128 + c0;
#pragma unroll
    for (int q = 0; q < 4; ++q) Z.z[q] = *(const u32x4*)(zp + 8 * q);
}
template <int MODE> __device__ __forceinline__ void rec_finalize(const DLAS unsigned char* lds, const RecArgs& A, const u32x4 (&RS)[18], const float (&nw)[32], int b, int h, int n, int t256) {
    const int row = t256 >> 2, c0 = (t256 & 3) * 32; const size_t grow = (size_t)b * LP + 64 * n + row;
    const DLAS float* op = (const DLAS float*)(lds + R_OB) + row * 128 + c0; float v[32]; float ss = 0.f;
#pragma unroll
    for (int q = 0; q < 8; ++q) { const f32x4 t = *(const DLAS f32x4*)(op + 4 * q); v[4 * q] = t.x; v[4 * q + 1] = t.y; v[4 * q + 2] = t.z; v[4 * q + 3] = t.w; ss += (t.x * t.x + t.y * t.y) + (t.z * t.z + t.w * t.w); }
    ss += __shfl_xor(ss, 1); ss += __shfl_xor(ss, 2);
    const float rs = rsqrtf(ss * (1.f / 128.f) + EPS);
    bf16* dst = A.OD + grow * 1024 + 512 + h * 128 + c0;
#pragma unroll
    for (int q = 0; q < 4; ++q) { const u32x4 z = RS[14 + q]; float zz[8] = {bfl(z.x), bfh(z.x), bfl(z.y), bfh(z.y), bfl(z.z), bfh(z.z), bfl(z.w), bfh(z.w)}; float r[8];
#pragma unroll
        for (int e = 0; e < 8; ++e) r[e] = v[8 * q + e] * rs * zz[e];
        u32x4 o; o.x = pkbf(r[0], r[1]); o.y = pkbf(r[2], r[3]); o.z = pkbf(r[4], r[5]); o.w = pkbf(r[6], r[7]); if (MODE == 0) *(u32x4*)(dst + 8 * q) = o; else asm volatile("" :: "v"(o)); }
}
#define CSTAMP(cond, i) do { if (PROBE_TS && MODE == 0 && A.TS && (cond)) __hip_atomic_store(A.TS + (i), (unsigned)__builtin_amdgcn_s_memrealtime(), __ATOMIC_RELAXED, __HIP_MEMORY_SCOPE_AGENT); } while (0)
#define DN_BAR_L() do { asm volatile("s_waitcnt lgkmcnt(0)" ::: "memory"); __builtin_amdgcn_s_barrier(); asm volatile("" ::: "memory"); } while (0)
template <int MODE> __device__ __forceinline__ void rec_chain(DLAS unsigned char* lds, const RecArgs& A, int bh, int wave, int lane) {
    const int b = bh >> 2, h = bh & 3;
    if (wave >= 4) {
        const int w4 = wave - 4, t256 = w4 * 64 + lane;
        __builtin_amdgcn_s_setprio(3);
        const unsigned voff = (unsigned)t256 * 16u;
        const unsigned* flg = A.FLAG + bh * NCH;
        int ready = 0;
#define REC_ENSURE(k) do { if (MODE == 0) { unsigned sp_ = 0; bool adv_ = false; while (ready < (k)) { const int i_ = ready + 1 + (lane & 15); \
              const unsigned f_ = (i_ < NCH) ? __hip_atomic_load(flg + i_, __ATOMIC_RELAXED, __HIP_MEMORY_SCOPE_AGENT) : 0u; \
              const unsigned long long m_ = __ballot(f_ == 0u) & 0xffffull; const int run_ = m_ ? (int)__builtin_ctzll(m_) : 16; \
              if (run_ > 0) { ready += run_; adv_ = true; } else { __builtin_amdgcn_s_sleep(8); if (++sp_ > (1u << 20)) break; } } \
            if (adv_) __builtin_amdgcn_fence(__ATOMIC_ACQUIRE, "agent"); } } while (0)
        u32x4 R0[18], R1[18];
        const unsigned zoff = (unsigned)(((t256 >> 2) * 512 + (t256 & 3) * 32) * 2);
#define REC_LOADR(RS, nn, zn_) do { if ((zn_) < NCH) { const unsigned char* zb_ = (const unsigned char*)(A.DZ + ((size_t)b * LP + 64 * (zn_)) * 512 + h * 128); asm volatile("" : "+s"(zb_)); \
            _Pragma("unroll") for (int q = 0; q < 4; ++q) asm volatile("global_load_dwordx4 %0, %1, %2 offset:%c3" : "=v"(RS[14 + q]) : "v"(zoff), "s"(zb_), "i"(16 * q)); } \
        if ((nn) < NCH) { REC_ENSURE(nn); const unsigned char* g_ = A.PREP + (size_t)(bh * NCH + (nn)) * IMG_BYTES; asm volatile("" : "+s"(g_)); \
            _Pragma("unroll") for (int p = 0; p < 14; ++p) { const unsigned char* gp_ = g_ + p * 4096; asm volatile("global_load_dwordx4 %0, %1, %2" : "=v"(RS[p]) : "v"(voff), "s"(gp_)); } } } while (0)
#define REC_RETIRE(RS, n) do { if ((n) > 2 && (n) < 63) asm volatile("s_waitcnt vmcnt(22)" ::: "memory"); else asm volatile("s_waitcnt vmcnt(0)" ::: "memory"); \
        _Pragma("unroll") for (int p = 0; p < 18; ++p) asm volatile("" : "+v"(RS[p])); } while (0)
#define REC_STORER(RS, nn) do { DLAS unsigned char* d_ = lds + (((nn) & 1) ? R_IMG1 : R_IMG0) + t256 * 16; _Pragma("unroll") for (int p = 0; p < 14; ++p) *(DLAS u32x4*)(d_ + p * 4096) = RS[p]; } while (0)
#define REC_ITER(RS, n) do { CSTAMP((n) == 40 && t256 == 0, 10); \
            if (MODE != 1) { REC_RETIRE(RS, n); CSTAMP((n) == 40 && t256 == 0, 21); if ((n) > 1) rec_finalize<MODE>(lds, A, RS, nw, b, h, (n) - 1, t256); CSTAMP((n) == 40 && t256 == 0, 11); \
                if ((n) + 1 < NCH) REC_STORER(RS, (n) + 1); CSTAMP((n) == 40 && t256 == 0, 12); \
                REC_LOADR(RS, (n) + 3, (n) + 1); } CSTAMP((n) == 40 && t256 == 0, 13); \
            DN_BAR_L();        CSTAMP((n) == 40 && t256 == 0, 14); \
            DN_BAR_L();        CSTAMP((n) == 40 && t256 == 0, 15); } while (0)
        REC_LOADR(R1, 1, NCH); REC_LOADR(R0, 2, NCH);
        float nw[32];
#pragma unroll
        for (int q = 0; q < 8; ++q) { const f32x4 t = *(const f32x4*)(A.onw + (t256 & 3) * 32 + 4 * q); nw[4 * q] = t.x; nw[4 * q + 1] = t.y; nw[4 * q + 2] = t.z; nw[4 * q + 3] = t.w; }
        REC_RETIRE(R1, 0); REC_STORER(R1, 1); REC_LOADR(R1, 3, 1);
        DN_BAR_L();
        for (int n = 1; n + 1 < NCH; n += 2) { REC_ITER(R0, n); REC_ITER(R1, n + 1); }
        REC_ITER(R0, NCH - 1);
        if (MODE != 1) { REC_RETIRE(R1, 0); rec_finalize<MODE>(lds, A, R1, nw, b, h, NCH - 1, t256); }
        __builtin_amdgcn_s_setprio(0);
#undef REC_LOADR
#undef REC_RETIRE
#undef REC_STORER
#undef REC_ITER
#undef REC_ENSURE
    } else {
        const int m = lane & 31, hh = lane >> 5;
        f32x16 S[4]; bf16x8 Sb[8]; f32x16 un[2];
#pragma unroll
        for (int d = 0; d < 4; ++d) S[d] = f32x16{};
#pragma unroll
        for (int s = 0; s < 8; ++s) Sb[s] = bf16x8{};
        if (MODE == 0) rec_wait_chunk(A.FLAG + bh * NCH + 1);
        { const float* up = A.U + (size_t)(bh * NCH + 1) * 8192 + wave * 2048 + lane * 16;
#pragma unroll
          for (int t = 0; t < 2; ++t) { const f32x4 a = *(const f32x4*)(up + t * 1024), bq = *(const f32x4*)(up + t * 1024 + 4), c = *(const f32x4*)(up + t * 1024 + 8), d = *(const f32x4*)(up + t * 1024 + 12);
              un[t] = (f32x16){a.x, a.y, a.z, a.w, bq.x, bq.y, bq.z, bq.w, c.x, c.y, c.z, c.w, d.x, d.y, d.z, d.w}; } }
        DN_BAR_L();
        const int c15 = (hh ^ (m & 15)) << 4, c7 = (hh ^ ((m >> 1) & 7)) << 4;
        const int aW0 = IMG_W + m * 256, aW1 = IMG_W + (32 + m) * 256, aQ0 = IMG_Q + m * 256, aQ1 = IMG_Q + (32 + m) * 256, aA0 = IMG_A + m * 128, aA1 = IMG_A + (32 + m) * 128, aK0 = IMG_K + m * 128;
#define FR(off) (*(const DLAS bf16x8*)(img + (off)))
#define SB_() __builtin_amdgcn_sched_barrier(0)
#define MF_(a, b, c) c = __builtin_amdgcn_mfma_f32_32x32x16_bf16(a, b, c, 0, 0, 0)
#define LD_G1(F, s) do { F[0] = FR(aW0 + ((32 * (s)) ^ c15)); F[1] = FR(aQ0 + ((32 * (s)) ^ c15)); F[2] = FR(aW1 + ((32 * (s)) ^ c15)); F[3] = FR(aQ1 + ((32 * (s)) ^ c15)); } while (0)
#define MM_G1(F, s) do { MF_(F[0], Sb[s], vn[0]); MF_(F[1], Sb[s], o[0]); MF_(F[2], Sb[s], vn[1]); MF_(F[3], Sb[s], o[1]); } while (0)
#define LD_G2(F, j) do { F[0] = FR(aA0 + ((32 * (2 * (j))) ^ c7)); F[1] = FR(aA1 + ((32 * (2 * (j))) ^ c7)); F[2] = FR(aA0 + ((32 * (2 * (j) + 1)) ^ c7)); F[3] = FR(aA1 + ((32 * (2 * (j) + 1)) ^ c7)); } while (0)
#define MM_G2(F, j) do { MF_(F[0], vb[2 * (j)], o[0]); MF_(F[1], vb[2 * (j)], o[1]); MF_(F[2], vb[2 * (j) + 1], o[0]); MF_(F[3], vb[2 * (j) + 1], o[1]); } while (0)
#define LD_G3(F, s) do { F[0] = FR(aK0 + ((32 * (s)) ^ c7)); F[1] = FR(aK0 + 32 * 128 + ((32 * (s)) ^ c7)); F[2] = FR(aK0 + 64 * 128 + ((32 * (s)) ^ c7)); F[3] = FR(aK0 + 96 * 128 + ((32 * (s)) ^ c7)); } while (0)
#define MM_G3(F, s) do { MF_(F[0], vb[s], S[0]); MF_(F[1], vb[s], S[1]); MF_(F[2], vb[s], S[2]); MF_(F[3], vb[s], S[3]); } while (0)
        for (int n = 1; n < NCH; ++n) {
            if (MODE == 2) { DN_BAR_L(); DN_BAR_L(); continue; }
            if (PROBE_TS && MODE == 0 && A.TS && wave == 0 && lane == 0 && (n % 10) == 0) __hip_atomic_store(A.TS + n / 10, (unsigned)__builtin_amdgcn_s_memrealtime(), __ATOMIC_RELAXED, __HIP_MEMORY_SCOPE_AGENT);
            const DLAS unsigned char* img = lds + ((n & 1) ? R_IMG1 : R_IMG0);
            const float cd = A.CD[bh * NCH + n];
            f32x16 vn[2], o[2]; bf16x8 fa[4], fb[4];
#pragma unroll
            for (int t = 0; t < 2; ++t) { vn[t] = un[t]; o[t] = f32x16{}; }
            CSTAMP(n == 40 && wave == 0 && lane == 0, 16);
            LD_G1(fa, 0); SB_();
            LD_G1(fb, 1); SB_(); MM_G1(fa, 0); S[0] = S[0] * cd; SB_();
            LD_G1(fa, 2); SB_(); MM_G1(fb, 1); S[1] = S[1] * cd; SB_();
            LD_G1(fb, 3); SB_(); MM_G1(fa, 2); S[2] = S[2] * cd; SB_();
            LD_G1(fa, 4); SB_(); MM_G1(fb, 3); S[3] = S[3] * cd; SB_();
            LD_G1(fb, 5); SB_(); MM_G1(fa, 4); SB_();
            LD_G1(fa, 6); SB_(); MM_G1(fb, 5); SB_();
            LD_G1(fb, 7); SB_(); MM_G1(fa, 6); SB_();
            LD_G2(fa, 0); SB_(); MM_G1(fb, 7); SB_(); CSTAMP(n == 40 && wave == 0 && lane == 0, 17);
            if (n + 1 < NCH) {
                const float* up = A.U + (size_t)(bh * NCH + n + 1) * 8192 + wave * 2048 + lane * 16;
#pragma unroll
                for (int t = 0; t < 2; ++t) { const f32x4 a = *(const f32x4*)(up + t * 1024), bq = *(const f32x4*)(up + t * 1024 + 4), c = *(const f32x4*)(up + t * 1024 + 8), d = *(const f32x4*)(up + t * 1024 + 12);
                    un[t] = (f32x16){a.x, a.y, a.z, a.w, bq.x, bq.y, bq.z, bq.w, c.x, c.y, c.z, c.w, d.x, d.y, d.z, d.w}; } }
            bf16x8 vb[4];
#pragma unroll
            for (int t = 0; t < 2; ++t) { vb[2 * t] = pack8(vn[t], 0); vb[2 * t + 1] = pack8(vn[t], 1); }
            SB_();
            LD_G2(fb, 1); SB_(); MM_G2(fa, 0); SB_();
            LD_G3(fa, 0); SB_(); MM_G2(fb, 1); SB_();
            LD_G3(fb, 1); SB_(); MM_G3(fa, 0); SB_();
            LD_G3(fa, 2); SB_(); MM_G3(fb, 1); SB_();
            LD_G3(fb, 3); SB_(); MM_G3(fa, 2); SB_();
            MM_G3(fb, 3); SB_();
#pragma unroll
            for (int d = 0; d < 4; ++d) { Sb[2 * d] = pack8(S[d], 0); Sb[2 * d + 1] = pack8(S[d], 1); }
            CSTAMP(n == 40 && wave == 0 && lane == 0, 18);
            DN_BAR_L();
            CSTAMP(n == 40 && wave == 0 && lane == 0, 19);
            { DLAS float* ob = (DLAS float*)(lds + R_OB) + 32 * wave + m;
#pragma unroll
              for (int t = 0; t < 2; ++t)
#pragma unroll
                  for (int r = 0; r < 16; ++r) ob[(32 * t + (r & 3) + 8 * (r >> 2) + 4 * hh) * 128] = o[t][r]; }
            DN_BAR_L();
            CSTAMP(n == 40 && wave == 0 && lane == 0, 20);
        }
    }
}
#undef FR
#undef SB_
#undef MF_
#undef LD_G1
#undef MM_G1
#undef LD_G2
#undef MM_G2
#undef LD_G3
#undef MM_G3
}

__device__ __forceinline__ float fsigmoid_g(float x) { return __builtin_amdgcn_rcpf(1.f + __builtin_amdgcn_exp2f(-LOG2E * x)); }
struct EpiG1 { static constexpr bool PERM = true, AFTER_DRAIN = false;
    bf16 *OD, *FK, *FV, *DQKV, *DZ; const float* onw;
    __device__ __forceinline__ void operator()(const pg8::f32x4 (&acc)[2][2][4][2], const pg8::Unit& u, int wr, int wc, int fr, int fq) const {
        const int pn = u.pn; bf16* base; int ldc, colt; float sc = 1.f;
        if (pn < 2) { base = OD; ldc = 1024; colt = pn * 256; sc = C2; }
        else if (pn < 4) { base = FK; ldc = 512; colt = (pn - 2) * 256; }
        else if (pn < 6) { base = FV; ldc = 512; colt = (pn - 4) * 256; }
        else if (pn < 12) { base = DQKV; ldc = 1536; colt = (pn - 6) * 256; }
        else { base = DZ; ldc = 512; colt = (pn - 12) * 256; }
        const int row0 = u.pm * 256 + wr * 64 + fr, col0 = colt + wc * 32 + 8 * fq;
#pragma unroll
        for (int ai = 0; ai < 2; ++ai)
#pragma unroll
            for (int m = 0; m < 4; ++m) { bf16* rowp = base + (size_t)(row0 + ai * 128 + m * 16) * ldc + col0;
#pragma unroll
                for (int bj = 0; bj < 2; ++bj) { pg8::f32x4 v0 = acc[ai][bj][m][0] * sc, v1 = acc[ai][bj][m][1] * sc; pg8::u32x4 w;
                    if (pn >= 12) { const int cw_ = (col0 + bj * 128) & 127; const pg8::f32x4 n0 = *(const pg8::f32x4*)(onw + cw_), n1 = *(const pg8::f32x4*)(onw + cw_ + 4);
#pragma unroll
                        for (int e = 0; e < 4; ++e) { v0[e] = v0[e] * fsigmoid_g(v0[e]) * n0[e]; v1[e] = v1[e] * fsigmoid_g(v1[e]) * n1[e]; } }
                    w.x = pg8::cvt_pk_bf16(v0[0], v0[1]); w.y = pg8::cvt_pk_bf16(v0[2], v0[3]); w.z = pg8::cvt_pk_bf16(v1[0], v1[1]); w.w = pg8::cvt_pk_bf16(v1[2], v1[3]);
                    *(pg8::u32x4*)(rowp + bj * 128) = w; } }
    }
};
struct SchedG1 { int c, G; const char* A; const char* B;
    __device__ __forceinline__ bool next(int i, pg8::Unit& u) const { int pm, pn; if (!pg8::static_tile(R / 256, 14, G, c, i, pm, pn)) return false;
        u.pm = pm; u.pn = pn; u.sub = 0; u.nt = 16; u.A = A + (size_t)pm * 256 * 1024 * 2; u.B = B + (size_t)pn * 256 * 1024 * 2; return true; }
    __device__ __forceinline__ void a_ready(const pg8::Unit&) const {}
    __device__ __forceinline__ void done(const pg8::Unit&) const {}
};

#define LAS __attribute__((address_space(3)))
typedef float f32x4 __attribute__((ext_vector_type(4)));
typedef unsigned v4u __attribute__((ext_vector_type(4)));
constexpr int NWAVES = 8, MISC_OFF = 147456, LDS_BYTES = MISC_OFF + 256;

#define LDS_WAIT() asm volatile("s_waitcnt lgkmcnt(0)" ::: "memory")
__device__ __forceinline__ unsigned pk2(float lo, float hi) { return f2bf(lo) | (f2bf(hi) << 16); }
__device__ __forceinline__ float wave_sum(float v) {
#pragma unroll
    for (int o = 1; o < 64; o <<= 1) v += __shfl_xor(v, o);
    return v;
}
__device__ __forceinline__ float fsigmoid(float x) { return __builtin_amdgcn_rcpf(1.f + __builtin_amdgcn_exp2f(-LOG2E * x)); }
__device__ __forceinline__ int nat_row0(int pm) { return (pm >> 4) * LP + 128 + (pm & 15) * 256; }
struct EpiBr { static constexpr bool PERM = true, AFTER_DRAIN = false;
    bf16* S; bf16* Y;
    __device__ __forceinline__ void operator()(const pg8::f32x4 (&acc)[2][2][4][2], const pg8::Unit& u, int wr, int wc, int fr, int fq) const {
        v4u* Sg = (v4u*)S + ((wr * 4 + wc) * 64 + fq * 16 + fr); const int sub = u.sub;
        const int row0 = u.pm * 256 + wr * 64 + fr, col0 = u.pn * 256 + wc * 32 + 8 * fq;
#pragma unroll
        for (int ai = 0; ai < 2; ++ai)
#pragma unroll
            for (int m = 0; m < 4; ++m)
#pragma unroll
                for (int bj = 0; bj < 2; ++bj) { const int idx = ((ai * 4 + m) * 2 + bj) * 512; const pg8::f32x4 v0 = acc[ai][bj][m][0], v1 = acc[ai][bj][m][1];
                    if ((sub & 1) == 0) { v4u w; w.x = pg8::cvt_pk_bf16(fsigmoid(v0[0]), fsigmoid(v0[1])); w.y = pg8::cvt_pk_bf16(fsigmoid(v0[2]), fsigmoid(v0[3]));
                        w.z = pg8::cvt_pk_bf16(fsigmoid(v1[0]), fsigmoid(v1[1])); w.w = pg8::cvt_pk_bf16(fsigmoid(v1[2]), fsigmoid(v1[3])); Sg[idx] = w; }
                    else { const v4u s = Sg[idx]; bf16* yp = Y + (size_t)(row0 + ai * 128 + m * 16) * 1024 + col0 + bj * 128;
                        float t[8]; t[0] = __builtin_bit_cast(float, s.x << 16) * v0[0]; t[1] = __builtin_bit_cast(float, s.x & 0xffff0000u) * v0[1]; t[2] = __builtin_bit_cast(float, s.y << 16) * v0[2]; t[3] = __builtin_bit_cast(float, s.y & 0xffff0000u) * v0[3];
                        t[4] = __builtin_bit_cast(float, s.z << 16) * v1[0]; t[5] = __builtin_bit_cast(float, s.z & 0xffff0000u) * v1[1]; t[6] = __builtin_bit_cast(float, s.w << 16) * v1[2]; t[7] = __builtin_bit_cast(float, s.w & 0xffff0000u) * v1[3];
                        if (sub == 3) { const v4u y = *(const v4u*)yp; t[0] += __builtin_bit_cast(float, y.x << 16); t[1] += __builtin_bit_cast(float, y.x & 0xffff0000u); t[2] += __builtin_bit_cast(float, y.y << 16); t[3] += __builtin_bit_cast(float, y.y & 0xffff0000u);
                            t[4] += __builtin_bit_cast(float, y.z << 16); t[5] += __builtin_bit_cast(float, y.z & 0xffff0000u); t[6] += __builtin_bit_cast(float, y.w << 16); t[7] += __builtin_bit_cast(float, y.w & 0xffff0000u); }
                        v4u w; w.x = pg8::cvt_pk_bf16(t[0], t[1]); w.y = pg8::cvt_pk_bf16(t[2], t[3]); w.z = pg8::cvt_pk_bf16(t[4], t[5]); w.w = pg8::cvt_pk_bf16(t[6], t[7]); *(v4u*)yp = w; } }
    }
};
struct SchedBr { int c, G; const char *HN, *OD, *WG, *WB;
    __device__ __forceinline__ bool next(int i, pg8::Unit& u) const { int pm, pn; if (!pg8::static_tile(64, 4, G, c, i >> 2, pm, pn)) return false;
        const int sub = i & 3; u.pm = pm; u.pn = pn; u.sub = sub; const size_t arow = (size_t)nat_row0(pm) * 2048;
        if ((sub & 1) == 0) { u.nt = 16; u.A = HN + arow; u.B = WG + (size_t)((sub >> 1) * 1024 + pn * 256) * 2048; }
        else { u.nt = 8; u.A = OD + arow + (sub >> 1) * 1024; u.B = WB + (size_t)(pn * 256) * 2048 + (sub >> 1) * 1024; }
        return true; }
    __device__ __forceinline__ void a_ready(const pg8::Unit&) const {}
    __device__ __forceinline__ void done(const pg8::Unit&) const {}
};
struct SchedStd { int c, G, nM, nN, nt; const char* A; const char* B; size_t astep, bstep;
    __device__ __forceinline__ bool next(int i, pg8::Unit& u) const { int pm, pn; if (!pg8::static_tile(nM, nN, G, c, i, pm, pn)) return false;
        u.pm = pm; u.pn = pn; u.sub = 0; u.nt = nt; u.A = A + (size_t)pm * astep; u.B = B + (size_t)pn * bstep; return true; }
    __device__ __forceinline__ void a_ready(const pg8::Unit&) const {}
    __device__ __forceinline__ void done(const pg8::Unit&) const {}
};
struct EpiRes { static constexpr bool PERM = false, AFTER_DRAIN = true;
    const float* base; float* out; bf16* HB; float* SS;
    __device__ __forceinline__ void fused(pg8::f32x4 (&acc)[2][2][4][2], const pg8::Unit& u, int wr, int wc, int fr, int fq, PG8_LAS unsigned char* lds, int wid, int lane) const {
        LAS float* P = (LAS float*)lds; const int col0 = u.pn * 256 + wc * 32 + 4 * fq;
#pragma unroll
        for (int ai = 0; ai < 2; ++ai)
#pragma unroll
            for (int m = 0; m < 4; ++m) { const int r = ai * 128 + wr * 64 + m * 16 + fr; const size_t off = (size_t)(u.pm * 256 + r) * 1024 + col0; float s = 0.f;
#pragma unroll
                for (int bj = 0; bj < 2; ++bj)
#pragma unroll
                    for (int n = 0; n < 2; ++n) { const pg8::f32x4 h = *(const pg8::f32x4*)(base + off + bj * 128 + n * 16) + acc[ai][bj][m][n];
                        *(pg8::f32x4*)(out + off + bj * 128 + n * 16) = h; s += (h[0] * h[0] + h[1] * h[1]) + (h[2] * h[2] + h[3] * h[3]);
                        if (HB) { unsigned long long w = (unsigned long long)pg8::cvt_pk_bf16(h[0], h[1]) | ((unsigned long long)pg8::cvt_pk_bf16(h[2], h[3]) << 32); *(unsigned long long*)(HB + off + bj * 128 + n * 16) = w; } }
                s += __shfl_xor(s, 16); s += __shfl_xor(s, 32);
                if (fq == 0) P[r * 4 + wc] = s; }
        asm volatile("s_waitcnt lgkmcnt(0)" ::: "memory"); __builtin_amdgcn_s_barrier(); asm volatile("" ::: "memory");
        const int t = wid * 64 + lane; if (t < 256) SS[(size_t)u.pn * RT + u.pm * 256 + t] = (P[t * 4] + P[t * 4 + 1]) + (P[t * 4 + 2] + P[t * 4 + 3]);
    }
};
struct EpiGU { static constexpr bool PERM = true, AFTER_DRAIN = false;
    const float* SS; bf16* HID;
    __device__ __forceinline__ void operator()(const pg8::f32x4 (&acc)[2][2][4][2], const pg8::Unit& u, int wr, int wc, int fr, int fq) const {
        const int row0 = u.pm * 256 + wr * 64 + fr, col0 = u.pn * 128 + wc * 32 + 8 * fq;
#pragma unroll
        for (int ai = 0; ai < 2; ++ai)
#pragma unroll
            for (int m = 0; m < 4; ++m) { const int row = row0 + ai * 128 + m * 16;
                const float rs = rsqrtf(((SS[row] + SS[RT + row]) + (SS[2 * RT + row] + SS[3 * RT + row])) * (1.f / DM) + EPS); float h[8];
#pragma unroll
                for (int n = 0; n < 2; ++n)
#pragma unroll
                    for (int e = 0; e < 4; ++e) { const float g = acc[ai][0][m][n][e] * rs, up = acc[ai][1][m][n][e] * rs; h[4 * n + e] = g * fsigmoid(g) * up; }
                v4u w; w.x = pg8::cvt_pk_bf16(h[0], h[1]); w.y = pg8::cvt_pk_bf16(h[2], h[3]); w.z = pg8::cvt_pk_bf16(h[4], h[5]); w.w = pg8::cvt_pk_bf16(h[6], h[7]);
                *(v4u*)(HID + (size_t)row * DFF + col0) = w; }
    }
};
#define XB_TMO      128
#define XB_XCNT(j)  (256  + 64 * (j))
#define XB_XSUB(j)  (1280 + 64 * (j))
#define XB_XGEN(j)  (2304 + 64 * (j))
#define XB_TOP      3328
#define XB_TOPGEN   3392
#define XCD_BAR_WORDS 3456
#define XB_SPIN_CAP (1u << 18)

__device__ __forceinline__ unsigned xb_ld(unsigned* p)              { return __hip_atomic_load(p, __ATOMIC_RELAXED, __HIP_MEMORY_SCOPE_AGENT); }
__device__ __forceinline__ unsigned xb_add(unsigned* p, unsigned v) { return __hip_atomic_fetch_add(p, v, __ATOMIC_RELAXED, __HIP_MEMORY_SCOPE_AGENT); }
__device__ __forceinline__ unsigned xb_xcc_id() { return (unsigned)__builtin_amdgcn_s_getreg((3 << 11) | 20) & 0xFu; }
#define XB_SPIN(cond, bar) do { unsigned _sp = 0; while (cond) { __builtin_amdgcn_s_sleep(1); \
    if ((++_sp & 255u) == 0u) { if (xb_ld(&(bar)[XB_TMO])) break; if (_sp > XB_SPIN_CAP) { atomicAdd(&(bar)[XB_TMO], 1u); break; } } } } while (0)

struct XcdBarrier {
    unsigned* bar; unsigned x;
    volatile LAS unsigned* st;
};

__device__ __forceinline__ XcdBarrier xcd_barrier_post(unsigned* bar, volatile LAS unsigned* st, bool t0) {
    XcdBarrier b; b.bar = bar; b.x = xb_xcc_id(); b.st = st;
    if (t0) (void)xb_add(&bar[XB_XCNT(b.x)], 1u);
    return b;
}
__device__ __forceinline__ void xcd_barrier_complete(unsigned* bar, unsigned x, unsigned& nloc, unsigned& nx) {
    const unsigned G = gridDim.x * gridDim.y * gridDim.z;
    unsigned sum, cnt, mine, sp = 0u;
    for (;;) {
        sum = 0u; cnt = 0u; mine = 0u;
#pragma unroll
        for (unsigned j = 0; j < 16; ++j) { const unsigned c = xb_ld(&bar[XB_XCNT(j)]); sum += c; cnt += (c > 0u) ? 1u : 0u; mine = (j == x) ? c : mine; }
        if (sum == G) break;
        __builtin_amdgcn_s_sleep(1);
        if ((++sp & 255u) == 0u) { if (xb_ld(&bar[XB_TMO])) break; if (sp > XB_SPIN_CAP) { atomicAdd(&bar[XB_TMO], 1u); break; } }
    }
    nloc = mine > 0u ? mine : 1u; nx = cnt > 0u ? cnt : 1u;
}

__device__ __forceinline__ void xcd_barrier(const XcdBarrier& b, bool t0) {
    asm volatile("s_waitcnt vmcnt(0)" ::: "memory");
    __syncthreads();
    if (t0) {
        unsigned* bar = b.bar;
        __builtin_amdgcn_s_waitcnt(0);
        unsigned nloc = b.st[0], nx = b.st[1];
        if (nloc == 0u) { xcd_barrier_complete(bar, b.x, nloc, nx); b.st[0] = nloc; b.st[1] = nx; }
        const unsigned old = xb_add(&bar[XB_XSUB(b.x)], 1u);
        const unsigned gen = old / nloc;
        if (old + 1u == (gen + 1u) * nloc) {
            __builtin_amdgcn_fence(__ATOMIC_RELEASE, "agent");
            asm volatile("s_waitcnt vmcnt(0)" ::: "memory");
            const unsigned og = xb_add(&bar[XB_TOP], 1u);
            const unsigned tg = og / nx;
            if (og + 1u == (tg + 1u) * nx) xb_add(&bar[XB_TOPGEN], 1u);
            else XB_SPIN(xb_ld(&bar[XB_TOPGEN]) == tg, bar);
            __builtin_amdgcn_fence(__ATOMIC_ACQUIRE, "agent");
            xb_add(&bar[XB_XGEN(b.x)], 1u);
            asm volatile("s_waitcnt vmcnt(0)" ::: "memory");
        } else {
            XB_SPIN(xb_ld(&bar[XB_XGEN(b.x)]) == gen, bar);
            __builtin_amdgcn_fence(__ATOMIC_ACQUIRE, "agent");
            asm volatile("s_waitcnt vmcnt(0)" ::: "memory");
        }
    }
    __syncthreads();
}


struct Args { const float* in[17]; float* out; unsigned char* ws; int ph_lo, ph_hi; };

__device__ __forceinline__ void p0_transpose_item(const float* __restrict__ W, int srcN, int col0, int k0, bf16* __restrict__ WT, int drow0, int ldk, int koff, const float* __restrict__ scale, LAS float* scr, int lane) {
#pragma unroll 8
    for (int i = 0; i < 32; ++i) { const int kk = 2 * i + (lane >> 5); float v = W[(size_t)(k0 + kk) * srcN + col0 + (lane & 31)]; if (scale) v *= scale[k0 + kk]; scr[kk * 33 + (lane & 31)] = v; }
    LDS_WAIT(); asm volatile("" ::: "memory");
    const int c = lane & 7;
#pragma unroll
    for (int j = 0; j < 4; ++j) { const int n = (lane >> 3) + 8 * j; const LAS float* s = scr + (8 * c) * 33 + n;
        v4u o; o.x = pk2(s[0 * 33], s[1 * 33]); o.y = pk2(s[2 * 33], s[3 * 33]); o.z = pk2(s[4 * 33], s[5 * 33]); o.w = pk2(s[6 * 33], s[7 * 33]);
        *(v4u*)(WT + (size_t)(drow0 + n) * ldk + koff + k0 + 8 * c) = o; }
    LDS_WAIT(); asm volatile("" ::: "memory");
}
__device__ __forceinline__ bool p0_mat(int& r, const float* W, int srcN, int col0, int Ncols, int K, bf16* WT, int drow0, int ldk, int koff, const float* scale, int rowmode, LAS float* scr, int lane) {
    const int nblk = Ncols / 32, nitems = (K / 64) * nblk;
    if (r >= nitems) { r -= nitems; return false; }
    const int kb = r / nblk, nb = r % nblk, n0 = 32 * nb;
    const int dr = rowmode == 0 ? drow0 + n0 : ((n0 >> 7) * 256 + (n0 & 127) + (rowmode == 2 ? 128 : 0));
    p0_transpose_item(W, srcN, col0 + n0, 64 * kb, WT, dr, ldk, koff, scale, scr, lane); return true;
}

__global__ void __launch_bounds__(NWAVES * 64, 2) mega(Args args) {
    extern __shared__ __attribute__((aligned(16))) unsigned char lds_raw[];
    cg::grid_group grid = cg::this_grid();
    LAS unsigned char* lds = (LAS unsigned char*)lds_raw;
#define FRESH_TID() int lane = lane_id(); asm volatile("" : "+v"(lane)); const int wave = wave_s, tid = wave * 64 + lane; (void)tid
    const int wave_s = __builtin_amdgcn_readfirstlane((int)threadIdx.x >> 6);
    const int G = gridDim.x, bx = blockIdx.x;
    const int vcu = (G % 8 == 0) ? (bx % 8) * (G / 8) + bx / 8 : bx;
    unsigned char* ws = args.ws;
    const float* x = args.in[0]; const float* meta = args.in[1]; const float* mix_nw = args.in[2]; const float* w_in = args.in[3];
    const float* fbias = args.in[4]; const float* a_log = args.in[6]; const float* dt_bias = args.in[7];
    const float* wbf = args.in[9]; const float* wbd = args.in[10]; const float* wout = args.in[11];
    const float* ffn_nw = args.in[12]; const float* wg = args.in[13]; const float* wu = args.in[14]; const float* wd = args.in[15];
    float *CQ = (float*)(ws + WS_CQ), *GG = (float*)(ws + WS_GG), *BT = (float*)(ws + WS_BT), *LF = (float*)(ws + WS_LF);
    bf16 *WIN = (bf16*)(ws + WS_WIN), *WG = (bf16*)(ws + WS_WG), *WB = (bf16*)(ws + WS_WB), *WOUT = (bf16*)(ws + WS_WOUT), *WGU = (bf16*)(ws + WS_WGU), *WDN = (bf16*)(ws + WS_WDN);
    bf16 *HN = (bf16*)(ws + WS_HN), *OD = (bf16*)(ws + WS_OD), *FK = (bf16*)(ws + WS_FK), *FV = (bf16*)(ws + WS_FV), *DQKV = (bf16*)(ws + WS_DQKV), *DZ = (bf16*)(ws + WS_DZ), *Y = (bf16*)(ws + WS_Y), *HID = (bf16*)(ws + WS_HID), *H1B = HN;
    float *SS1 = (float*)(ws + WS_SS1), *SS2 = (float*)(ws + WS_SS2);
    const int lo = args.ph_lo, hi = args.ph_hi;
    if (hi < 0) grid.sync();
    { int l0 = lane_id(); if (wave_s == 0 && l0 < 64) ((volatile LAS unsigned*)(lds + MISC_OFF))[l0] = 0u; }
    __syncthreads();
    const XcdBarrier xbar = xcd_barrier_post((unsigned*)(ws + WS_BAR), (volatile LAS unsigned*)(lds + MISC_OFF), wave_s == 0 && lane_id() == 0);
#define GRID_SYNC() xcd_barrier(xbar, wave_s == 0 && lane_id() == 0)
#define STAMP(k) do { if (PROBE_TS && bx == 0 && wave_s == 0 && lane_id() == 0) { const unsigned long long t_ = __builtin_amdgcn_s_memrealtime(); ((volatile LAS unsigned*)(lds + MISC_OFF))[32 + 2 * (k)] = (unsigned)t_; } } while (0)
    STAMP(0);
#define STAMPG(slot, blk) do { if (PROBE_TS && bx == (blk) && wave_s == 0 && lane_id() == 0) __hip_atomic_store((unsigned*)(ws + WS_BAR) + 6144 + (slot), (unsigned)__builtin_amdgcn_s_memrealtime(), __ATOMIC_RELAXED, __HIP_MEMORY_SCOPE_AGENT); } while (0)
#define IN(k) (lo <= (k) && (k) < hi)
#define BOTH(k) (IN(k) && IN((k) + 1))

    if (IN(0)) {
      { int reps_ = 1 + ((PROBE_REP >> 0) & 1); asm volatile("" : "+s"(reps_)); for (int rep_ = 0; rep_ < reps_; ++rep_) {
        FRESH_TID();
        const int gw = vcu * NWAVES + wave, NGW = G * NWAVES;
        { LAS float* scr = (LAS float*)(lds + wave * 16384);
          constexpr int NITEMS = 16 * 112 + 16 * 64 + 2 * 8 * 32 + 16 * 32 + 2 * 16 * 88 + 44 * 32;
          for (int it = gw; it < NITEMS; it += NGW) { int r = it;
            if (p0_mat(r, w_in, DIN, 0, 1536, 1024, WIN, 0, 1024, 0, nullptr, 0, scr, lane)) continue;
            if (p0_mat(r, w_in, DIN, 1544, 1536, 1024, WIN, 1536, 1024, 0, nullptr, 0, scr, lane)) continue;
            if (p0_mat(r, w_in, DIN, 3088, 512, 1024, WIN, 3072, 1024, 0, nullptr, 0, scr, lane)) continue;
            if (p0_mat(r, w_in, DIN, 3600, 2048, 1024, WG, 0, 1024, 0, nullptr, 0, scr, lane)) continue;
            if (p0_mat(r, wbf, 1024, 0, 1024, 512, WB, 0, 1024, 0, nullptr, 0, scr, lane)) continue;
            if (p0_mat(r, wbd, 1024, 0, 1024, 512, WB, 0, 1024, 512, nullptr, 0, scr, lane)) continue;
            if (p0_mat(r, wout, 1024, 0, 1024, 1024, WOUT, 0, 1024, 0, nullptr, 0, scr, lane)) continue;
            if (p0_mat(r, wg, DFF, 0, DFF, 1024, WGU, 0, 1024, 0, ffn_nw, 1, scr, lane)) continue;
            if (p0_mat(r, wu, DFF, 0, DFF, 1024, WGU, 0, 1024, 0, ffn_nw, 2, scr, lane)) continue;
            p0_mat(r, wd, 1024, 0, 1024, DFF, WDN, 0, DFF, 0, nullptr, 0, scr, lane);
          } }
        __syncthreads();
        LAS float* W16 = (LAS float*)lds;
#pragma unroll 2
        for (int i = tid; i < 1024 * 4; i += NWAVES * 64) { const int k = i >> 2, q = i & 3;
            const f32x4 v = *(const f32x4*)(w_in + (size_t)k * DIN + (q < 2 ? 1536 + 4 * q : 3080 + 4 * (q - 2)));
            *(LAS f32x4*)(W16 + ((k & 3) * 256 + (k >> 2)) * 20 + 4 * q) = v; }
        __syncthreads();
        for (int r = gw; r < R; r += NGW) {
            const int b = r / LP, pos = r % LP;
            const float* src = pos < NPAD ? nullptr : (pos < 128 ? meta + (size_t)(pos - NPAD) * DM : x + ((size_t)b * SEQ + (pos - 128)) * DM);
            f32x4 v[4]; float ss = 0.f;
#pragma unroll
            for (int j = 0; j < 4; ++j) { v[j] = src ? ((const f32x4*)src)[lane + 64 * j] : (f32x4){0.f, 0.f, 0.f, 0.f}; ss += (v[j].x * v[j].x + v[j].y * v[j].y) + (v[j].z * v[j].z + v[j].w * v[j].w); }
            const float rs = rsqrtf(wave_sum(ss) * (1.f / DM) + EPS);
            unsigned long long* o8 = (unsigned long long*)(HN + (size_t)r * DM) + lane;
            float acc[16];
#pragma unroll
            for (int c = 0; c < 16; ++c) acc[c] = 0.f;
#pragma unroll
            for (int j = 0; j < 4; ++j) { asm volatile("" ::: "memory");
                const f32x4 nwv = ((const f32x4*)mix_nw)[lane + 64 * j]; const f32x4 hn = v[j] * rs * nwv;
                o8[64 * j] = (unsigned long long)pk2(hn.x, hn.y) | ((unsigned long long)pk2(hn.z, hn.w) << 32);
#pragma unroll
                for (int e = 0; e < 4; ++e) { const LAS float* wr_ = W16 + (e * 256 + lane + 64 * j) * 20; const float he = hn[e];
#pragma unroll
                    for (int q = 0; q < 4; ++q) { const f32x4 w = *(const LAS f32x4*)(wr_ + 4 * q); acc[4 * q] += he * w.x; acc[4 * q + 1] += he * w.y; acc[4 * q + 2] += he * w.z; acc[4 * q + 3] += he * w.w; } } }
            float mine = 0.f;
#pragma unroll
            for (int c = 0; c < 16; ++c) { const float t = wave_sum(acc[c]); mine = (lane == c) ? t : mine; }
            if (lane < 16) { const bool valid = pos >= NPAD; const int j = lane;
                if (j < 8) { const float z = mine + fbias[j]; LF[(size_t)(b * 8 + j) * LP + pos] = fminf(z, 0.f) - log1pf(expf(-fabsf(z))); }
                else if (j < 12) { const int h = j - 8; BT[(size_t)(b * 4 + h) * LP + pos] = valid ? sigmoidf_(mine) : 0.f; }
                else { const int h = j - 12; const float z = mine + dt_bias[h]; const float sp = fmaxf(z, 0.f) + log1pf(expf(-fabsf(z))); GG[(size_t)(b * 4 + h) * LP + pos] = valid ? -expf(a_log[h]) * sp : 0.f; } }
        }
      } }
        if (BOTH(0)) { GRID_SYNC(); for (int e_ = 0; e_ < PROBE_SYNC; ++e_) GRID_SYNC(); } STAMP(1);
    }
    if (IN(1)) {
      { int reps_ = 1 + ((PROBE_REP >> 1) & 1); asm volatile("" : "+s"(reps_)); for (int rep_ = 0; rep_ < reps_; ++rep_) {
        __syncthreads();
        { pg8::Gemm g{1024, 1024}; SchedG1 S{bx, G, (const char*)HN, (const char*)WIN}; EpiG1 E{OD, FK, FV, DQKV, DZ, args.in[8]};
          pg8::gemm_phase<EpiG1, SchedG1, true, true>(lds, g, S, E, wave_s); }
        if (bx >= G - 32) {
            FRESH_TID();
            __syncthreads();
            const int bh = bx - (G - 32); LAS float* part = (LAS float*)lds;
            const float* lf = LF + (size_t)bh * LP; float* cq = CQ + (size_t)bh * LP;
            float v[9]; float run = 0.f;
#pragma unroll
            for (int e = 0; e < 9; ++e) { const int i = tid * 9 + e; const float t = (i < LP && i >= NPAD) ? lf[i] : 0.f; run += t; v[e] = run; }
            float incl = run;
#pragma unroll
            for (int o = 1; o < 64; o <<= 1) { const float t = __shfl_up(incl, o); if (lane >= o) incl += t; }
            if (lane == 63) part[wave] = incl;
            __syncthreads();
            float base = incl - run;
            for (int w = 0; w < wave; ++w) base += part[w];
#pragma unroll
            for (int e = 0; e < 9; ++e) { const int i = tid * 9 + e; if (i < LP) cq[i] = i >= NPAD ? (base + v[e]) * LOG2E : 1e30f; }
        }
      } }
        if (BOTH(1)) { GRID_SYNC(); for (int e_ = 0; e_ < PROBE_SYNC; ++e_) GRID_SYNC(); } STAMP(2);
    }
    if (IN(2)) {
        FRESH_TID();
        __syncthreads();
        unsigned* FLAG = (unsigned*)(ws + WS_BAR) + 4096;
        const dn::PrepArgs P{DQKV, args.in[5], GG, BT, (unsigned char*)args.out, (float*)(ws + WS_U), (float*)(ws + WS_CD), FLAG, (PROBE_TS && bx == 17) ? (unsigned*)(ws + WS_BAR) + 6144 + 30 : nullptr};
        STAMPG(20, 0);
        if (bx < 16) {
            const dn::RecArgs A{(const unsigned char*)args.out, (const float*)(ws + WS_U), (const float*)(ws + WS_CD), DZ, args.in[8], OD, FLAG, (PROBE_TS && bx == 0) ? (unsigned*)(ws + WS_BAR) + 6144 + 40 : nullptr};
            dn::rec_chain<0>(lds, A, bx, wave, lane); __syncthreads(); STAMPG(21, 0);
            if ((PROBE_REP >> 10) & 1) { dn::rec_chain<1>(lds, A, bx, wave, lane); __syncthreads(); }
            if ((PROBE_REP >> 12) & 1) { dn::rec_chain<2>(lds, A, bx, wave, lane); __syncthreads(); } }
        { unsigned* ctr = (unsigned*)(ws + WS_BAR) + 3584; volatile LAS unsigned* slot = (volatile LAS unsigned*)(lds + MISC_OFF + 64);
#define PULL_(idx_) do { int ln_ = lane_id(); asm volatile("" : "+v"(ln_)); if (wave_s == 0 && ln_ == 0) *slot = atomicAdd(ctr, 1u); __syncthreads(); idx_ = (unsigned)__builtin_amdgcn_readfirstlane((int)*slot); } while (0)
          unsigned idx; PULL_(idx);
          while (idx < (unsigned)dn::NITEM) { int ln = lane_id(); asm volatile("" : "+v"(ln)); dn::prep_item(lds, P, (int)(idx & 15u), 1 + (int)(idx >> 4), wave_s, ln); PULL_(idx); }
          STAMPG(23, 17); STAMPG(25, 255);
          while (idx < (unsigned)dn::NITEM + 512u) { const unsigned u = idx - (unsigned)dn::NITEM; const int bh = (int)(u & 31u), qb = 15 - (int)(u >> 5);
              attn_body::attn_unit<8>(bh >> 3, bh & 7, qb, (const attn_body::bf16*)OD, (const attn_body::bf16*)FK, (const attn_body::bf16*)FV, (attn_body::bf16*)OD, CQ, (char*)lds_raw, wave_s); PULL_(idx); }
          STAMPG(22, 0); STAMPG(24, 17); STAMPG(26, 255);
#undef PULL_
        }
        if (BOTH(2)) { GRID_SYNC(); for (int e_ = 0; e_ < PROBE_SYNC; ++e_) GRID_SYNC(); } STAMP(3);
    }
    if (IN(3)) { STAMP(4); }
    if (IN(4)) {
      { int reps_ = 1 + ((PROBE_REP >> 4) & 1); asm volatile("" : "+s"(reps_)); for (int rep_ = 0; rep_ < reps_; ++rep_) {
        __syncthreads();
        { pg8::Gemm g{1024, 1024}; SchedBr S{bx, G, (const char*)HN, (const char*)OD, (const char*)WG, (const char*)WB}; EpiBr E{(bf16*)args.out + (size_t)bx * 65536, Y};
          pg8::gemm_phase<EpiBr, SchedBr, true, true>(lds, g, S, E, wave_s); }
      } }
        if (BOTH(4)) { GRID_SYNC(); for (int e_ = 0; e_ < PROBE_SYNC; ++e_) GRID_SYNC(); } STAMP(5);
    }
    if (IN(5)) {
      if ((PROBE_REP >> 11) & 1) { const unsigned long long t0_ = __builtin_amdgcn_s_memrealtime(); while (__builtin_amdgcn_s_memrealtime() - t0_ < 10000ull) __builtin_amdgcn_s_sleep(8); }
      { int reps_ = 1 + ((PROBE_REP >> 5) & 1); asm volatile("" : "+s"(reps_)); for (int rep_ = 0; rep_ < reps_; ++rep_) {
        __syncthreads();
        { pg8::Gemm g{1024, 1024}; SchedStd S{bx, G, 64, 4, 16, (const char*)Y, (const char*)WOUT, (size_t)256 * 1024 * 2, (size_t)256 * 1024 * 2}; EpiRes E{x, args.out, H1B, SS1};
          pg8::gemm_phase<EpiRes, SchedStd, false, true>(lds, g, S, E, wave_s); }
      } }
        if (BOTH(5)) { GRID_SYNC(); for (int e_ = 0; e_ < PROBE_SYNC; ++e_) GRID_SYNC(); } STAMP(6);
    }
    if (IN(6)) {
      { int reps_ = 1 + ((PROBE_REP >> 6) & 1); asm volatile("" : "+s"(reps_)); for (int rep_ = 0; rep_ < reps_; ++rep_) {
        __syncthreads();
        { pg8::Gemm g{1024, 1024}; SchedStd S{bx, G, 64, 22, 16, (const char*)H1B, (const char*)WGU, (size_t)256 * 1024 * 2, (size_t)256 * 1024 * 2}; EpiGU E{SS1, HID};
          pg8::gemm_phase<EpiGU, SchedStd, true, true>(lds, g, S, E, wave_s); }
      } }
        if (BOTH(6)) { GRID_SYNC(); for (int e_ = 0; e_ < PROBE_SYNC; ++e_) GRID_SYNC(); } STAMP(7);
    }
    if (IN(7)) {
        __syncthreads();
        { pg8::Gemm g{DFF, DFF}; SchedStd S{bx, G, 64, 4, 44, (const char*)HID, (const char*)WDN, (size_t)256 * DFF * 2, (size_t)256 * DFF * 2}; EpiRes E{args.out, args.out, nullptr, SS2};
          pg8::gemm_phase<EpiRes, SchedStd, false, true>(lds, g, S, E, wave_s); }
        if (BOTH(7)) { GRID_SYNC(); for (int e_ = 0; e_ < PROBE_SYNC; ++e_) GRID_SYNC(); } STAMP(8);
    }
    if (IN(8)) {
        FRESH_TID();
        const int gw = vcu * NWAVES + wave, NGW = G * NWAVES; const float* fnw = args.in[16];
        for (int m = gw; m < RT; m += NGW) { f32x4* o = (f32x4*)(args.out + (size_t)m * DM) + lane;
            const float rs = rsqrtf(((SS2[m] + SS2[RT + m]) + (SS2[2 * RT + m] + SS2[3 * RT + m])) * (1.f / DM) + EPS);
#pragma unroll
            for (int j = 0; j < 4; ++j) o[64 * j] = o[64 * j] * rs * ((const f32x4*)fnw)[lane + 64 * j]; }
        STAMP(9);
        if (PROBE_TS && bx == 0 && wave_s == 0 && lane_id() == 0) { asm volatile("s_waitcnt vmcnt(0) lgkmcnt(0)" ::: "memory"); volatile LAS unsigned* ts_ = (volatile LAS unsigned*)(lds + MISC_OFF) + 32;
            unsigned d_ = PROBE_TS == 10 ? ts_[2 * 9] - ts_[0] : ts_[2 * (PROBE_TS % 100)] - ts_[2 * ((PROBE_TS % 100) - 1)];
            if (PROBE_TS >= 100) { const unsigned* g_ = (const unsigned*)(ws + WS_BAR) + 6144; d_ = __hip_atomic_load(g_ + PROBE_TS / 100, __ATOMIC_RELAXED, __HIP_MEMORY_SCOPE_AGENT) - __hip_atomic_load(g_ + PROBE_TS % 100, __ATOMIC_RELAXED, __HIP_MEMORY_SCOPE_AGENT); }
            args.out[0] += (PROBE_TS >= 5000 ? 2e-3f : 1e-4f) * (float)(int)d_; }
    }
#undef IN
#undef BOTH
}
extern "C" void kernel_launch(void* const* d_in, const int* in_sizes, int n_in, void* d_out, int out_size, void* d_ws, size_t ws_size, hipStream_t stream) {
    if (n_in != 17 || ws_size < WS_END || out_size != RT * DM) { fprintf(stderr, "kernel_launch: unexpected shapes (n_in %d, ws %zu, out %d)\n", n_in, ws_size, out_size); return; }
    static int grid = 0;
    if (grid == 0) {
        int dev = 0, cus = 0, per_cu = 0; (void)hipGetDevice(&dev); (void)hipDeviceGetAttribute(&cus, hipDeviceAttributeMultiprocessorCount, dev);
        if (hipFuncSetAttribute((const void*)mega, hipFuncAttributeMaxDynamicSharedMemorySize, LDS_BYTES) != hipSuccess) { fprintf(stderr, "kernel_launch: hipFuncSetAttribute failed\n"); grid = -1; return; }
        if (hipOccupancyMaxActiveBlocksPerMultiprocessor(&per_cu, (const void*)mega, NWAVES * 64, LDS_BYTES) != hipSuccess || per_cu < 1) { fprintf(stderr, "kernel_launch: occupancy query says %d\n", per_cu); per_cu = 1; }
        (void)hipGetLastError();
        grid = cus;
        if (grid != 256) fprintf(stderr, "kernel_launch: %d CUs (built for 256)\n", grid);
    }
    if (grid < 0) return;
    unsigned char* ws = (unsigned char*)d_ws; float* out = (float*)d_out;
    if (hipMemsetAsync((char*)d_ws + WS_BAR, 0, 32768, stream) != hipSuccess) { fprintf(stderr, "kernel_launch: memset failed\n"); return; }
    Args a{}; for (int i = 0; i < 17; ++i) a.in[i] = (const float*)d_in[i]; a.out = out; a.ws = ws; a.ph_lo = 0; a.ph_hi = 9;
    { void* params[] = {&a}; hipError_t e = hipLaunchCooperativeKernel((const void*)mega, dim3(grid), dim3(NWAVES * 64), params, LDS_BYTES, stream);
      if (e != hipSuccess) { fprintf(stderr, "kernel_launch: cooperative launch failed: %s\n", hipGetErrorString(e)); return; } }
}
```

```cpp
#include <hip/hip_runtime.h>
#include <hip/hip_cooperative_groups.h>
#include <hip/hip_bf16.h>
#include <cmath>
#include <cstdint>
#include <cstdio>

namespace cg = cooperative_groups;
typedef unsigned short bf16;
constexpr int NB = 4, SEQ = 4096, DM = 1024, LP = 4224, R = NB * LP, RT = NB * SEQ, DIN = 5648, DFF = 2816;
constexpr int NPAD = 112;
constexpr float EPS = 1e-6f;
constexpr float LOG2E = 1.4426950408889634f;
constexpr float C2 = 0.125f * LOG2E;

#ifndef PROBE_SYNC
#define PROBE_SYNC 0
#endif
#ifndef PROBE_REP
#define PROBE_REP 0
#endif
#ifndef PROBE_TS
#define PROBE_TS 0
#endif
constexpr size_t MiB = 1u << 20;
constexpr size_t WS_BAR = 0;
constexpr size_t WS_LG = 1 * MiB;
constexpr size_t WS_CQ = 2 * MiB + 256 * 1024;
constexpr size_t WS_GG = 2 * MiB + 896 * 1024;
constexpr size_t WS_BT = 3 * MiB + 256 * 1024;
constexpr size_t WS_SS1 = 3 * MiB + 512 * 1024;
constexpr size_t WS_SS2 = 3 * MiB + 768 * 1024;
constexpr size_t WS_LF = 4 * MiB;
constexpr size_t WS_WIN = 5 * MiB;
constexpr size_t WS_WG = 12 * MiB;
constexpr size_t WS_WB = 16 * MiB;
constexpr size_t WS_WOUT = 18 * MiB;
constexpr size_t WS_WGU = 20 * MiB;
constexpr size_t WS_WDN = 31 * MiB;
constexpr size_t WS_HN = 37 * MiB;
constexpr size_t WS_OD = 70 * MiB;
constexpr size_t WS_FK = 103 * MiB;
constexpr size_t WS_FV = 119 * MiB + 512 * 1024;
constexpr size_t WS_DQKV = 136 * MiB;
constexpr size_t WS_DZ = 185 * MiB + 512 * 1024;
constexpr size_t WS_CD = 1 * MiB;
constexpr size_t WS_U = 202 * MiB;
constexpr size_t WS_Y = 202 * MiB;
constexpr size_t WS_HID = 70 * MiB;
constexpr size_t WS_END = 256 * MiB;

__device__ __forceinline__ unsigned f2bf(float f) { unsigned u = __builtin_bit_cast(unsigned, f); return (u + 0x7fffu + ((u >> 16) & 1u)) >> 16; }
__device__ __forceinline__ float bf2f(bf16 b) { return __builtin_bit_cast(float, (unsigned)b << 16); }
__device__ __forceinline__ float sigmoidf_(float x) { return 1.f / (1.f + expf(-x)); }
__device__ __forceinline__ float siluf_(float x) { return x / (1.f + expf(-x)); }
__device__ __forceinline__ int lane_id() { int l; asm volatile("v_mbcnt_lo_u32_b32 %0, -1, 0\n\tv_mbcnt_hi_u32_b32 %0, -1, %0" : "=v"(l)); return l; }
__device__ __forceinline__ int nat_row(int m) { return (m >> 12) * LP + 128 + (m & 4095); }

namespace pg8 {
#define PG8_LAS __attribute__((address_space(3)))
typedef unsigned short bf16_t;
typedef short bf16x8 __attribute__((ext_vector_type(8)));
typedef float f32x4 __attribute__((ext_vector_type(4)));
typedef unsigned u32x4 __attribute__((ext_vector_type(4)));
constexpr int BM = 256, BK = 64, HALF = 128, HTB = HALF * BK * 2  , STAGE_BYTES = 8 * HTB, NXCD = 8, WGM = 8;
__host__ __device__ __forceinline__ int lds_byte(int r, int c) { const int st = (r >> 4) * 2 + (c >> 5), rr = r & 15, cc = c & 31, ob = rr * 64 + cc * 2; return st * 1024 + (ob ^ (((ob >> 9) & 1) << 5)); }
__host__ __device__ __forceinline__ void stage_rc(int b, int& R, int& C) { const int st = b / 1024, sb = b % 1024, swz = sb ^ (((sb >> 9) & 1) << 5); R = (st >> 1) * 16 + swz / 64; C = (st & 1) * 32 + (swz % 64) / 2; }
__host__ __device__ __forceinline__ int perm32(int rho) { const int n = rho >> 4, i = rho & 15; return 8 * (i >> 2) + 4 * n + (i & 3); }
struct Unit { const char* A; const char* B; int nt; int pm, pn, sub; };
struct Gemm { int lda, ldb; };
__device__ __forceinline__ bool static_tile(int nM, int nN, int G, int c, int i, int& pm, int& pn) {
    const int nwg = nM * nN; const long L = (long)i * G + c; if (L >= nwg) return false;
    int wgid = (int)L; { const int q = nwg / NXCD, r = nwg % NXCD, xcd = wgid % NXCD, off = wgid / NXCD; wgid = (xcd < r ? xcd * (q + 1) : r * (q + 1) + (xcd - r) * q) + off; }
    const int nig = WGM * nN, gid = wgid / nig, fm = gid * WGM, gsz = (nM - fm) < WGM ? (nM - fm) : WGM;
    pm = fm + ((wgid % nig) % gsz); pn = (wgid % nig) / gsz; return true;
}
__device__ __forceinline__ unsigned cvt_pk_bf16(float lo, float hi) { unsigned r; asm volatile("v_cvt_pk_bf16_f32 %0, %1, %2" : "=v"(r) : "v"(lo), "v"(hi)); return r; }
template <class Epi, class Sched, bool ALIGN_EPI = false, bool SP2 = false>
__device__ __forceinline__ void gemm_phase(PG8_LAS unsigned char* lds, const Gemm g, const Sched& S, const Epi& E, const int wave_s) {
    int lane = lane_id(); asm volatile("" : "+v"(lane)); const int wid = wave_s, tid = wid * 64 + lane, wr = wid >> 2, wc = wid & 3, fr = lane & 15, fq = lane >> 4;
    const int lda = g.lda, ldb = g.ldb;
    unsigned voffA[2], voffB[2];
#pragma unroll
    for (int i = 0; i < 2; ++i) { int R, C; stage_rc(tid * 16 + i * 8192, R, C); const int Rb = Epi::PERM ? ((R & ~31) + perm32(R & 31)) : R;
        voffA[i] = (unsigned)(R * lda + C) * 2u; voffB[i] = (unsigned)(Rb * ldb + C) * 2u; }
    const size_t kstep = (size_t)(BK * 2);
    const size_t hstepA = (size_t)HALF * lda * 2, hstepB = (size_t)HALF * ldb * 2;
    const unsigned ldsw = (unsigned)wid * 1024u;
    const int aoff = lds_byte(wr * 64 + fr, fq * 8), boff = lds_byte(wc * 32 + fr, fq * 8);
#define PG8_SA(b, h) (((b) * 2 + (h)) * HTB)
#define PG8_SB(b, h) ((4 + (b) * 2 + (h)) * HTB)
#define PG8_STAGE(bufoff, gbase, voff) do { _Pragma("unroll") for (int _i = 0; _i < 2; ++_i) \
        __builtin_amdgcn_global_load_lds((const unsigned*)((const char*)(gbase) + (voff)[_i]), (PG8_LAS unsigned*)(lds + (bufoff) + ldsw + _i * 8192), 16, 0, 0); } while (0)
#define PG8_LDA(dst, b, h) do { _Pragma("unroll") for (int m = 0; m < 4; ++m) _Pragma("unroll") for (int k = 0; k < 2; ++k) dst[m][k] = *(const PG8_LAS bf16x8*)(lds + PG8_SA(b, h) + aoff + m * 2048 + k * 1024); } while (0)
#define PG8_LDB(dst, b, h) do { _Pragma("unroll") for (int n = 0; n < 2; ++n) _Pragma("unroll") for (int k = 0; k < 2; ++k) dst[n][k] = *(const PG8_LAS bf16x8*)(lds + PG8_SB(b, h) + boff + n * 2048 + k * 1024); } while (0)
#define PG8_MMA(ai, bj, At, Bt) do { __builtin_amdgcn_s_setprio(1); _Pragma("unroll") for (int m = 0; m < 4; ++m) _Pragma("unroll") for (int n = 0; n < 2; ++n) _Pragma("unroll") for (int k = 0; k < 2; ++k) \
        acc[ai][bj][m][n] = __builtin_amdgcn_mfma_f32_16x16x32_bf16(Bt[n][k], At[m][k], acc[ai][bj][m][n], 0, 0, 0); __builtin_amdgcn_s_setprio(0); } while (0)
#define PG8_WAIT_V(n) asm volatile("s_waitcnt vmcnt(" #n ")" ::: "memory")
#define PG8_WAIT_L(n) asm volatile("s_waitcnt lgkmcnt(" #n ")" ::: "memory")
#define PG8_BAR __builtin_amdgcn_s_barrier()
#define PG8_SCHED __builtin_amdgcn_sched_barrier(0)
    Unit cur, nxt; int ui = 0;
    if (!S.next(0, cur)) return;
    f32x4 acc[2][2][4][2];
#pragma unroll
    for (int a = 0; a < 2; ++a)
#pragma unroll
        for (int b = 0; b < 2; ++b)
#pragma unroll
            for (int m = 0; m < 4; ++m)
#pragma unroll
                for (int n = 0; n < 2; ++n) acc[a][b][m][n] = (f32x4){0.f, 0.f, 0.f, 0.f};
    bf16x8 At[4][2], B0[2][2], B1[2][2];
    const char* cA = cur.A; const char* cB = cur.B;
    S.a_ready(cur);
    if constexpr (SP2) {
        PG8_STAGE(PG8_SB(0, 0), cB, voffB); PG8_STAGE(PG8_SB(0, 1), cB + hstepB, voffB); PG8_STAGE(PG8_SA(0, 0), cA, voffA); PG8_STAGE(PG8_SA(0, 1), cA + hstepA, voffA);
        if (wr == 1) PG8_BAR;
        PG8_WAIT_V(2); PG8_BAR;
        PG8_STAGE(PG8_SB(1, 0), cB + kstep, voffB); PG8_STAGE(PG8_SA(1, 0), cA + kstep, voffA); PG8_STAGE(PG8_SB(1, 1), cB + hstepB + kstep, voffB);
        PG8_WAIT_V(6); PG8_BAR;
    } else {
        PG8_STAGE(PG8_SB(0, 0), cB, voffB); PG8_STAGE(PG8_SA(0, 0), cA, voffA); PG8_STAGE(PG8_SB(0, 1), cB + hstepB, voffB); PG8_STAGE(PG8_SA(0, 1), cA + hstepA, voffA);
        if (wr == 1) PG8_BAR;
        PG8_WAIT_V(4); PG8_BAR;
        PG8_STAGE(PG8_SB(1, 0), cB + kstep, voffB); PG8_STAGE(PG8_SA(1, 0), cA + kstep, voffA); PG8_STAGE(PG8_SB(1, 1), cB + hstepB + kstep, voffB);
        PG8_WAIT_V(6); PG8_BAR;
    }
    for (;;) {
        const bool has_next = S.next(ui + 1, nxt);
        const char* nA = has_next ? nxt.A : cA; const char* nB = has_next ? nxt.B : cB;
        const int nt = cur.nt;
        for (int t = 0; t < nt; t += 2) {
            const bool last = (t == nt - 2);
            const char* a1 = cA + (size_t)(t + 1) * kstep;
            const char* a2 = last ? nA : cA + (size_t)(t + 2) * kstep; const char* b2 = last ? nB : cB + (size_t)(t + 2) * kstep;
            const char* a3 = a2 + kstep; const char* b3 = b2 + kstep;
            if (last && has_next) S.a_ready(nxt);
            if constexpr (SP2) {
            PG8_LDB(B0, 0, 0); PG8_LDB(B1, 0, 1); PG8_SCHED; PG8_LDA(At, 0, 0); PG8_STAGE(PG8_SA(1, 1), a1 + hstepA, voffA);
            PG8_WAIT_V(8); PG8_WAIT_L(0); PG8_BAR; PG8_MMA(0, 0, At, B0); PG8_MMA(0, 1, At, B1); PG8_BAR; PG8_SCHED;
            PG8_LDA(At, 0, 1); PG8_STAGE(PG8_SB(0, 0), b2, voffB); PG8_STAGE(PG8_SB(0, 1), b2 + hstepB, voffB); PG8_STAGE(PG8_SA(0, 0), a2, voffA);
            PG8_WAIT_V(8); PG8_WAIT_L(0); PG8_BAR; PG8_MMA(1, 0, At, B0); PG8_MMA(1, 1, At, B1); PG8_BAR; PG8_SCHED;
            PG8_LDB(B0, 1, 0); PG8_LDB(B1, 1, 1); PG8_SCHED; PG8_LDA(At, 1, 0); PG8_STAGE(PG8_SA(0, 1), a2 + hstepA, voffA);
            PG8_WAIT_V(8); PG8_WAIT_L(0); PG8_BAR; PG8_MMA(0, 0, At, B0); PG8_MMA(0, 1, At, B1); PG8_BAR; PG8_SCHED;
            PG8_LDA(At, 1, 1); PG8_STAGE(PG8_SB(1, 0), b3, voffB); PG8_STAGE(PG8_SB(1, 1), b3 + hstepB, voffB); PG8_STAGE(PG8_SA(1, 0), a3, voffA);
            PG8_WAIT_V(8); PG8_WAIT_L(0); PG8_BAR; PG8_MMA(1, 0, At, B0); PG8_MMA(1, 1, At, B1); PG8_BAR; PG8_SCHED;
            } else {
            PG8_LDB(B0, 0, 0); PG8_SCHED; PG8_LDA(At, 0, 0); PG8_STAGE(PG8_SA(1, 1), a1 + hstepA, voffA);
            PG8_WAIT_L(8); PG8_BAR; PG8_WAIT_L(0); PG8_MMA(0, 0, At, B0); PG8_BAR; PG8_SCHED;
            PG8_LDB(B1, 0, 1); PG8_STAGE(PG8_SB(0, 0), b2, voffB);
            PG8_BAR; PG8_WAIT_L(0); PG8_MMA(0, 1, At, B1); PG8_BAR;
            PG8_LDA(At, 0, 1); PG8_STAGE(PG8_SA(0, 0), a2, voffA);
            PG8_BAR; PG8_WAIT_L(0); PG8_MMA(1, 0, At, B0); PG8_BAR; PG8_SCHED;
            PG8_STAGE(PG8_SB(0, 1), b2 + hstepB, voffB);
            PG8_WAIT_V(6); PG8_BAR; PG8_MMA(1, 1, At, B1); PG8_BAR;
            PG8_LDB(B0, 1, 0); PG8_SCHED; PG8_LDA(At, 1, 0); PG8_STAGE(PG8_SA(0, 1), a2 + hstepA, voffA);
            PG8_WAIT_L(8); PG8_BAR; PG8_WAIT_L(0); PG8_MMA(0, 0, At, B0); PG8_BAR; PG8_SCHED;
            PG8_LDB(B1, 1, 1); PG8_STAGE(PG8_SB(1, 0), b3, voffB);
            PG8_BAR; PG8_WAIT_L(0); PG8_MMA(0, 1, At, B1); PG8_BAR;
            PG8_LDA(At, 1, 1); PG8_STAGE(PG8_SA(1, 0), a3, voffA);
            PG8_BAR; PG8_WAIT_L(0); PG8_MMA(1, 0, At, B0); PG8_BAR; PG8_SCHED;
            PG8_STAGE(PG8_SB(1, 1), b3 + hstepB, voffB);
            PG8_WAIT_V(6); PG8_BAR; PG8_MMA(1, 1, At, B1); PG8_BAR;
            }
        }
        if constexpr (ALIGN_EPI) { if (wr == 0) PG8_BAR; }
        if constexpr (!Epi::AFTER_DRAIN) { E(acc, cur, wr, wc, fr, fq); S.done(cur); }
        if (!has_next) break;
#pragma unroll
        for (int a = 0; a < 2; ++a)
#pragma unroll
            for (int b = 0; b < 2; ++b)
#pragma unroll
                for (int m = 0; m < 4; ++m)
#pragma unroll
                    for (int n = 0; n < 2; ++n) acc[a][b][m][n] = (f32x4){0.f, 0.f, 0.f, 0.f};
        cur = nxt; cA = nA; cB = nB; ++ui;
        if constexpr (ALIGN_EPI) { if (wr == 1) PG8_BAR; }
    }
    PG8_WAIT_V(0);
    if constexpr (!ALIGN_EPI) { if (wr == 0) PG8_BAR; }
    PG8_BAR;
    if constexpr (Epi::AFTER_DRAIN) { E.fused(acc, cur, wr, wc, fr, fq, lds, wid, lane); S.done(cur); }
#undef PG8_SA
#undef PG8_SB
#undef PG8_STAGE
#undef PG8_LDA
#undef PG8_LDB
#undef PG8_MMA
#undef PG8_WAIT_V
#undef PG8_WAIT_L
#undef PG8_BAR
#undef PG8_SCHED
}
}

namespace attn_body {
using bf16=__hip_bfloat16;
using bf16x8=__attribute__((ext_vector_type(8)))short;
using s16x4=__attribute__((ext_vector_type(4)))short;
using f32x16=__attribute__((ext_vector_type(16)))float;
using u32x4=__attribute__((ext_vector_type(4)))unsigned;
constexpr int BATCH=4,NHEAD=8,SEQ=4224,D=64,QP=1024,KP=512;
constexpr int NW=8,QBLK=32,QB=QBLK*NW,KVBLK=64,NQB=16;
constexpr int ATTN_UNIT_ROWS=QB;
__device__ __forceinline__ int crow(int r,int hi){return (r&3)+8*(r>>2)+4*hi;}
#define SBAR() __builtin_amdgcn_sched_barrier(0)
__device__ __forceinline__ void cmask(f32x16&p0,f32x16&p1,int jb,int qrel,int hi){
  const float NEG=-INFINITY; int kb=64*jb+4*hi;
  #pragma unroll
  for(int r=0;r<16;++r){int kv=kb+(r&3)+8*(r>>2); if(kv>qrel)p0[r]=NEG; if(kv+32>qrel)p1[r]=NEG;}
}

constexpr int NSLOT=3, SLOTB=8192;
constexpr int LDS_K=0, LDS_V=NSLOT*SLOTB, LDS_WS=2*NSLOT*SLOTB, LDS_OST=LDS_WS+NW*64*4, LDS_CT=LDS_OST+NW*4096+2048, LDS_BYTES=LDS_CT+SEQ*4;
constexpr float C2=0.125f*1.4426950408889634f;
__device__ __forceinline__ void glds16(const void*gsrc,unsigned lds_dst){unsigned keep;
  asm volatile("s_mov_b32 %0, m0\n\ts_mov_b32 m0, %2\n\ts_nop 0\n\tglobal_load_lds_dwordx4 %1, off\n\ts_mov_b32 m0, %0":"=&s"(keep):"v"(gsrc),"s"(lds_dst):"memory");}
__device__ __forceinline__ float max3f(float a,float b,float c){float r;asm("v_max3_f32 %0, %1, %2, %3":"=v"(r):"v"(a),"v"(b),"v"(c));return r;}
__device__ __forceinline__ float max2f(float a,float b){float r;asm("v_max_f32_e32 %0, %1, %2":"=v"(r):"v"(a),"v"(b));return r;}
__device__ __forceinline__ float fadd_s(float a,float b){float r;asm("v_add_f32_e32 %0, %1, %2":"=v"(r):"v"(a),"v"(b));return r;}
__device__ __forceinline__ float fsub_s(float a,float b){float r;asm("v_sub_f32_e32 %0, %1, %2":"=v"(r):"v"(a),"v"(b));return r;}
typedef float f32x2_t __attribute__((ext_vector_type(2))); typedef float f32x4_t __attribute__((ext_vector_type(4))); typedef __bf16 bf16x2_t __attribute__((ext_vector_type(2)));
__device__ __forceinline__ unsigned cvtpk_s(float lo,float hi){f32x2_t v={lo,hi};bf16x2_t b=__builtin_convertvector(v,bf16x2_t);return __builtin_bit_cast(unsigned,b);}
#define WAIT_BAR(N) asm volatile("s_waitcnt vmcnt(" #N ") lgkmcnt(0)\n\ts_barrier":::"memory")

__device__ __forceinline__ void qkt(f32x16&p0,f32x16&p1,const char*Kslot,const bf16x8*qr,const f32x16&negm,int r32,int hi){
  const char*kb=Kslot+hi*1024+r32*16;
  #pragma unroll
  for(int d0=0;d0<4;++d0){
    const bf16x8 b0=*reinterpret_cast<const bf16x8*>(kb+d0*2048);
    const bf16x8 b1=*reinterpret_cast<const bf16x8*>(kb+d0*2048+512);
    if(d0==0){p0=__builtin_amdgcn_mfma_f32_32x32x16_bf16(b0,qr[0],negm,0,0,0);p1=__builtin_amdgcn_mfma_f32_32x32x16_bf16(b1,qr[0],negm,0,0,0);}
    else{p0=__builtin_amdgcn_mfma_f32_32x32x16_bf16(b0,qr[d0],p0,0,0,0);p1=__builtin_amdgcn_mfma_f32_32x32x16_bf16(b1,qr[d0],p1,0,0,0);}}
}
typedef __attribute__((address_space(3))) const char* lds_cptr;
typedef short v4i16_t __attribute__((ext_vector_type(4)));
__device__ __forceinline__ void kload8(bf16x8*kf,lds_cptr kp){
  kf[0]=*(const __attribute__((address_space(3))) bf16x8*)(kp);      kf[1]=*(const __attribute__((address_space(3))) bf16x8*)(kp+512);
  kf[2]=*(const __attribute__((address_space(3))) bf16x8*)(kp+2048); kf[3]=*(const __attribute__((address_space(3))) bf16x8*)(kp+2560);
  kf[4]=*(const __attribute__((address_space(3))) bf16x8*)(kp+4096); kf[5]=*(const __attribute__((address_space(3))) bf16x8*)(kp+4608);
  kf[6]=*(const __attribute__((address_space(3))) bf16x8*)(kp+6144); kf[7]=*(const __attribute__((address_space(3))) bf16x8*)(kp+6656);
}
__device__ __forceinline__ void kload2(bf16x8*kf,lds_cptr kp,int j){ kf[2*j]=*(const __attribute__((address_space(3))) bf16x8*)(kp+j*2048); kf[2*j+1]=*(const __attribute__((address_space(3))) bf16x8*)(kp+j*2048+512); }
__device__ __forceinline__ s16x4 vtr(lds_cptr p){ return __builtin_bit_cast(s16x4,__builtin_amdgcn_ds_read_tr16_b64_v4i16((__attribute__((address_space(3))) v4i16_t*)p)); }
__device__ __forceinline__ float rowmax(const f32x16&p0,const f32x16&p1){
  float a=max3f(p0[0],p0[1],p1[0]),b=max3f(p0[2],p0[3],p1[1]);a=max3f(a,p1[2],p1[3]);
  #pragma unroll
  for(int r=4;r<16;r+=4){a=max3f(a,p0[r],p0[r+1]);b=max3f(b,p0[r+2],p0[r+3]);a=max3f(a,p1[r],p1[r+1]);b=max3f(b,p1[r+2],p1[r+3]);}
  const float m=max2f(a,b);
  auto rr=__builtin_amdgcn_permlane32_swap(__float_as_uint(m),__float_as_uint(m),false,false);
  return max2f(__uint_as_float(rr[0]),__uint_as_float(rr[1]));
}
__device__ __forceinline__ void pv(f32x16*o,int vb,bf16x8 pa0,bf16x8 pa1,bf16x8 pa2,bf16x8 pa3){
  #pragma unroll
  for(int d0=0;d0<2;++d0){s16x4 lo[4],hi[4];
    #pragma unroll
    for(int ks=0;ks<4;++ks){
      asm volatile("ds_read_b64_tr_b16 %0,%1 offset:%c2":"=&v"(lo[ks]):"v"(vb),"i"(d0*4096+ks*1024):"memory");
      asm volatile("ds_read_b64_tr_b16 %0,%1 offset:%c2":"=&v"(hi[ks]):"v"(vb),"i"(d0*4096+ks*1024+512):"memory");}
    asm volatile("s_waitcnt lgkmcnt(0)":::"memory");SBAR();
    #define PK(k) (bf16x8){lo[k][0],lo[k][1],lo[k][2],lo[k][3],hi[k][0],hi[k][1],hi[k][2],hi[k][3]}
    o[d0]=__builtin_amdgcn_mfma_f32_32x32x16_bf16(pa0,PK(0),o[d0],0,0,0);
    o[d0]=__builtin_amdgcn_mfma_f32_32x32x16_bf16(pa1,PK(1),o[d0],0,0,0);
    o[d0]=__builtin_amdgcn_mfma_f32_32x32x16_bf16(pa2,PK(2),o[d0],0,0,0);
    o[d0]=__builtin_amdgcn_mfma_f32_32x32x16_bf16(pa3,PK(3),o[d0],0,0,0);
    #undef PK
  }
}

#ifndef ATTN_STORE16
#define ATTN_STORE16(p,v) (*(u32x4*)(p)=(v))
#endif
template<int THRL> __device__ __forceinline__ void attn_unit(int b,int h,int qb,const bf16*Q,const bf16*__restrict__ K,const bf16*__restrict__ V,bf16*O,const float*__restrict__ CQ,char*shm,const int wave_s){
  int lane=lane_id(); asm volatile("":"+v"(lane));
  const int wid=wave_s,tid=wid*64+lane,r32=lane&31,hi=lane>>5;
  const long rowbase=(long)b*SEQ; const int q0=128+qb*QB;
  const bf16*Qw=Q+(rowbase+q0+wid*QBLK)*QP+h*D;
  const bf16*Kh=K+rowbase*KP+h*D,*Vh=V+rowbase*KP+h*D;
  const unsigned lds0=(unsigned)(uintptr_t)shm;
  float*wsf=(float*)(shm+LDS_WS)+wid*64;
  const bf16*ksrc=Kh+(long)lane*KP+wid*8;
  const bf16*vsrc=Vh+(long)(16*(wid&3)+(lane>>2))*KP+(wid>>2)*32+(lane&3)*8;
  const unsigned kdst=lds0+LDS_K+wid*1024, vdst=lds0+LDS_V+wid*1024;
  #define PT(t) (((t)<2)?((t)^1):(t))
  #define DMA_K(t,slot) glds16(ksrc+(long)PT(t)*KVBLK*KP,(unsigned)__builtin_amdgcn_readfirstlane(kdst+(slot)))
  #define DMA_V(t,slot) glds16(vsrc+(long)PT(t)*KVBLK*KP,(unsigned)__builtin_amdgcn_readfirstlane(vdst+(slot)))
  const int vb0=(int)(lds0+LDS_V)+((lane>>4)&1)*32+(lane&3)*8+(4*hi+((lane&15)>>2))*64;
  const char*Kbase=shm+LDS_K; bf16x8 kf[8];
  const lds_cptr shm3=(lds_cptr)shm; const lds_cptr kp0=shm3+LDS_K+hi*1024+r32*16; const lds_cptr vp0=shm3+LDS_V+((lane>>4)&1)*32+(lane&3)*8+(4*hi+((lane&15)>>2))*64;
  const int NT=(q0+QB)/KVBLK;
  DMA_K(0,0);DMA_V(0,0);DMA_K(1,SLOTB);
  bf16x8 qr[4];
  #pragma unroll
  for(int d0=0;d0<4;++d0)qr[d0]=*reinterpret_cast<const bf16x8*>(&Qw[(long)r32*QP+d0*16+hi*8]);
  { const float*cg=CQ+(long)(b*NHEAD+h)*SEQ; __attribute__((address_space(3))) float*ct=(__attribute__((address_space(3))) float*)((lds_cptr)shm+LDS_CT); const int ncp=q0+QB;
    for(int i=tid;i<ncp;i+=NW*64)ct[i]=cg[i]; }
  const lds_cptr ctp=(lds_cptr)shm+LDS_CT+hi*16;
  float mhat=0.f,l_reg=0.f;f32x16 o[2];o[0]=f32x16{};o[1]=f32x16{};
  const float cqp=CQ[(long)(b*NHEAD+h)*SEQ+q0+wid*QBLK+r32];
  const f32x16 negm=f32x16{};
  float base=cqp;
  const int qrel=wid*QBLK+r32;
  #define CMASK(P0,P1,t) do{int jb_=(t)-(NT-4); if(jb_>=0)cmask(P0,P1,jb_,qrel,hi);}while(0)
  bool resc=false;
  #define START(P0,P1) do{ const float rm=rowmax(P0,P1); resc=false; \
    { const float dl=rm; mhat=fadd_s(mhat,dl); \
      _Pragma("unroll") for(int r=0;r<16;++r){P0[r]=fsub_s(P0[r],dl);P1[r]=fsub_s(P1[r],dl);} \
      base=cqp-mhat; } \
    _Pragma("unroll") for(int r=0;r<16;++r)P0[r]=__builtin_amdgcn_exp2f(P0[r]); }while(0)
  #define RESC() do{ if(resc){ asm volatile("s_waitcnt lgkmcnt(0)":::"memory"); \
      _Pragma("unroll") for(int d_=0;d_<2;++d_) _Pragma("unroll") for(int r=0;r<16;++r)o[d_][r]*=wsf[crow(r,hi)]; } }while(0)
  #define CKSUB(C0,C1,t) do{ const lds_cptr cp_=ctp+256*PT(t); \
    const f32x2_t b2_={base,base}; \
    _Pragma("unroll") for(int g_=0;g_<4;++g_){ const f32x4_t a_=*(const __attribute__((address_space(3))) f32x4_t*)(cp_+32*g_); \
      f32x2_t x_={C0[4*g_],C0[4*g_+1]},y_={C0[4*g_+2],C0[4*g_+3]}; x_=(x_-(f32x2_t){a_[0],a_[1]})+b2_; y_=(y_-(f32x2_t){a_[2],a_[3]})+b2_; \
      C0[4*g_]=x_[0];C0[4*g_+1]=x_[1];C0[4*g_+2]=y_[0];C0[4*g_+3]=y_[1]; } SBAR(); \
    _Pragma("unroll") for(int g_=0;g_<4;++g_){ const f32x4_t a_=*(const __attribute__((address_space(3))) f32x4_t*)(cp_+128+32*g_); \
      f32x2_t x_={C1[4*g_],C1[4*g_+1]},y_={C1[4*g_+2],C1[4*g_+3]}; x_=(x_-(f32x2_t){a_[0],a_[1]})+b2_; y_=(y_-(f32x2_t){a_[2],a_[3]})+b2_; \
      C1[4*g_]=x_[0];C1[4*g_+1]=x_[1];C1[4*g_+2]=y_[0];C1[4*g_+3]=y_[1]; } SBAR(); }while(0)
  f32x16 pA0,pA1,pB0,pB1;
  int sl_prev=0,sl_cur=0,sl_next=SLOTB;
  #define ROT() do{sl_prev=sl_cur;sl_cur=sl_next;sl_next=(sl_next==(NSLOT-1)*SLOTB)?0:sl_next+SLOTB;}while(0)
  DMA_K(2,2*SLOTB);
  WAIT_BAR(3);
  qkt(pA0,pA1,Kbase,qr,negm,r32,hi);asm volatile("s_nop 15\n\ts_nop 7":"+v"(pA0),"+v"(pA1));CKSUB(pA0,pA1,0);CMASK(pA0,pA1,0);
  START(pA0,pA1);
  _Pragma("unroll") for(int r=0;r<16;++r)pA1[r]=__builtin_amdgcn_exp2f(pA1[r]);
  WAIT_BAR(0);
  DMA_K(3,0);DMA_V(1,SLOTB);
  ROT();
  kload8(kf,kp0+sl_cur);
  WAIT_BAR(2);
  s16x4 vlo[8],vhi[8]; u32x4 pw0,pw1,pw2,pw3;
  #define PKW(P,B) cvtpk_s(P[B],P[B+1])
  #define PAF(k) __builtin_bit_cast(bf16x8,pw##k)
  #define VFR(i) (bf16x8){vlo[i][0],vlo[i][1],vlo[i][2],vlo[i][3],vhi[i][0],vhi[i][1],vhi[i][2],vhi[i][3]}
  #define PIN(x) asm volatile("":"+v"(x))
  #define MX3(a,b,c) __builtin_fmaxf(__builtin_fmaxf((a),(b)),(c))
  #define GAPA(MF,A0,A1,A2,A3,W0,W1,PW) do{ MF; sacc+=A0; sacc+=A1; sacc+=A2; sacc+=A3; PIN(sacc); W0; W1; PIN(PW); SBAR(); }while(0)
  #define EX(v) __builtin_amdgcn_exp2f(v)
  #define GAPB(MF,X,B) do{ MF; X[B]=EX(X[B]); X[B+1]=EX(X[B+1]); X[B+2]=EX(X[B+2]); X[B+3]=EX(X[B+3]); PIN(X); SBAR(); }while(0)
  #define VRD(i) do{ vlo[i]=vtr(vp_+(((i)>>2)*4096+((i)&3)*1024)); vhi[i]=vtr(vp_+(((i)>>2)*4096+((i)&3)*1024+512)); }while(0)
  #define KRD(G,j) do{ if(G){ kload2(kf,kp0+sl_next,j); SBAR(); } }while(0)
  #define STEP(C0,C1,P0,P1,t,GK,GV,GL) do{ SBAR(); \
    const lds_cptr vp_=vp0+sl_prev; \
    VRD(0); SBAR(); float sacc=(P0[0]+P0[1]); \
    GAPA(C0=__builtin_amdgcn_mfma_f32_32x32x16_bf16(kf[0],qr[0],negm,0,0,0), P0[2],P0[3],P0[4],P0[5],     pw0[0]=PKW(P0,0), pw0[1]=PKW(P0,2), pw0); \
    VRD(4); SBAR(); GAPA(C1=__builtin_amdgcn_mfma_f32_32x32x16_bf16(kf[1],qr[0],negm,0,0,0), P0[6],P0[7],P0[8],P0[9],     pw0[2]=PKW(P0,4), pw0[3]=PKW(P0,6), pw0); \
    VRD(1); SBAR(); GAPA(C0=__builtin_amdgcn_mfma_f32_32x32x16_bf16(kf[2],qr[1],C0,0,0,0),   P0[10],P0[11],P0[12],P0[13], pw1[0]=PKW(P0,8), pw1[1]=PKW(P0,10), pw1); \
    VRD(5); SBAR(); GAPA(C1=__builtin_amdgcn_mfma_f32_32x32x16_bf16(kf[3],qr[1],C1,0,0,0),   P0[14],P0[15],P1[0],P1[1],   pw1[2]=PKW(P0,12),pw1[3]=PKW(P0,14), pw1); \
    VRD(2); SBAR(); GAPA(C0=__builtin_amdgcn_mfma_f32_32x32x16_bf16(kf[4],qr[2],C0,0,0,0),   P1[2],P1[3],P1[4],P1[5],     pw2[0]=PKW(P1,0), pw2[1]=PKW(P1,2), pw2); \
    VRD(6); SBAR(); GAPA(C1=__builtin_amdgcn_mfma_f32_32x32x16_bf16(kf[5],qr[2],C1,0,0,0),   P1[6],P1[7],P1[8],P1[9],     pw2[2]=PKW(P1,4), pw2[3]=PKW(P1,6), pw2); \
    VRD(3); SBAR(); GAPA(C0=__builtin_amdgcn_mfma_f32_32x32x16_bf16(kf[6],qr[3],C0,0,0,0),   P1[10],P1[11],P1[12],P1[13], pw3[0]=PKW(P1,8), pw3[1]=PKW(P1,10), pw3); \
    VRD(7); SBAR(); GAPA(C1=__builtin_amdgcn_mfma_f32_32x32x16_bf16(kf[7],qr[3],C1,0,0,0),   P1[14],P1[15],0.f,0.f,       pw3[2]=PKW(P1,12),pw3[3]=PKW(P1,14), pw3); \
    l_reg+=sacc; \
    if(GK){DMA_K((t)+3,sl_cur);} if(GV){DMA_V((t)+1,sl_next);} \
    CKSUB(C0,C1,t); CMASK(C0,C1,t); \
    { float a=MX3(C0[0],C0[1],C1[0]),b=MX3(C0[2],C0[3],C1[1]); a=MX3(a,C1[2],C1[3]); \
      _Pragma("unroll") for(int r=4;r<16;r+=4){a=MX3(a,C0[r],C0[r+1]);b=MX3(b,C0[r+2],C0[r+3]);a=MX3(a,C1[r],C1[r+1]);b=MX3(b,C1[r+2],C1[r+3]);} \
      float rm=__builtin_fmaxf(a,b); { auto rr=__builtin_amdgcn_permlane32_swap(__float_as_uint(rm),__float_as_uint(rm),false,false); rm=__builtin_fmaxf(__uint_as_float(rr[0]),__uint_as_float(rr[1])); } \
      resc=false; \
      if(__builtin_expect(__any(rm>(float)THRL),0)){ const float dl=__builtin_fmaxf(rm,0.f); mhat+=dl; \
        _Pragma("unroll") for(int r=0;r<16;++r){C0[r]-=dl;C1[r]-=dl;} \
        base=cqp-mhat; \
        const float f=__builtin_amdgcn_exp2f(-dl); l_reg*=f; if(hi==0)wsf[r32]=f; resc=true; } } \
    SBAR(); \
    GAPB(o[0]=__builtin_amdgcn_mfma_f32_32x32x16_bf16(PAF(0),VFR(0),o[0],0,0,0), C0,0); \
    GAPB(o[1]=__builtin_amdgcn_mfma_f32_32x32x16_bf16(PAF(0),VFR(4),o[1],0,0,0), C0,4); \
    KRD(GL,0); GAPB(o[0]=__builtin_amdgcn_mfma_f32_32x32x16_bf16(PAF(1),VFR(1),o[0],0,0,0), C0,8); \
    KRD(GL,1); GAPB(o[1]=__builtin_amdgcn_mfma_f32_32x32x16_bf16(PAF(1),VFR(5),o[1],0,0,0), C0,12); \
    KRD(GL,2); GAPB(o[0]=__builtin_amdgcn_mfma_f32_32x32x16_bf16(PAF(2),VFR(2),o[0],0,0,0), C1,0); \
    KRD(GL,3); GAPB(o[1]=__builtin_amdgcn_mfma_f32_32x32x16_bf16(PAF(2),VFR(6),o[1],0,0,0), C1,4); \
    GAPB(o[0]=__builtin_amdgcn_mfma_f32_32x32x16_bf16(PAF(3),VFR(3),o[0],0,0,0), C1,8); \
    GAPB(o[1]=__builtin_amdgcn_mfma_f32_32x32x16_bf16(PAF(3),VFR(7),o[1],0,0,0), C1,12); \
    }while(0)
  int t=1;
  #undef CMASK
  #define CMASK(P0,P1,t) do{}while(0)
  for(;t+5<NT;t+=2){
    STEP(pB0,pB1,pA0,pA1,t,true,true,true);     WAIT_BAR(2); RESC(); ROT();
    STEP(pA0,pA1,pB0,pB1,t+1,true,true,true);   WAIT_BAR(2); RESC(); ROT();
  }
  #undef CMASK
  #define CMASK(P0,P1,t) do{int jb_=(t)-(NT-4); if(jb_>=0)cmask(P0,P1,jb_,qrel,hi);}while(0)
  #define ENDW(tt) do{ if((tt)+3<NT){WAIT_BAR(2);} else if((tt)+2<NT){WAIT_BAR(1);} else {WAIT_BAR(0);} }while(0)
  for(;t+1<NT;t+=2){
    STEP(pB0,pB1,pA0,pA1,t,(t+3<NT),(t+1<NT),(t+1<NT));       ENDW(t);   RESC(); ROT();
    STEP(pA0,pA1,pB0,pB1,t+1,(t+4<NT),(t+2<NT),(t+2<NT));     ENDW(t+1); RESC(); ROT();
  }
  STEP(pB0,pB1,pA0,pA1,NT-1,false,false,false); RESC();
  { float sacc=pB0[0]+pB0[1]; _Pragma("unroll") for(int r=2;r<16;++r)sacc+=pB0[r]; _Pragma("unroll") for(int r=0;r<16;++r)sacc+=pB1[r]; l_reg+=sacc;
    pw0=(u32x4){PKW(pB0,0),PKW(pB0,2),PKW(pB0,4),PKW(pB0,6)};pw1=(u32x4){PKW(pB0,8),PKW(pB0,10),PKW(pB0,12),PKW(pB0,14)};pw2=(u32x4){PKW(pB1,0),PKW(pB1,2),PKW(pB1,4),PKW(pB1,6)};pw3=(u32x4){PKW(pB1,8),PKW(pB1,10),PKW(pB1,12),PKW(pB1,14)};
    SBAR(); pv(o,vb0+sl_cur,PAF(0),PAF(1),PAF(2),PAF(3)); }
  #undef PKW
  #undef PAF
  #undef VFR
  #undef PIN
  #undef MX3
  #undef GAPA
  #undef GAPB
  #undef EX
  #undef VRD
  #undef KRD
  #undef STEP
  #undef ENDW
  {auto rr=__builtin_amdgcn_permlane32_swap(__float_as_uint(l_reg),__float_as_uint(l_reg),false,false);l_reg=__uint_as_float(rr[0])+__uint_as_float(rr[1]);}
  int lane_e=lane_id(); asm volatile("":"+v"(lane_e));
  const int r32e=lane_e&31,hie=lane_e>>5; float*wsfe=(float*)(shm+LDS_WS)+wid*64;
  if(hie==0)wsfe[32+r32e]=l_reg;asm volatile("s_waitcnt lgkmcnt(0)":::"memory");
  float rli[16];
  #pragma unroll
  for(int r=0;r<16;++r)rli[r]=__builtin_amdgcn_rcpf(wsfe[32+crow(r,hie)]);
  bf16*Ow=O+(rowbase+q0+wid*QBLK)*QP+h*D;
  { bf16*stg=(bf16*)(shm+LDS_OST)+wid*2048;
    #pragma unroll
    for(int r=0;r<16;++r){const int orow=crow(r,hie);
      #pragma unroll
      for(int d0=0;d0<2;++d0)stg[orow*64+d0*32+r32e]=__float2bfloat16(o[d0][r]*rli[r]);}
    asm volatile("s_waitcnt lgkmcnt(0)":::"memory");
    #pragma unroll
    for(int i=0;i<4;++i){const int row=i*8+(lane_e>>3),ch=lane_e&7; const u32x4 v=*(const u32x4*)(stg+row*64+ch*8); ATTN_STORE16(Ow+(long)row*QP+ch*8,v);} }
  asm volatile("s_waitcnt lgkmcnt(0)\n\ts_barrier":::"memory");
  #undef DMA_K
  #undef PT
  #undef CKSUB
  #undef DMA_V
  #undef CMASK
  #undef START
  #undef RESC
  #undef ROT
}
constexpr int ATTN_LDS_BYTES=LDS_BYTES;
struct AttnTensors { const bf16* Q; const bf16* K; const bf16* V; bf16* O; const float* CQ; };
struct AttnUnit { int bh; int qb; };
struct StaticOrder {
  int vcu;
  __device__ __forceinline__ explicit StaticOrder(int grid,int block):vcu((block%8)*(grid/8)+block/8){}
  __device__ __forceinline__ bool next(int i,AttnUnit&u)const{ if(i>=2)return false; const int s=vcu&7; u.bh=vcu>>3; u.qb=(i==0)?s:15-s; return true; }
  __device__ __forceinline__ void a_ready(const AttnUnit&)const{}
  __device__ __forceinline__ void done(const AttnUnit&)const{}
};
struct QueueOrder {
  unsigned* ctr; volatile __attribute__((address_space(3))) unsigned* slot; bool t0;
  __device__ __forceinline__ bool next(int,AttnUnit&u)const{ if(t0)*slot=atomicAdd(ctr,1u); __syncthreads(); const unsigned idx=(unsigned)__builtin_amdgcn_readfirstlane((int)*slot);
    if(idx>=(unsigned)(BATCH*NHEAD*NQB))return false; u.qb=NQB-1-(int)(idx>>5); u.bh=(int)(idx&31); return true; }
  __device__ __forceinline__ void a_ready(const AttnUnit&)const{}
  __device__ __forceinline__ void done(const AttnUnit&)const{}
};
template<class Sched,int THRL=8> __device__ __forceinline__ void attn_phase(char*lds,const AttnTensors&T,const Sched&S,const int wave_s){
  AttnUnit u;
  for(int i=0;S.next(i,u);++i){ S.a_ready(u); attn_unit<THRL>(u.bh/NHEAD,u.bh%NHEAD,u.qb,T.Q,T.K,T.V,T.O,T.CQ,lds,wave_s); S.done(u); }
}
#undef SBAR
#undef WAIT_BAR
}

namespace dn {
typedef short bf16x8 __attribute__((ext_vector_type(8)));
typedef float f32x16 __attribute__((ext_vector_type(16)));
typedef float f32x4 __attribute__((ext_vector_type(4)));
typedef float f32x2 __attribute__((ext_vector_type(2)));
typedef unsigned u32x4 __attribute__((ext_vector_type(4)));
typedef unsigned u32x2 __attribute__((ext_vector_type(2)));
#define DLAS __attribute__((address_space(3)))
constexpr int NCH = 66, NITEM = 16 * 65;
constexpr int IMG_W = 0, IMG_Q = 16384, IMG_K = 32768, IMG_A = 49152, IMG_BYTES = 57344;
constexpr float QSCALE = 0.08838834764831845f;
__device__ __forceinline__ int img_off128(int m, int k) { const int ch = 2 * (k >> 4) + ((k >> 2) & 1), pos = 4 * ((k >> 3) & 1) + (k & 3); return m * 256 + ((ch ^ (m & 15)) << 4) + pos * 2; }
__device__ __forceinline__ int img_off64(int m, int k)  { const int ch = 2 * (k >> 4) + ((k >> 2) & 1), pos = 4 * ((k >> 3) & 1) + (k & 3); return m * 128 + ((ch ^ ((m >> 1) & 7)) << 4) + pos * 2; }
__device__ __forceinline__ float bfl(unsigned w) { return __builtin_bit_cast(float, w << 16); }
__device__ __forceinline__ float bfh(unsigned w) { return __builtin_bit_cast(float, w & 0xffff0000u); }
typedef __bf16 bf16x2_t __attribute__((ext_vector_type(2)));
__device__ __forceinline__ unsigned pkbf(float lo, float hi) { const f32x2 v = {lo, hi}; return __builtin_bit_cast(unsigned, __builtin_convertvector(v, bf16x2_t)); }
__device__ __forceinline__ float wsum(float v) {
#pragma unroll
    for (int o = 1; o < 64; o <<= 1) v += __shfl_xor(v, o);
    return v;
}
struct PrepArgs { const bf16* DQKV; const float* cw; const float* GG; const float* BT; unsigned char* PREP; float* U; float* CD; unsigned* FLAG; unsigned* TS; };
constexpr int L_QB = 0, L_KB = 17408, L_RHS = 34816, L_AM = 100352, L_AIMG = 117760, L_SC = 125952, L_IMG = L_RHS;

template <int J> __device__ __forceinline__ void solve2_load(f32x4 (&C)[8], int amt_h) {
#pragma unroll
    for (int g = 0; g < 8; ++g) C[g] = *(const DLAS f32x4*)((const DLAS unsigned char*)(size_t)0 + amt_h + (J * 68 + 4 * g) * 4);
}
template <int J> __device__ __forceinline__ float solve2_xj(const float (&x)[32]) {
    const float own = x[J & 31]; const auto rr = __builtin_amdgcn_permlane32_swap(__float_as_uint(own), __float_as_uint(own), false, false);
    return J < 32 ? __uint_as_float(rr[0]) : __uint_as_float(rr[1]);
}
template <int J> __device__ __forceinline__ void solve2_apply(float (&x)[32], const f32x4 (&C)[8], float xj) {
#pragma unroll
    for (int g = 0; g < 8; ++g) { x[4 * g] -= C[g].x * xj; x[4 * g + 1] -= C[g].y * xj; x[4 * g + 2] -= C[g].z * xj; x[4 * g + 3] -= C[g].w * xj; }
}
template <int J> __device__ __forceinline__ void solve2_rows(float (&x)[32], f32x4 (&CA)[8], f32x4 (&CB)[8], int amt_h) {
    if constexpr (J < 63) {
        const float xj = solve2_xj<J>(x);
        if constexpr (J + 1 < 63) { asm volatile("" : "+v"(amt_h) : "v"(xj)); solve2_load<J + 1>(CB, amt_h); }
        solve2_apply<J>(x, CA, xj);
        solve2_rows<J + 1>(x, CB, CA, amt_h);
    }
}
#define DN_FRESH_LANE() asm volatile("" : "+v"(lane))
#define PSTAMP(i) do { if (PROBE_TS && P.TS && wave == 0 && lane == 0) __hip_atomic_store(P.TS + (i), (unsigned)__builtin_amdgcn_s_memrealtime(), __ATOMIC_RELAXED, __HIP_MEMORY_SCOPE_AGENT); } while (0)
__device__ __forceinline__ void prep_item(DLAS unsigned char* lds, const PrepArgs& P, int bh, int n, int wave, int lane) {
    DN_FRESH_LANE(); PSTAMP(0);
    const int b = bh >> 2, h = bh & 3; const size_t rowbase = (size_t)b * LP + 64 * n; const int item = bh * NCH + n;
    int vz = 0; asm volatile("" : "+v"(vz));
    DLAS float* SCf = (DLAS float*)(lds + L_SC + vz);
    if (wave == 0) { const float g = P.GG[(size_t)bh * LP + 64 * n + lane], be = P.BT[(size_t)bh * LP + 64 * n + lane]; float gc = g;
#pragma unroll
        for (int o = 1; o < 64; o <<= 1) { const float t = __shfl_up(gc, o); if (lane >= o) gc += t; }
        const float gl = __shfl(gc, 63);
        SCf[lane] = gc; SCf[64 + lane] = be; SCf[128 + lane] = __expf(gc); SCf[192 + lane] = __expf(gl - gc); SCf[256 + lane] = be * __expf(gc);
        if (lane == 63) P.CD[item] = __expf(gc); }
    { const int r0 = 8 * wave;
      unsigned u[3][11]; float w0[3][4], w1[3][4];
      const unsigned lo4 = 4u * (unsigned)lane, lo8 = 8u * (unsigned)lane;
#pragma unroll
      for (int which = 0; which < 3; ++which) { const int colu = which * 512 + h * 128;
        const unsigned char* wb = (const unsigned char*)(P.cw + colu); const unsigned char* ub = (const unsigned char*)(P.DQKV + (rowbase + r0 - 3) * 1536 + colu);
#pragma unroll
        for (int i = 0; i < 4; ++i) { const f32x2 wv = *(const f32x2*)(wb + (size_t)i * 1536 * 4 + lo8); w0[which][i] = wv.x; w1[which][i] = wv.y; }
#pragma unroll
        for (int rr = 0; rr < 11; ++rr) u[which][rr] = *(const unsigned*)(ub + (size_t)rr * 1536 * 2 + lo4); }
#pragma unroll
      for (int which = 0; which < 3; ++which) { float a0[8], a1[8], ss[8];
#pragma unroll
        for (int r = 0; r < 8; ++r) { float x0 = 0.f, x1 = 0.f;
#pragma unroll
            for (int i = 0; i < 4; ++i) { x0 += w0[which][i] * bfl(u[which][r + i]); x1 += w1[which][i] * bfh(u[which][r + i]); }
            x0 = x0 * __builtin_amdgcn_rcpf(1.f + __expf(-x0)); x1 = x1 * __builtin_amdgcn_rcpf(1.f + __expf(-x1)); a0[r] = x0; a1[r] = x1; ss[r] = x0 * x0 + x1 * x1; }
        if (which < 2) {
#pragma unroll
            for (int o = 1; o < 64; o <<= 1)
#pragma unroll
                for (int r = 0; r < 8; ++r) ss[r] += __shfl_xor(ss[r], o);
#pragma unroll
            for (int r = 0; r < 8; ++r) { const float rs = rsqrtf(ss[r] + EPS); a0[r] *= rs; a1[r] *= rs; } }
#pragma unroll
        for (int r = 0; r < 8; ++r) { const int row = r0 + r;
            if (which < 2) { *(DLAS unsigned*)(lds + (which == 0 ? L_QB : L_KB) + row * 272 + 4 * lane) = pkbf(a0[r], a1[r]);
                if (which == 1) *(DLAS f32x2*)(lds + L_RHS + row * 1024 + 512 + 8 * lane) = (f32x2){a0[r], a1[r]}; }
            else *(DLAS f32x2*)(lds + L_RHS + row * 1024 + 8 * lane) = (f32x2){a0[r], a1[r]}; } } }
    __syncthreads();
    DN_FRESH_LANE(); PSTAMP(1);
    { const int which = wave >> 2, ti = (wave >> 1) & 1, tj = wave & 1, m = lane & 31, hh = lane >> 5;
      const DLAS unsigned char* ap = lds + (which == 0 ? L_KB : L_QB) + (32 * ti + m) * 272 + hh * 16; const DLAS unsigned char* bp = lds + L_KB + (32 * tj + m) * 272 + hh * 16;
      f32x16 acc = f32x16{};
#pragma unroll
      for (int s = 0; s < 8; ++s) acc = __builtin_amdgcn_mfma_f32_32x32x16_bf16(*(const DLAS bf16x8*)(ap + 32 * s), *(const DLAS bf16x8*)(bp + 32 * s), acc, 0, 0, 0);
      const int col = 32 * tj + m; const float gcc = SCf[col];
#pragma unroll
      for (int r = 0; r < 16; ++r) { const int row = 32 * ti + (r & 3) + 8 * (r >> 2) + 4 * hh; const float d = __expf(fminf(SCf[row] - gcc, 0.f));
          if (which == 0) { *(DLAS float*)(lds + L_AM + (row * 68 + col) * 4) = col < row ? SCf[64 + row] * acc[r] * d : 0.f; }
          else { const float v = col <= row ? acc[r] * QSCALE * d : 0.f; *(DLAS unsigned short*)(lds + L_AIMG + img_off64(row, col)) = (unsigned short)(pkbf(v, 0.f) & 0xffffu); } } }
    __syncthreads();
    DN_FRESH_LANE(); PSTAMP(2);
    if (wave < 4) {
        const int c = 64 * wave + lane; float x[64];
#pragma unroll
        for (int i = 0; i < 64; ++i) { const float sc = (c < 128) ? SCf[64 + i] : SCf[64 + i] * SCf[128 + i]; x[i] = *(const DLAS float*)(lds + L_RHS + (i * 256 + c) * 4) * sc; }
        __syncthreads();
#pragma unroll
        for (int i = 1; i < 64; ++i) { float s0 = 0.f, s1 = 0.f, s2 = 0.f, s3 = 0.f;
#pragma unroll
            for (int j4 = 0; j4 < (i + 3) / 4; ++j4) { const f32x4 a = *(const DLAS f32x4*)(lds + vz + L_AM + (i * 68 + 4 * j4) * 4);
                s0 += a.x * x[4 * j4]; s1 += a.y * x[4 * j4 + 1]; s2 += a.z * x[4 * j4 + 2]; s3 += a.w * x[4 * j4 + 3]; }
            x[i] -= (s0 + s1) + (s2 + s3); __builtin_amdgcn_sched_barrier(0); }
        if (c < 128) {
            float* up = P.U + (size_t)item * 8192 + (size_t)(c >> 5) * 2048 + (c & 31) * 16;
#pragma unroll
            for (int t = 0; t < 2; ++t)
#pragma unroll
                for (int hi = 0; hi < 2; ++hi)
#pragma unroll
                    for (int q = 0; q < 4; ++q) { const int rb = 32 * t + 8 * q + 4 * hi; *(f32x4*)(up + t * 1024 + hi * 512 + 4 * q) = (f32x4){x[rb], x[rb + 1], x[rb + 2], x[rb + 3]}; }
        } else { const int dk = c - 128;
#pragma unroll
            for (int i = 0; i < 64; ++i) *(DLAS unsigned short*)(lds + L_IMG + IMG_W + img_off128(i, dk)) = (unsigned short)(pkbf(-x[i], 0.f) & 0xffffu); }
    } else {
        __syncthreads();
        const int t = (wave - 4) * 64 + lane;
        { const int i = t >> 2, d0 = (t & 3) * 32; const float sc = QSCALE * SCf[128 + i];
#pragma unroll
          for (int g8 = 0; g8 < 4; ++g8) { const u32x4 qv = *(const DLAS u32x4*)(lds + L_QB + i * 272 + (d0 + 8 * g8) * 2);
              u32x2 lo, hi2; lo.x = pkbf(bfl(qv.x) * sc, bfh(qv.x) * sc); lo.y = pkbf(bfl(qv.y) * sc, bfh(qv.y) * sc); hi2.x = pkbf(bfl(qv.z) * sc, bfh(qv.z) * sc); hi2.y = pkbf(bfl(qv.w) * sc, bfh(qv.w) * sc);
              *(DLAS u32x2*)(lds + L_IMG + IMG_Q + img_off128(i, d0 + 8 * g8)) = lo; *(DLAS u32x2*)(lds + L_IMG + IMG_Q + img_off128(i, d0 + 8 * g8 + 4)) = hi2; } }
        { const int d = t >> 1, g0 = (t & 1) * 8;
#pragma unroll
          for (int g = 0; g < 8; ++g) { const int c0 = 4 * (g0 + g); float v[4];
#pragma unroll
              for (int e = 0; e < 4; ++e) v[e] = bfl((unsigned)*(const DLAS unsigned short*)(lds + L_KB + (c0 + e) * 272 + d * 2)) * SCf[192 + c0 + e];
              u32x2 w; w.x = pkbf(v[0], v[1]); w.y = pkbf(v[2], v[3]); *(DLAS u32x2*)(lds + L_IMG + IMG_K + img_off64(d, c0)) = w; } }
    }
    __syncthreads();
    DN_FRESH_LANE(); PSTAMP(3);
    { const int t = wave * 64 + lane; unsigned char* dst = P.PREP + (size_t)item * IMG_BYTES;
#pragma unroll
      for (int p = 0; p < 6; ++p) *(u32x4*)(dst + (p * 512 + t) * 16) = *(const DLAS u32x4*)(lds + L_IMG + (p * 512 + t) * 16);
      *(u32x4*)(dst + IMG_A + t * 16) = *(const DLAS u32x4*)(lds + L_AIMG + t * 16); }
    asm volatile("s_waitcnt vmcnt(0)" ::: "memory");
    __syncthreads(); PSTAMP(4);
    if (wave == 0 && lane == 0) { __builtin_amdgcn_fence(__ATOMIC_RELEASE, "agent"); asm volatile("s_waitcnt vmcnt(0)" ::: "memory"); __hip_atomic_store(P.FLAG + item, 1u, __ATOMIC_RELAXED, __HIP_MEMORY_SCOPE_AGENT); }
    PSTAMP(5);
}
struct RecArgs { const unsigned char* PREP; const float* U; const float* CD; const bf16* DZ; const float* onw; bf16* OD; const unsigned* FLAG; unsigned* TS; };
__device__ __forceinline__ void rec_wait_chunk(const unsigned* f) { unsigned sp = 0;
    while (__builtin_amdgcn_readfirstlane((int)__hip_atomic_load(f, __ATOMIC_RELAXED, __HIP_MEMORY_SCOPE_AGENT)) == 0) { __builtin_amdgcn_s_sleep(4); if (++sp > (1u << 22)) break; }
    __builtin_amdgcn_fence(__ATOMIC_ACQUIRE, "agent"); }
constexpr int R_IMG0 = 0, R_IMG1 = IMG_BYTES, R_OB = 2 * IMG_BYTES, R_BYTES = R_OB + 64 * 128 * 4;
#define DN_BAR() do { asm volatile("s_waitcnt vmcnt(0) lgkmcnt(0)" ::: "memory"); __builtin_amdgcn_s_barrier(); asm volatile("" ::: "memory"); } while (0)
__device__ __forceinline__ bf16x8 pack8(const f32x16& v, int s) { u32x4 w; w.x = pkbf(v[8 * s], v[8 * s + 1]); w.y = pkbf(v[8 * s + 2], v[8 * s + 3]); w.z = pkbf(v[8 * s + 4], v[8 * s + 5]); w.w = pkbf(v[8 * s + 6], v[8 * s + 7]); return __builtin_bit_cast(bf16x8, w); }
__device__ __forceinline__ void rec_dma_images(DLAS unsigned char* dst, const unsigned char* src, int w4, int lane) {
    const unsigned char* gp = src + w4 * 1024 + lane * 16; DLAS unsigned char* lp = dst + w4 * 1024;
#pragma unroll 1
    for (int p = 0; p < 14; ++p) { __builtin_amdgcn_global_load_lds((const unsigned*)gp, (DLAS unsigned*)lp, 16, 0, 0); gp += 4096; lp += 4096; }
}
struct ZPre { u32x4 z[4]; };
__device__ __forceinline__ void rec_load_z(ZPre& Z, const RecArgs& A, int b, int h, int n, int t256) {
    const int row = t256 >> 2, c0 = (t256 & 3) * 32; const bf16* zp = A.DZ + ((size_t)b * LP + 64 * n + row) * 512 + h * 128 + c0;
#pragma unroll
    for (int q = 0; q < 4; ++q) Z.z[q] = *(const u32x4*)(zp + 8 * q);
}
template <int MODE> __device__ __forceinline__ void rec_finalize(const DLAS unsigned char* lds, const RecArgs& A, const u32x4 (&RS)[18], const float (&nw)[32], int b, int h, int n, int t256) {
    const int row = t256 >> 2, c0 = (t256 & 3) * 32; const size_t grow = (size_t)b * LP + 64 * n + row;
    const DLAS float* op = (const DLAS float*)(lds + R_OB) + row * 128 + c0; float v[32]; float ss = 0.f;
#pragma unroll
    for (int q = 0; q < 8; ++q) { const f32x4 t = *(const DLAS f32x4*)(op + 4 * q); v[4 * q] = t.x; v[4 * q + 1] = t.y; v[4 * q + 2] = t.z; v[4 * q + 3] = t.w; ss += (t.x * t.x + t.y * t.y) + (t.z * t.z + t.w * t.w); }
    ss += __shfl_xor(ss, 1); ss += __shfl_xor(ss, 2);
    const float rs = rsqrtf(ss * (1.f / 128.f) + EPS);
    bf16* dst = A.OD + grow * 1024 + 512 + h * 128 + c0;
#pragma unroll
    for (int q = 0; q < 4; ++q) { const u32x4 z = RS[14 + q]; float zz[8] = {bfl(z.x), bfh(z.x), bfl(z.y), bfh(z.y), bfl(z.z), bfh(z.z), bfl(z.w), bfh(z.w)}; float r[8];
#pragma unroll
        for (int e = 0; e < 8; ++e) r[e] = v[8 * q + e] * rs * zz[e];
        u32x4 o; o.x = pkbf(r[0], r[1]); o.y = pkbf(r[2], r[3]); o.z = pkbf(r[4], r[5]); o.w = pkbf(r[6], r[7]); if (MODE == 0) *(u32x4*)(dst + 8 * q) = o; else asm volatile("" :: "v"(o)); }
}
#define CSTAMP(cond, i) do { if (PROBE_TS && MODE == 0 && A.TS && (cond)) __hip_atomic_store(A.TS + (i), (unsigned)__builtin_amdgcn_s_memrealtime(), __ATOMIC_RELAXED, __HIP_MEMORY_SCOPE_AGENT); } while (0)
#define DN_BAR_L() do { asm volatile("s_waitcnt lgkmcnt(0)" ::: "memory"); __builtin_amdgcn_s_barrier(); asm volatile("" ::: "memory"); } while (0)
template <int MODE> __device__ __forceinline__ void rec_chain(DLAS unsigned char* lds, const RecArgs& A, int bh, int wave, int lane) {
    const int b = bh >> 2, h = bh & 3;
    if (wave >= 4) {
        const int w4 = wave - 4, t256 = w4 * 64 + lane;
        const unsigned voff = (unsigned)t256 * 16u;
        const unsigned* flg = A.FLAG + bh * NCH;
        int ready = 0;
#define REC_ENSURE(k) do { if (MODE == 0) { unsigned sp_ = 0; bool adv_ = false; while (ready < (k)) { const int i_ = ready + 1 + (lane & 15); \
              const unsigned f_ = (i_ < NCH) ? __hip_atomic_load(flg + i_, __ATOMIC_RELAXED, __HIP_MEMORY_SCOPE_AGENT) : 0u; \
              const unsigned long long m_ = __ballot(f_ == 0u) & 0xffffull; const int run_ = m_ ? (int)__builtin_ctzll(m_) : 16; \
              if (run_ > 0) { ready += run_; adv_ = true; } else { __builtin_amdgcn_s_sleep(8); if (++sp_ > (1u << 20)) break; } } \
            if (adv_) __builtin_amdgcn_fence(__ATOMIC_ACQUIRE, "agent"); } } while (0)
        u32x4 R0[18], R1[18];
        const unsigned zoff = (unsigned)(((t256 >> 2) * 512 + (t256 & 3) * 32) * 2);
#define REC_LOADR(RS, nn, zn_) do { if ((zn_) < NCH) { const unsigned char* zb_ = (const unsigned char*)(A.DZ + ((size_t)b * LP + 64 * (zn_)) * 512 + h * 128); asm volatile("" : "+s"(zb_)); \
            _Pragma("unroll") for (int q = 0; q < 4; ++q) asm volatile("global_load_dwordx4 %0, %1, %2 offset:%c3" : "=v"(RS[14 + q]) : "v"(zoff), "s"(zb_), "i"(16 * q)); } \
        if ((nn) < NCH) { REC_ENSURE(nn); const unsigned char* g_ = A.PREP + (size_t)(bh * NCH + (nn)) * IMG_BYTES; asm volatile("" : "+s"(g_)); \
            _Pragma("unroll") for (int p = 0; p < 14; ++p) { const unsigned char* gp_ = g_ + p * 4096; asm volatile("global_load_dwordx4 %0, %1, %2" : "=v"(RS[p]) : "v"(voff), "s"(gp_)); } } } while (0)
#define REC_RETIRE(RS, n) do { if ((n) > 2 && (n) < 63) asm volatile("s_waitcnt vmcnt(22)" ::: "memory"); else asm volatile("s_waitcnt vmcnt(0)" ::: "memory"); \
        _Pragma("unroll") for (int p = 0; p < 18; ++p) asm volatile("" : "+v"(RS[p])); } while (0)
#define REC_STORER(RS, nn) do { DLAS unsigned char* d_ = lds + (((nn) & 1) ? R_IMG1 : R_IMG0) + t256 * 16; _Pragma("unroll") for (int p = 0; p < 14; ++p) *(DLAS u32x4*)(d_ + p * 4096) = RS[p]; } while (0)
#define REC_ITER(RS, n) do { CSTAMP((n) == 40 && t256 == 0, 10); \
            if (MODE != 1) { REC_RETIRE(RS, n); CSTAMP((n) == 40 && t256 == 0, 21); if ((n) > 1) rec_finalize<MODE>(lds, A, RS, nw, b, h, (n) - 1, t256); CSTAMP((n) == 40 && t256 == 0, 11); \
                if ((n) + 1 < NCH) REC_STORER(RS, (n) + 1); CSTAMP((n) == 40 && t256 == 0, 12); \
                REC_LOADR(RS, (n) + 3, (n) + 1); } CSTAMP((n) == 40 && t256 == 0, 13); \
            DN_BAR_L();        CSTAMP((n) == 40 && t256 == 0, 14); \
            DN_BAR_L();        CSTAMP((n) == 40 && t256 == 0, 15); } while (0)
        REC_LOADR(R1, 1, NCH); REC_LOADR(R0, 2, NCH);
        float nw[32];
#pragma unroll
        for (int q = 0; q < 8; ++q) { const f32x4 t = *(const f32x4*)(A.onw + (t256 & 3) * 32 + 4 * q); nw[4 * q] = t.x; nw[4 * q + 1] = t.y; nw[4 * q + 2] = t.z; nw[4 * q + 3] = t.w; }
        REC_RETIRE(R1, 0); REC_STORER(R1, 1); REC_LOADR(R1, 3, 1);
        DN_BAR_L();
        for (int n = 1; n + 1 < NCH; n += 2) { REC_ITER(R0, n); REC_ITER(R1, n + 1); }
        REC_ITER(R0, NCH - 1);
        if (MODE != 1) { REC_RETIRE(R1, 0); rec_finalize<MODE>(lds, A, R1, nw, b, h, NCH - 1, t256); }
#undef REC_LOADR
#undef REC_RETIRE
#undef REC_STORER
#undef REC_ITER
#undef REC_ENSURE
    } else {
        const int m = lane & 31, hh = lane >> 5;
        f32x16 S[4]; bf16x8 Sb[8]; f32x16 un[2];
#pragma unroll
        for (int d = 0; d < 4; ++d) S[d] = f32x16{};
#pragma unroll
        for (int s = 0; s < 8; ++s) Sb[s] = bf16x8{};
        if (MODE == 0) rec_wait_chunk(A.FLAG + bh * NCH + 1);
        { const float* up = A.U + (size_t)(bh * NCH + 1) * 8192 + wave * 2048 + lane * 16;
#pragma unroll
          for (int t = 0; t < 2; ++t) { const f32x4 a = *(const f32x4*)(up + t * 1024), bq = *(const f32x4*)(up + t * 1024 + 4), c = *(const f32x4*)(up + t * 1024 + 8), d = *(const f32x4*)(up + t * 1024 + 12);
              un[t] = (f32x16){a.x, a.y, a.z, a.w, bq.x, bq.y, bq.z, bq.w, c.x, c.y, c.z, c.w, d.x, d.y, d.z, d.w}; } }
        DN_BAR_L();
        const int c15 = (hh ^ (m & 15)) << 4, c7 = (hh ^ ((m >> 1) & 7)) << 4;
        const int aW0 = IMG_W + m * 256, aW1 = IMG_W + (32 + m) * 256, aQ0 = IMG_Q + m * 256, aQ1 = IMG_Q + (32 + m) * 256, aA0 = IMG_A + m * 128, aA1 = IMG_A + (32 + m) * 128, aK0 = IMG_K + m * 128;
#define FR(off) (*(const DLAS bf16x8*)(img + (off)))
#define SB_() __builtin_amdgcn_sched_barrier(0)
#define MF_(a, b, c) c = __builtin_amdgcn_mfma_f32_32x32x16_bf16(a, b, c, 0, 0, 0)
#define LD_G1(F, s) do { F[0] = FR(aW0 + ((32 * (s)) ^ c15)); F[1] = FR(aQ0 + ((32 * (s)) ^ c15)); F[2] = FR(aW1 + ((32 * (s)) ^ c15)); F[3] = FR(aQ1 + ((32 * (s)) ^ c15)); } while (0)
#define MM_G1(F, s) do { MF_(F[0], Sb[s], vn[0]); MF_(F[1], Sb[s], o[0]); MF_(F[2], Sb[s], vn[1]); MF_(F[3], Sb[s], o[1]); } while (0)
#define LD_G2(F, j) do { F[0] = FR(aA0 + ((32 * (2 * (j))) ^ c7)); F[1] = FR(aA1 + ((32 * (2 * (j))) ^ c7)); F[2] = FR(aA0 + ((32 * (2 * (j) + 1)) ^ c7)); F[3] = FR(aA1 + ((32 * (2 * (j) + 1)) ^ c7)); } while (0)
#define MM_G2(F, j) do { MF_(F[0], vb[2 * (j)], o[0]); MF_(F[1], vb[2 * (j)], o[1]); MF_(F[2], vb[2 * (j) + 1], o[0]); MF_(F[3], vb[2 * (j) + 1], o[1]); } while (0)
#define LD_G3(F, s) do { F[0] = FR(aK0 + ((32 * (s)) ^ c7)); F[1] = FR(aK0 + 32 * 128 + ((32 * (s)) ^ c7)); F[2] = FR(aK0 + 64 * 128 + ((32 * (s)) ^ c7)); F[3] = FR(aK0 + 96 * 128 + ((32 * (s)) ^ c7)); } while (0)
#define MM_G3(F, s) do { MF_(F[0], vb[s], S[0]); MF_(F[1], vb[s], S[1]); MF_(F[2], vb[s], S[2]); MF_(F[3], vb[s], S[3]); } while (0)
        for (int n = 1; n < NCH; ++n) {
            if (MODE == 2) { DN_BAR_L(); DN_BAR_L(); continue; }
            if (PROBE_TS && MODE == 0 && A.TS && wave == 0 && lane == 0 && (n % 10) == 0) __hip_atomic_store(A.TS + n / 10, (unsigned)__builtin_amdgcn_s_memrealtime(), __ATOMIC_RELAXED, __HIP_MEMORY_SCOPE_AGENT);
            const DLAS unsigned char* img = lds + ((n & 1) ? R_IMG1 : R_IMG0);
            const float cd = A.CD[bh * NCH + n];
            f32x16 vn[2], o[2]; bf16x8 fa[4], fb[4];
#pragma unroll
            for (int t = 0; t < 2; ++t) { vn[t] = un[t]; o[t] = f32x16{}; }
            CSTAMP(n == 40 && wave == 0 && lane == 0, 16);
            LD_G1(fa, 0); SB_();
            LD_G1(fb, 1); SB_(); MM_G1(fa, 0); S[0] = S[0] * cd; SB_();
            LD_G1(fa, 2); SB_(); MM_G1(fb, 1); S[1] = S[1] * cd; SB_();
            LD_G1(fb, 3); SB_(); MM_G1(fa, 2); S[2] = S[2] * cd; SB_();
            LD_G1(fa, 4); SB_(); MM_G1(fb, 3); S[3] = S[3] * cd; SB_();
            LD_G1(fb, 5); SB_(); MM_G1(fa, 4); SB_();
            LD_G1(fa, 6); SB_(); MM_G1(fb, 5); SB_();
            LD_G1(fb, 7); SB_(); MM_G1(fa, 6); SB_();
            LD_G2(fa, 0); SB_(); MM_G1(fb, 7); SB_(); CSTAMP(n == 40 && wave == 0 && lane == 0, 17);
            if (n + 1 < NCH) {
                const float* up = A.U + (size_t)(bh * NCH + n + 1) * 8192 + wave * 2048 + lane * 16;
#pragma unroll
                for (int t = 0; t < 2; ++t) { const f32x4 a = *(const f32x4*)(up + t * 1024), bq = *(const f32x4*)(up + t * 1024 + 4), c = *(const f32x4*)(up + t * 1024 + 8), d = *(const f32x4*)(up + t * 1024 + 12);
                    un[t] = (f32x16){a.x, a.y, a.z, a.w, bq.x, bq.y, bq.z, bq.w, c.x, c.y, c.z, c.w, d.x, d.y, d.z, d.w}; } }
            bf16x8 vb[4];
#pragma unroll
            for (int t = 0; t < 2; ++t) { vb[2 * t] = pack8(vn[t], 0); vb[2 * t + 1] = pack8(vn[t], 1); }
            SB_();
            LD_G2(fb, 1); SB_(); MM_G2(fa, 0); SB_();
            LD_G3(fa, 0); SB_(); MM_G2(fb, 1); SB_();
            LD_G3(fb, 1); SB_(); MM_G3(fa, 0); SB_();
            LD_G3(fa, 2); SB_(); MM_G3(fb, 1); SB_();
            LD_G3(fb, 3); SB_(); MM_G3(fa, 2); SB_();
            MM_G3(fb, 3); SB_();
#pragma unroll
            for (int d = 0; d < 4; ++d) { Sb[2 * d] = pack8(S[d], 0); Sb[2 * d + 1] = pack8(S[d], 1); }
            CSTAMP(n == 40 && wave == 0 && lane == 0, 18);
            DN_BAR_L();
            CSTAMP(n == 40 && wave == 0 && lane == 0, 19);
            { DLAS float* ob = (DLAS float*)(lds + R_OB) + 32 * wave + m;
#pragma unroll
              for (int t = 0; t < 2; ++t)
#pragma unroll
                  for (int r = 0; r < 16; ++r) ob[(32 * t + (r & 3) + 8 * (r >> 2) + 4 * hh) * 128] = o[t][r]; }
            DN_BAR_L();
            CSTAMP(n == 40 && wave == 0 && lane == 0, 20);
        }
    }
}
#undef FR
#undef SB_
#undef MF_
#undef LD_G1
#undef MM_G1
#undef LD_G2
#undef MM_G2
#undef LD_G3
#undef MM_G3
}

__device__ __forceinline__ float fsigmoid_g(float x) { return __builtin_amdgcn_rcpf(1.f + __builtin_amdgcn_exp2f(-LOG2E * x)); }
struct EpiG1 { static constexpr bool PERM = true, AFTER_DRAIN = false;
    bf16 *OD, *FK, *FV, *DQKV, *DZ; const float* onw;
    __device__ __forceinline__ void operator()(const pg8::f32x4 (&acc)[2][2][4][2], const pg8::Unit& u, int wr, int wc, int fr, int fq) const {
        const int pn = u.pn; bf16* base; int ldc, colt; float sc = 1.f;
        if (pn < 2) { base = OD; ldc = 1024; colt = pn * 256; sc = C2; }
        else if (pn < 4) { base = FK; ldc = 512; colt = (pn - 2) * 256; }
        else if (pn < 6) { base = FV; ldc = 512; colt = (pn - 4) * 256; }
        else if (pn < 12) { base = DQKV; ldc = 1536; colt = (pn - 6) * 256; }
        else { base = DZ; ldc = 512; colt = (pn - 12) * 256; }
        const int row0 = u.pm * 256 + wr * 64 + fr, col0 = colt + wc * 32 + 8 * fq;
#pragma unroll
        for (int ai = 0; ai < 2; ++ai)
#pragma unroll
            for (int m = 0; m < 4; ++m) { bf16* rowp = base + (size_t)(row0 + ai * 128 + m * 16) * ldc + col0;
#pragma unroll
                for (int bj = 0; bj < 2; ++bj) { pg8::f32x4 v0 = acc[ai][bj][m][0] * sc, v1 = acc[ai][bj][m][1] * sc; pg8::u32x4 w;
                    if (pn >= 12) { const int cw_ = (col0 + bj * 128) & 127; const pg8::f32x4 n0 = *(const pg8::f32x4*)(onw + cw_), n1 = *(const pg8::f32x4*)(onw + cw_ + 4);
#pragma unroll
                        for (int e = 0; e < 4; ++e) { v0[e] = v0[e] * fsigmoid_g(v0[e]) * n0[e]; v1[e] = v1[e] * fsigmoid_g(v1[e]) * n1[e]; } }
                    w.x = pg8::cvt_pk_bf16(v0[0], v0[1]); w.y = pg8::cvt_pk_bf16(v0[2], v0[3]); w.z = pg8::cvt_pk_bf16(v1[0], v1[1]); w.w = pg8::cvt_pk_bf16(v1[2], v1[3]);
                    *(pg8::u32x4*)(rowp + bj * 128) = w; } }
    }
};
struct SchedG1 { int c, G; const char* A; const char* B;
    __device__ __forceinline__ bool next(int i, pg8::Unit& u) const { int pm, pn; if (!pg8::static_tile(R / 256, 14, G, c, i, pm, pn)) return false;
        u.pm = pm; u.pn = pn; u.sub = 0; u.nt = 16; u.A = A + (size_t)pm * 256 * 1024 * 2; u.B = B + (size_t)pn * 256 * 1024 * 2; return true; }
    __device__ __forceinline__ void a_ready(const pg8::Unit&) const {}
    __device__ __forceinline__ void done(const pg8::Unit&) const {}
};

#define LAS __attribute__((address_space(3)))
typedef float f32x4 __attribute__((ext_vector_type(4)));
typedef unsigned v4u __attribute__((ext_vector_type(4)));
constexpr int NWAVES = 8, MISC_OFF = 147456, LDS_BYTES = MISC_OFF + 256;

#define LDS_WAIT() asm volatile("s_waitcnt lgkmcnt(0)" ::: "memory")
__device__ __forceinline__ unsigned pk2(float lo, float hi) { return f2bf(lo) | (f2bf(hi) << 16); }
__device__ __forceinline__ float wave_sum(float v) {
#pragma unroll
    for (int o = 1; o < 64; o <<= 1) v += __shfl_xor(v, o);
    return v;
}
__device__ __forceinline__ float fsigmoid(float x) { return __builtin_amdgcn_rcpf(1.f + __builtin_amdgcn_exp2f(-LOG2E * x)); }
__device__ __forceinline__ int nat_row0(int pm) { return (pm >> 4) * LP + 128 + (pm & 15) * 256; }
struct EpiBr { static constexpr bool PERM = true, AFTER_DRAIN = false;
    bf16* S; bf16* Y;
    __device__ __forceinline__ void operator()(const pg8::f32x4 (&acc)[2][2][4][2], const pg8::Unit& u, int wr, int wc, int fr, int fq) const {
        v4u* Sg = (v4u*)S + ((wr * 4 + wc) * 64 + fq * 16 + fr); const int sub = u.sub;
        const int row0 = u.pm * 256 + wr * 64 + fr, col0 = u.pn * 256 + wc * 32 + 8 * fq;
#pragma unroll
        for (int ai = 0; ai < 2; ++ai)
#pragma unroll
            for (int m = 0; m < 4; ++m)
#pragma unroll
                for (int bj = 0; bj < 2; ++bj) { const int idx = ((ai * 4 + m) * 2 + bj) * 512; const pg8::f32x4 v0 = acc[ai][bj][m][0], v1 = acc[ai][bj][m][1];
                    if ((sub & 1) == 0) { v4u w; w.x = pg8::cvt_pk_bf16(fsigmoid(v0[0]), fsigmoid(v0[1])); w.y = pg8::cvt_pk_bf16(fsigmoid(v0[2]), fsigmoid(v0[3]));
                        w.z = pg8::cvt_pk_bf16(fsigmoid(v1[0]), fsigmoid(v1[1])); w.w = pg8::cvt_pk_bf16(fsigmoid(v1[2]), fsigmoid(v1[3])); Sg[idx] = w; }
                    else { const v4u s = Sg[idx]; bf16* yp = Y + (size_t)(row0 + ai * 128 + m * 16) * 1024 + col0 + bj * 128;
                        float t[8]; t[0] = __builtin_bit_cast(float, s.x << 16) * v0[0]; t[1] = __builtin_bit_cast(float, s.x & 0xffff0000u) * v0[1]; t[2] = __builtin_bit_cast(float, s.y << 16) * v0[2]; t[3] = __builtin_bit_cast(float, s.y & 0xffff0000u) * v0[3];
                        t[4] = __builtin_bit_cast(float, s.z << 16) * v1[0]; t[5] = __builtin_bit_cast(float, s.z & 0xffff0000u) * v1[1]; t[6] = __builtin_bit_cast(float, s.w << 16) * v1[2]; t[7] = __builtin_bit_cast(float, s.w & 0xffff0000u) * v1[3];
                        if (sub == 3) { const v4u y = *(const v4u*)yp; t[0] += __builtin_bit_cast(float, y.x << 16); t[1] += __builtin_bit_cast(float, y.x & 0xffff0000u); t[2] += __builtin_bit_cast(float, y.y << 16); t[3] += __builtin_bit_cast(float, y.y & 0xffff0000u);
                            t[4] += __builtin_bit_cast(float, y.z << 16); t[5] += __builtin_bit_cast(float, y.z & 0xffff0000u); t[6] += __builtin_bit_cast(float, y.w << 16); t[7] += __builtin_bit_cast(float, y.w & 0xffff0000u); }
                        v4u w; w.x = pg8::cvt_pk_bf16(t[0], t[1]); w.y = pg8::cvt_pk_bf16(t[2], t[3]); w.z = pg8::cvt_pk_bf16(t[4], t[5]); w.w = pg8::cvt_pk_bf16(t[6], t[7]); *(v4u*)yp = w; } }
    }
};
struct SchedBr { int c, G; const char *HN, *OD, *WG, *WB;
    __device__ __forceinline__ bool next(int i, pg8::Unit& u) const { int pm, pn; if (!pg8::static_tile(64, 4, G, c, i >> 2, pm, pn)) return false;
        const int sub = i & 3; u.pm = pm; u.pn = pn; u.sub = sub; const size_t arow = (size_t)nat_row0(pm) * 2048;
        if ((sub & 1) == 0) { u.nt = 16; u.A = HN + arow; u.B = WG + (size_t)((sub >> 1) * 1024 + pn * 256) * 2048; }
        else { u.nt = 8; u.A = OD + arow + (sub >> 1) * 1024; u.B = WB + (size_t)(pn * 256) * 2048 + (sub >> 1) * 1024; }
        return true; }
    __device__ __forceinline__ void a_ready(const pg8::Unit&) const {}
    __device__ __forceinline__ void done(const pg8::Unit&) const {}
};
struct SchedStd { int c, G, nM, nN, nt; const char* A; const char* B; size_t astep, bstep;
    __device__ __forceinline__ bool next(int i, pg8::Unit& u) const { int pm, pn; if (!pg8::static_tile(nM, nN, G, c, i, pm, pn)) return false;
        u.pm = pm; u.pn = pn; u.sub = 0; u.nt = nt; u.A = A + (size_t)pm * astep; u.B = B + (size_t)pn * bstep; return true; }
    __device__ __forceinline__ void a_ready(const pg8::Unit&) const {}
    __device__ __forceinline__ void done(const pg8::Unit&) const {}
};
struct EpiRes { static constexpr bool PERM = false, AFTER_DRAIN = true;
    const float* base; float* out; bf16* HB; float* SS;
    __device__ __forceinline__ void fused(pg8::f32x4 (&acc)[2][2][4][2], const pg8::Unit& u, int wr, int wc, int fr, int fq, PG8_LAS unsigned char* lds, int wid, int lane) const {
        LAS float* P = (LAS float*)lds; const int col0 = u.pn * 256 + wc * 32 + 4 * fq;
#pragma unroll
        for (int ai = 0; ai < 2; ++ai)
#pragma unroll
            for (int m = 0; m < 4; ++m) { const int r = ai * 128 + wr * 64 + m * 16 + fr; const size_t off = (size_t)(u.pm * 256 + r) * 1024 + col0; float s = 0.f;
#pragma unroll
                for (int bj = 0; bj < 2; ++bj)
#pragma unroll
                    for (int n = 0; n < 2; ++n) { const pg8::f32x4 h = *(const pg8::f32x4*)(base + off + bj * 128 + n * 16) + acc[ai][bj][m][n];
                        *(pg8::f32x4*)(out + off + bj * 128 + n * 16) = h; s += (h[0] * h[0] + h[1] * h[1]) + (h[2] * h[2] + h[3] * h[3]);
                        if (HB) { unsigned long long w = (unsigned long long)pg8::cvt_pk_bf16(h[0], h[1]) | ((unsigned long long)pg8::cvt_pk_bf16(h[2], h[3]) << 32); *(unsigned long long*)(HB + off + bj * 128 + n * 16) = w; } }
                s += __shfl_xor(s, 16); s += __shfl_xor(s, 32);
                if (fq == 0) P[r * 4 + wc] = s; }
        asm volatile("s_waitcnt lgkmcnt(0)" ::: "memory"); __builtin_amdgcn_s_barrier(); asm volatile("" ::: "memory");
        const int t = wid * 64 + lane; if (t < 256) SS[(size_t)u.pn * RT + u.pm * 256 + t] = (P[t * 4] + P[t * 4 + 1]) + (P[t * 4 + 2] + P[t * 4 + 3]);
    }
};
struct EpiGU { static constexpr bool PERM = true, AFTER_DRAIN = false;
    const float* SS; bf16* HID;
    __device__ __forceinline__ void operator()(const pg8::f32x4 (&acc)[2][2][4][2], const pg8::Unit& u, int wr, int wc, int fr, int fq) const {
        const int row0 = u.pm * 256 + wr * 64 + fr, col0 = u.pn * 128 + wc * 32 + 8 * fq;
#pragma unroll
        for (int ai = 0; ai < 2; ++ai)
#pragma unroll
            for (int m = 0; m < 4; ++m) { const int row = row0 + ai * 128 + m * 16;
                const float rs = rsqrtf(((SS[row] + SS[RT + row]) + (SS[2 * RT + row] + SS[3 * RT + row])) * (1.f / DM) + EPS); float h[8];
#pragma unroll
                for (int n = 0; n < 2; ++n)
#pragma unroll
                    for (int e = 0; e < 4; ++e) { const float g = acc[ai][0][m][n][e] * rs, up = acc[ai][1][m][n][e] * rs; h[4 * n + e] = g * fsigmoid(g) * up; }
                v4u w; w.x = pg8::cvt_pk_bf16(h[0], h[1]); w.y = pg8::cvt_pk_bf16(h[2], h[3]); w.z = pg8::cvt_pk_bf16(h[4], h[5]); w.w = pg8::cvt_pk_bf16(h[6], h[7]);
                *(v4u*)(HID + (size_t)row * DFF + col0) = w; }
    }
};
#define XB_TMO      128
#define XB_XCNT(j)  (256  + 64 * (j))
#define XB_XSUB(j)  (1280 + 64 * (j))
#define XB_XGEN(j)  (2304 + 64 * (j))
#define XB_TOP      3328
#define XB_TOPGEN   3392
#define XCD_BAR_WORDS 3456
#define XB_SPIN_CAP (1u << 18)

__device__ __forceinline__ unsigned xb_ld(unsigned* p)              { return __hip_atomic_load(p, __ATOMIC_RELAXED, __HIP_MEMORY_SCOPE_AGENT); }
__device__ __forceinline__ unsigned xb_add(unsigned* p, unsigned v) { return __hip_atomic_fetch_add(p, v, __ATOMIC_RELAXED, __HIP_MEMORY_SCOPE_AGENT); }
__device__ __forceinline__ unsigned xb_xcc_id() { return (unsigned)__builtin_amdgcn_s_getreg((3 << 11) | 20) & 0xFu; }
#define XB_SPIN(cond, bar) do { unsigned _sp = 0; while (cond) { __builtin_amdgcn_s_sleep(1); \
    if ((++_sp & 255u) == 0u) { if (xb_ld(&(bar)[XB_TMO])) break; if (_sp > XB_SPIN_CAP) { atomicAdd(&(bar)[XB_TMO], 1u); break; } } } } while (0)

struct XcdBarrier {
    unsigned* bar; unsigned x;
    volatile LAS unsigned* st;
};

__device__ __forceinline__ XcdBarrier xcd_barrier_post(unsigned* bar, volatile LAS unsigned* st, bool t0) {
    XcdBarrier b; b.bar = bar; b.x = xb_xcc_id(); b.st = st;
    if (t0) (void)xb_add(&bar[XB_XCNT(b.x)], 1u);
    return b;
}
__device__ __forceinline__ void xcd_barrier_complete(unsigned* bar, unsigned x, unsigned& nloc, unsigned& nx) {
    const unsigned G = gridDim.x * gridDim.y * gridDim.z;
    unsigned sum, cnt, mine, sp = 0u;
    for (;;) {
        sum = 0u; cnt = 0u; mine = 0u;
#pragma unroll
        for (unsigned j = 0; j < 16; ++j) { const unsigned c = xb_ld(&bar[XB_XCNT(j)]); sum += c; cnt += (c > 0u) ? 1u : 0u; mine = (j == x) ? c : mine; }
        if (sum == G) break;
        __builtin_amdgcn_s_sleep(1);
        if ((++sp & 255u) == 0u) { if (xb_ld(&bar[XB_TMO])) break; if (sp > XB_SPIN_CAP) { atomicAdd(&bar[XB_TMO], 1u); break; } }
    }
    nloc = mine > 0u ? mine : 1u; nx = cnt > 0u ? cnt : 1u;
}

__device__ __forceinline__ void xcd_barrier(const XcdBarrier& b, bool t0) {
    asm volatile("s_waitcnt vmcnt(0)" ::: "memory");
    __syncthreads();
    if (t0) {
        unsigned* bar = b.bar;
        __builtin_amdgcn_s_waitcnt(0);
        unsigned nloc = b.st[0], nx = b.st[1];
        if (nloc == 0u) { xcd_barrier_complete(bar, b.x, nloc, nx); b.st[0] = nloc; b.st[1] = nx; }
        const unsigned old = xb_add(&bar[XB_XSUB(b.x)], 1u);
        const unsigned gen = old / nloc;
        if (old + 1u == (gen + 1u) * nloc) {
            __builtin_amdgcn_fence(__ATOMIC_RELEASE, "agent");
            asm volatile("s_waitcnt vmcnt(0)" ::: "memory");
            const unsigned og = xb_add(&bar[XB_TOP], 1u);
            const unsigned tg = og / nx;
            if (og + 1u == (tg + 1u) * nx) xb_add(&bar[XB_TOPGEN], 1u);
            else XB_SPIN(xb_ld(&bar[XB_TOPGEN]) == tg, bar);
            __builtin_amdgcn_fence(__ATOMIC_ACQUIRE, "agent");
            xb_add(&bar[XB_XGEN(b.x)], 1u);
            asm volatile("s_waitcnt vmcnt(0)" ::: "memory");
        } else {
            XB_SPIN(xb_ld(&bar[XB_XGEN(b.x)]) == gen, bar);
            __builtin_amdgcn_fence(__ATOMIC_ACQUIRE, "agent");
            asm volatile("s_waitcnt vmcnt(0)" ::: "memory");
        }
    }
    __syncthreads();
}


struct Args { const float* in[17]; float* out; unsigned char* ws; int ph_lo, ph_hi; };

__device__ __forceinline__ void p0_transpose_item(const float* __restrict__ W, int srcN, int col0, int k0, bf16* __restrict__ WT, int drow0, int ldk, int koff, const float* __restrict__ scale, LAS float* scr, int lane) {
    float tv[32];
#pragma unroll
    for (int i = 0; i < 32; ++i) { const int kk = 2 * i + (lane >> 5); tv[i] = W[(size_t)(k0 + kk) * srcN + col0 + (lane & 31)]; }
#pragma unroll
    for (int i = 0; i < 32; ++i) { const int kk = 2 * i + (lane >> 5); float v = tv[i]; if (scale) v *= scale[k0 + kk]; scr[kk * 33 + (lane & 31)] = v; }
    LDS_WAIT(); asm volatile("" ::: "memory");
    const int c = lane & 7;
#pragma unroll
    for (int j = 0; j < 4; ++j) { const int n = (lane >> 3) + 8 * j; const LAS float* s = scr + (8 * c) * 33 + n;
        v4u o; o.x = pk2(s[0 * 33], s[1 * 33]); o.y = pk2(s[2 * 33], s[3 * 33]); o.z = pk2(s[4 * 33], s[5 * 33]); o.w = pk2(s[6 * 33], s[7 * 33]);
        *(v4u*)(WT + (size_t)(drow0 + n) * ldk + koff + k0 + 8 * c) = o; }
    LDS_WAIT(); asm volatile("" ::: "memory");
}
__device__ __forceinline__ bool p0_mat(int& r, const float* W, int srcN, int col0, int Ncols, int K, bf16* WT, int drow0, int ldk, int koff, const float* scale, int rowmode, LAS float* scr, int lane) {
    const int nblk = Ncols / 32, nitems = (K / 64) * nblk;
    if (r >= nitems) { r -= nitems; return false; }
    const int kb = r / nblk, nb = r % nblk, n0 = 32 * nb;
    const int dr = rowmode == 0 ? drow0 + n0 : ((n0 >> 7) * 256 + (n0 & 127) + (rowmode == 2 ? 128 : 0));
    p0_transpose_item(W, srcN, col0 + n0, 64 * kb, WT, dr, ldk, koff, scale, scr, lane); return true;
}

__global__ void __launch_bounds__(NWAVES * 64, 2) mega(Args args) {
    extern __shared__ __attribute__((aligned(16))) unsigned char lds_raw[];
    cg::grid_group grid = cg::this_grid();
    LAS unsigned char* lds = (LAS unsigned char*)lds_raw;
#define FRESH_TID() int lane = lane_id(); asm volatile("" : "+v"(lane)); const int wave = wave_s, tid = wave * 64 + lane; (void)tid
    const int wave_s = __builtin_amdgcn_readfirstlane((int)threadIdx.x >> 6);
    const int G = gridDim.x, bx = blockIdx.x;
    const int vcu = (G % 8 == 0) ? (bx % 8) * (G / 8) + bx / 8 : bx;
    unsigned char* ws = args.ws;
    const float* x = args.in[0]; const float* meta = args.in[1]; const float* mix_nw = args.in[2]; const float* w_in = args.in[3];
    const float* fbias = args.in[4]; const float* a_log = args.in[6]; const float* dt_bias = args.in[7];
    const float* wbf = args.in[9]; const float* wbd = args.in[10]; const float* wout = args.in[11];
    const float* ffn_nw = args.in[12]; const float* wg = args.in[13]; const float* wu = args.in[14]; const float* wd = args.in[15];
    float *CQ = (float*)(ws + WS_CQ), *GG = (float*)(ws + WS_GG), *BT = (float*)(ws + WS_BT), *LF = (float*)(ws + WS_LF);
    bf16 *WIN = (bf16*)(ws + WS_WIN), *WG = (bf16*)(ws + WS_WG), *WB = (bf16*)(ws + WS_WB), *WOUT = (bf16*)(ws + WS_WOUT), *WGU = (bf16*)(ws + WS_WGU), *WDN = (bf16*)(ws + WS_WDN);
    bf16 *HN = (bf16*)(ws + WS_HN), *OD = (bf16*)(ws + WS_OD), *FK = (bf16*)(ws + WS_FK), *FV = (bf16*)(ws + WS_FV), *DQKV = (bf16*)(ws + WS_DQKV), *DZ = (bf16*)(ws + WS_DZ), *Y = (bf16*)(ws + WS_Y), *HID = (bf16*)(ws + WS_HID), *H1B = HN;
    float *SS1 = (float*)(ws + WS_SS1), *SS2 = (float*)(ws + WS_SS2);
    const int lo = args.ph_lo, hi = args.ph_hi;
    if (hi < 0) grid.sync();
    { int l0 = lane_id(); if (wave_s == 0 && l0 < 64) ((volatile LAS unsigned*)(lds + MISC_OFF))[l0] = 0u; }
    __syncthreads();
    const XcdBarrier xbar = xcd_barrier_post((unsigned*)(ws + WS_BAR), (volatile LAS unsigned*)(lds + MISC_OFF), wave_s == 0 && lane_id() == 0);
#define GRID_SYNC() xcd_barrier(xbar, wave_s == 0 && lane_id() == 0)
#define STAMP(k) do { if (PROBE_TS && bx == 0 && wave_s == 0 && lane_id() == 0) { const unsigned long long t_ = __builtin_amdgcn_s_memrealtime(); ((volatile LAS unsigned*)(lds + MISC_OFF))[32 + 2 * (k)] = (unsigned)t_; } } while (0)
    STAMP(0);
#define STAMPG(slot, blk) do { if (PROBE_TS && bx == (blk) && wave_s == 0 && lane_id() == 0) __hip_atomic_store((unsigned*)(ws + WS_BAR) + 6144 + (slot), (unsigned)__builtin_amdgcn_s_memrealtime(), __ATOMIC_RELAXED, __HIP_MEMORY_SCOPE_AGENT); } while (0)
    STAMPG(29, 0);
#define IN(k) (lo <= (k) && (k) < hi)
#define BOTH(k) (IN(k) && IN((k) + 1))

    if (IN(0)) {
      { int reps_ = 1 + ((PROBE_REP >> 0) & 1); asm volatile("" : "+s"(reps_)); for (int rep_ = 0; rep_ < reps_; ++rep_) {
        FRESH_TID();
        const int gw = vcu * NWAVES + wave, NGW = G * NWAVES;
        { LAS float* scr = (LAS float*)(lds + wave * 16384);
          constexpr int NITEMS = 16 * 112 + 16 * 64 + 2 * 8 * 32 + 16 * 32 + 2 * 16 * 88 + 44 * 32;
          for (int it = gw; it < NITEMS; it += NGW) { int r = it;
            if (p0_mat(r, w_in, DIN, 0, 1536, 1024, WIN, 0, 1024, 0, nullptr, 0, scr, lane)) continue;
            if (p0_mat(r, w_in, DIN, 1544, 1536, 1024, WIN, 1536, 1024, 0, nullptr, 0, scr, lane)) continue;
            if (p0_mat(r, w_in, DIN, 3088, 512, 1024, WIN, 3072, 1024, 0, nullptr, 0, scr, lane)) continue;
            if (p0_mat(r, w_in, DIN, 3600, 2048, 1024, WG, 0, 1024, 0, nullptr, 0, scr, lane)) continue;
            if (p0_mat(r, wbf, 1024, 0, 1024, 512, WB, 0, 1024, 0, nullptr, 0, scr, lane)) continue;
            if (p0_mat(r, wbd, 1024, 0, 1024, 512, WB, 0, 1024, 512, nullptr, 0, scr, lane)) continue;
            if (p0_mat(r, wout, 1024, 0, 1024, 1024, WOUT, 0, 1024, 0, nullptr, 0, scr, lane)) continue;
            if (p0_mat(r, wg, DFF, 0, DFF, 1024, WGU, 0, 1024, 0, ffn_nw, 1, scr, lane)) continue;
            if (p0_mat(r, wu, DFF, 0, DFF, 1024, WGU, 0, 1024, 0, ffn_nw, 2, scr, lane)) continue;
            p0_mat(r, wd, 1024, 0, 1024, DFF, WDN, 0, DFF, 0, nullptr, 0, scr, lane);
          } }
        STAMPG(27, 0);
        __syncthreads();
        LAS float* W16 = (LAS float*)lds;
#pragma unroll 2
        for (int i = tid; i < 1024 * 4; i += NWAVES * 64) { const int k = i >> 2, q = i & 3;
            const f32x4 v = *(const f32x4*)(w_in + (size_t)k * DIN + (q < 2 ? 1536 + 4 * q : 3080 + 4 * (q - 2)));
            *(LAS f32x4*)(W16 + ((k & 3) * 256 + (k >> 2)) * 20 + 4 * q) = v; }
        __syncthreads();
        f32x4 vnx[4];
#define HN_SRC(rr) (((rr) % LP) < NPAD ? (const float*)nullptr : (((rr) % LP) < 128 ? meta + (size_t)(((rr) % LP) - NPAD) * DM : x + ((size_t)((rr) / LP) * SEQ + (((rr) % LP) - 128)) * DM))
#define HN_LOAD(dst, rr) do { const float* s_ = HN_SRC(rr); _Pragma("unroll") for (int j = 0; j < 4; ++j) dst[j] = s_ ? ((const f32x4*)s_)[lane + 64 * j] : (f32x4){0.f, 0.f, 0.f, 0.f}; } while (0)
        if (gw < R) HN_LOAD(vnx, gw);
        for (int r = gw; r < R; r += NGW) {
            const int b = r / LP, pos = r % LP;
            f32x4 v[4]; float ss = 0.f;
#pragma unroll
            for (int j = 0; j < 4; ++j) { v[j] = vnx[j]; ss += (v[j].x * v[j].x + v[j].y * v[j].y) + (v[j].z * v[j].z + v[j].w * v[j].w); }
            if (r + NGW < R) HN_LOAD(vnx, r + NGW);
            const float rs = rsqrtf(wave_sum(ss) * (1.f / DM) + EPS);
            unsigned long long* o8 = (unsigned long long*)(HN + (size_t)r * DM) + lane;
            float acc[16];
#pragma unroll
            for (int c = 0; c < 16; ++c) acc[c] = 0.f;
#pragma unroll
            for (int j = 0; j < 4; ++j) { asm volatile("" ::: "memory");
                const f32x4 nwv = ((const f32x4*)mix_nw)[lane + 64 * j]; const f32x4 hn = v[j] * rs * nwv;
                o8[64 * j] = (unsigned long long)pk2(hn.x, hn.y) | ((unsigned long long)pk2(hn.z, hn.w) << 32);
#pragma unroll
                for (int e = 0; e < 4; ++e) { const LAS float* wr_ = W16 + (e * 256 + lane + 64 * j) * 20; const float he = hn[e];
#pragma unroll
                    for (int q = 0; q < 4; ++q) { const f32x4 w = *(const LAS f32x4*)(wr_ + 4 * q); acc[4 * q] += he * w.x; acc[4 * q + 1] += he * w.y; acc[4 * q + 2] += he * w.z; acc[4 * q + 3] += he * w.w; } } }
            float a8[8], a4[4], a2[2], mine;
            { const bool up = (lane & 32) != 0;
#pragma unroll
              for (int j = 0; j < 8; ++j) { const float keep = up ? acc[j + 8] : acc[j], send = up ? acc[j] : acc[j + 8]; a8[j] = keep + __shfl_xor(send, 32); } }
            { const bool up = (lane & 16) != 0;
#pragma unroll
              for (int j = 0; j < 4; ++j) { const float keep = up ? a8[j + 4] : a8[j], send = up ? a8[j] : a8[j + 4]; a4[j] = keep + __shfl_xor(send, 16); } }
            { const bool up = (lane & 8) != 0;
#pragma unroll
              for (int j = 0; j < 2; ++j) { const float keep = up ? a4[j + 2] : a4[j], send = up ? a4[j] : a4[j + 2]; a2[j] = keep + __shfl_xor(send, 8); } }
            { const bool up = (lane & 4) != 0; const float keep = up ? a2[1] : a2[0], send = up ? a2[0] : a2[1]; mine = keep + __shfl_xor(send, 4); }
            mine += __shfl_xor(mine, 1); mine += __shfl_xor(mine, 2);
            if ((lane & 3) == 0) { const bool valid = pos >= NPAD; const int j = lane >> 2;
                if (j < 8) { const float z = mine + fbias[j]; LF[(size_t)(b * 8 + j) * LP + pos] = fminf(z, 0.f) - log1pf(expf(-fabsf(z))); }
                else if (j < 12) { const int h = j - 8; BT[(size_t)(b * 4 + h) * LP + pos] = valid ? sigmoidf_(mine) : 0.f; }
                else { const int h = j - 12; const float z = mine + dt_bias[h]; const float sp = fmaxf(z, 0.f) + log1pf(expf(-fabsf(z))); GG[(size_t)(b * 4 + h) * LP + pos] = valid ? -expf(a_log[h]) * sp : 0.f; } }
        }
#undef HN_SRC
#undef HN_LOAD
      } }
        STAMPG(28, 0);
        if (BOTH(0)) { GRID_SYNC(); for (int e_ = 0; e_ < PROBE_SYNC; ++e_) GRID_SYNC(); } STAMP(1);
    }
    if (IN(1)) {
      { int reps_ = 1 + ((PROBE_REP >> 1) & 1); asm volatile("" : "+s"(reps_)); for (int rep_ = 0; rep_ < reps_; ++rep_) {
        __syncthreads();
        { pg8::Gemm g{1024, 1024}; SchedG1 S{bx, G, (const char*)HN, (const char*)WIN}; EpiG1 E{OD, FK, FV, DQKV, DZ, args.in[8]};
          pg8::gemm_phase<EpiG1, SchedG1, true, true>(lds, g, S, E, wave_s); }
        if (bx >= G - 32) {
            FRESH_TID();
            __syncthreads();
            const int bh = bx - (G - 32); LAS float* part = (LAS float*)lds;
            const float* lf = LF + (size_t)bh * LP; float* cq = CQ + (size_t)bh * LP;
            float v[9]; float run = 0.f;
#pragma unroll
            for (int e = 0; e < 9; ++e) { const int i = tid * 9 + e; const float t = (i < LP && i >= NPAD) ? lf[i] : 0.f; run += t; v[e] = run; }
            float incl = run;
#pragma unroll
            for (int o = 1; o < 64; o <<= 1) { const float t = __shfl_up(incl, o); if (lane >= o) incl += t; }
            if (lane == 63) part[wave] = incl;
            __syncthreads();
            float base = incl - run;
            for (int w = 0; w < wave; ++w) base += part[w];
#pragma unroll
            for (int e = 0; e < 9; ++e) { const int i = tid * 9 + e; if (i < LP) cq[i] = i >= NPAD ? (base + v[e]) * LOG2E : 1e30f; }
        }
      } }
        if (BOTH(1)) { GRID_SYNC(); for (int e_ = 0; e_ < PROBE_SYNC; ++e_) GRID_SYNC(); } STAMP(2);
    }
    if (IN(2)) {
        FRESH_TID();
        __syncthreads();
        unsigned* FLAG = (unsigned*)(ws + WS_BAR) + 4096;
        const dn::PrepArgs P{DQKV, args.in[5], GG, BT, (unsigned char*)args.out, (float*)(ws + WS_U), (float*)(ws + WS_CD), FLAG, (PROBE_TS && bx == 17) ? (unsigned*)(ws + WS_BAR) + 6144 + 30 : nullptr};
        STAMPG(20, 0);
        if (bx < 16) {
            const dn::RecArgs A{(const unsigned char*)args.out, (const float*)(ws + WS_U), (const float*)(ws + WS_CD), DZ, args.in[8], OD, FLAG, (PROBE_TS && bx == 0) ? (unsigned*)(ws + WS_BAR) + 6144 + 40 : nullptr};
            dn::rec_chain<0>(lds, A, bx, wave, lane); __syncthreads(); STAMPG(21, 0);
            if ((PROBE_REP >> 10) & 1) { dn::rec_chain<1>(lds, A, bx, wave, lane); __syncthreads(); }
            if ((PROBE_REP >> 12) & 1) { dn::rec_chain<2>(lds, A, bx, wave, lane); __syncthreads(); } }
        { unsigned* ctr = (unsigned*)(ws + WS_BAR) + 3584; volatile LAS unsigned* slot = (volatile LAS unsigned*)(lds + MISC_OFF + 64);
#define PULL_(idx_) do { int ln_ = lane_id(); asm volatile("" : "+v"(ln_)); if (wave_s == 0 && ln_ == 0) *slot = atomicAdd(ctr, 1u); __syncthreads(); idx_ = (unsigned)__builtin_amdgcn_readfirstlane((int)*slot); } while (0)
          unsigned idx; PULL_(idx);
          while (idx < (unsigned)dn::NITEM) { int ln = lane_id(); asm volatile("" : "+v"(ln)); dn::prep_item(lds, P, (int)(idx & 15u), 1 + (int)(idx >> 4), wave_s, ln); PULL_(idx); }
          STAMPG(23, 17); STAMPG(25, 255);
          while (idx < (unsigned)dn::NITEM + 512u) { const unsigned u = idx - (unsigned)dn::NITEM; const int bh = (int)(u & 31u), qb = 15 - (int)(u >> 5);
              attn_body::attn_unit<8>(bh >> 3, bh & 7, qb, (const attn_body::bf16*)OD, (const attn_body::bf16*)FK, (const attn_body::bf16*)FV, (attn_body::bf16*)OD, CQ, (char*)lds_raw, wave_s); PULL_(idx); }
          STAMPG(22, 0); STAMPG(24, 17); STAMPG(26, 255);
#undef PULL_
        }
        if (BOTH(2)) { GRID_SYNC(); for (int e_ = 0; e_ < PROBE_SYNC; ++e_) GRID_SYNC(); } STAMP(3);
    }
    if (IN(3)) { STAMP(4); }
    if (IN(4)) {
      { int reps_ = 1 + ((PROBE_REP >> 4) & 1); asm volatile("" : "+s"(reps_)); for (int rep_ = 0; rep_ < reps_; ++rep_) {
        __syncthreads();
        { pg8::Gemm g{1024, 1024}; SchedBr S{bx, G, (const char*)HN, (const char*)OD, (const char*)WG, (const char*)WB}; EpiBr E{(bf16*)args.out + (size_t)bx * 65536, Y};
          pg8::gemm_phase<EpiBr, SchedBr, true, true>(lds, g, S, E, wave_s); }
      } }
        if (BOTH(4)) { GRID_SYNC(); for (int e_ = 0; e_ < PROBE_SYNC; ++e_) GRID_SYNC(); } STAMP(5);
    }
    if (IN(5)) {
      if ((PROBE_REP >> 11) & 1) { const unsigned long long t0_ = __builtin_amdgcn_s_memrealtime(); while (__builtin_amdgcn_s_memrealtime() - t0_ < 10000ull) __builtin_amdgcn_s_sleep(8); }
      { int reps_ = 1 + ((PROBE_REP >> 5) & 1); asm volatile("" : "+s"(reps_)); for (int rep_ = 0; rep_ < reps_; ++rep_) {
        __syncthreads();
        { pg8::Gemm g{1024, 1024}; SchedStd S{bx, G, 64, 4, 16, (const char*)Y, (const char*)WOUT, (size_t)256 * 1024 * 2, (size_t)256 * 1024 * 2}; EpiRes E{x, args.out, H1B, SS1};
          pg8::gemm_phase<EpiRes, SchedStd, false, true>(lds, g, S, E, wave_s); }
      } }
        if (BOTH(5)) { GRID_SYNC(); for (int e_ = 0; e_ < PROBE_SYNC; ++e_) GRID_SYNC(); } STAMP(6);
    }
    if (IN(6)) {
      { int reps_ = 1 + ((PROBE_REP >> 6) & 1); asm volatile("" : "+s"(reps_)); for (int rep_ = 0; rep_ < reps_; ++rep_) {
        __syncthreads();
        { pg8::Gemm g{1024, 1024}; SchedStd S{bx, G, 64, 22, 16, (const char*)H1B, (const char*)WGU, (size_t)256 * 1024 * 2, (size_t)256 * 1024 * 2}; EpiGU E{SS1, HID};
          pg8::gemm_phase<EpiGU, SchedStd, true, true>(lds, g, S, E, wave_s); }
      } }
        if (BOTH(6)) { GRID_SYNC(); for (int e_ = 0; e_ < PROBE_SYNC; ++e_) GRID_SYNC(); } STAMP(7);
    }
    if (IN(7)) {
        __syncthreads();
        { pg8::Gemm g{DFF, DFF}; SchedStd S{bx, G, 64, 4, 44, (const char*)HID, (const char*)WDN, (size_t)256 * DFF * 2, (size_t)256 * DFF * 2}; EpiRes E{args.out, args.out, nullptr, SS2};
          pg8::gemm_phase<EpiRes, SchedStd, false, true>(lds, g, S, E, wave_s); }
        if (BOTH(7)) { GRID_SYNC(); for (int e_ = 0; e_ < PROBE_SYNC; ++e_) GRID_SYNC(); } STAMP(8);
    }
    if (IN(8)) {
        FRESH_TID();
        const int gw = vcu * NWAVES + wave, NGW = G * NWAVES; const float* fnw = args.in[16];
        for (int m = gw; m < RT; m += NGW) { f32x4* o = (f32x4*)(args.out + (size_t)m * DM) + lane;
            const float rs = rsqrtf(((SS2[m] + SS2[RT + m]) + (SS2[2 * RT + m] + SS2[3 * RT + m])) * (1.f / DM) + EPS);
#pragma unroll
            for (int j = 0; j < 4; ++j) o[64 * j] = o[64 * j] * rs * ((const f32x4*)fnw)[lane + 64 * j]; }
        STAMP(9);
        if (PROBE_TS && bx == 0 && wave_s == 0 && lane_id() == 0) { asm volatile("s_waitcnt vmcnt(0) lgkmcnt(0)" ::: "memory"); volatile LAS unsigned* ts_ = (volatile LAS unsigned*)(lds + MISC_OFF) + 32;
            unsigned d_ = PROBE_TS == 10 ? ts_[2 * 9] - ts_[0] : ts_[2 * (PROBE_TS % 100)] - ts_[2 * ((PROBE_TS % 100) - 1)];
            if (PROBE_TS >= 100) { const unsigned* g_ = (const unsigned*)(ws + WS_BAR) + 6144; d_ = __hip_atomic_load(g_ + PROBE_TS / 100, __ATOMIC_RELAXED, __HIP_MEMORY_SCOPE_AGENT) - __hip_atomic_load(g_ + PROBE_TS % 100, __ATOMIC_RELAXED, __HIP_MEMORY_SCOPE_AGENT); }
            args.out[0] += (PROBE_TS >= 5000 ? 2e-3f : 1e-4f) * (float)(int)d_; }
    }
#undef IN
#undef BOTH
}
extern "C" void kernel_launch(void* const* d_in, const int* in_sizes, int n_in, void* d_out, int out_size, void* d_ws, size_t ws_size, hipStream_t stream) {
    if (n_in != 17 || ws_size < WS_END || out_size != RT * DM) { fprintf(stderr, "kernel_launch: unexpected shapes (n_in %d, ws %zu, out %d)\n", n_in, ws_size, out_size); return; }
    static int grid = 0;
    if (grid == 0) {
        int dev = 0, cus = 0, per_cu = 0; (void)hipGetDevice(&dev); (void)hipDeviceGetAttribute(&cus, hipDeviceAttributeMultiprocessorCount, dev);
        if (hipFuncSetAttribute((const void*)mega, hipFuncAttributeMaxDynamicSharedMemorySize, LDS_BYTES) != hipSuccess) { fprintf(stderr, "kernel_launch: hipFuncSetAttribute failed\n"); grid = -1; return; }
        if (hipOccupancyMaxActiveBlocksPerMultiprocessor(&per_cu, (const void*)mega, NWAVES * 64, LDS_BYTES) != hipSuccess || per_cu < 1) { fprintf(stderr, "kernel_launch: occupancy query says %d\n", per_cu); per_cu = 1; }
        (void)hipGetLastError();
        grid = cus;
        if (grid != 256) fprintf(stderr, "kernel_launch: %d CUs (built for 256)\n", grid);
    }
    if (grid < 0) return;
    unsigned char* ws = (unsigned char*)d_ws; float* out = (float*)d_out;
    if (hipMemsetAsync((char*)d_ws + WS_BAR, 0, 32768, stream) != hipSuccess) { fprintf(stderr, "kernel_launch: memset failed\n"); return; }
    Args a{}; for (int i = 0; i < 17; ++i) a.in[i] = (const float*)d_in[i]; a.out = out; a.ws = ws; a.ph_lo = 0; a.ph_hi = 9;
    { void* params[] = {&a}; hipError_t e = hipLaunchCooperativeKernel((const void*)mega, dim3(grid), dim3(NWAVES * 64), params, LDS_BYTES, stream);
      if (e != hipSuccess) { fprintf(stderr, "kernel_launch: cooperative launch failed: %s\n", hipGetErrorString(e)); return; } }
}
```

```cpp
#include <hip/hip_runtime.h>
#include <hip/hip_cooperative_groups.h>
#include <hip/hip_bf16.h>
#include <cmath>
#include <cstdint>
#include <cstdio>

namespace cg = cooperative_groups;
typedef unsigned short bf16;
constexpr int NB = 4, SEQ = 4096, DM = 1024, LP = 4224, R = NB * LP, RT = NB * SEQ, DIN = 5648, DFF = 2816;
constexpr int NPAD = 112;
constexpr float EPS = 1e-6f;
constexpr float LOG2E = 1.4426950408889634f;
constexpr float C2 = 0.125f * LOG2E;

#ifndef PROBE_SYNC
#define PROBE_SYNC 0
#endif
#ifndef PROBE_REP
#define PROBE_REP 0
#endif
#ifndef PROBE_TS
#define PROBE_TS 0
#endif
constexpr size_t MiB = 1u << 20;
constexpr size_t WS_BAR = 0;
constexpr size_t WS_LG = 1 * MiB;
constexpr size_t WS_CQ = 2 * MiB + 256 * 1024;
constexpr size_t WS_GG = 2 * MiB + 896 * 1024;
constexpr size_t WS_BT = 3 * MiB + 256 * 1024;
constexpr size_t WS_SS1 = 3 * MiB + 512 * 1024;
constexpr size_t WS_SS2 = 3 * MiB + 768 * 1024;
constexpr size_t WS_LF = 4 * MiB;
constexpr size_t WS_WIN = 5 * MiB;
constexpr size_t WS_WG = 12 * MiB;
constexpr size_t WS_WB = 16 * MiB;
constexpr size_t WS_WOUT = 18 * MiB;
constexpr size_t WS_WGU = 20 * MiB;
constexpr size_t WS_WDN = 31 * MiB;
constexpr size_t WS_HN = 37 * MiB;
constexpr size_t WS_OD = 70 * MiB;
constexpr size_t WS_FK = 103 * MiB;
constexpr size_t WS_FV = 119 * MiB + 512 * 1024;
constexpr size_t WS_DQKV = 136 * MiB;
constexpr size_t WS_DZ = 185 * MiB + 512 * 1024;
constexpr size_t WS_CD = 1 * MiB;
constexpr size_t WS_U = 202 * MiB;
constexpr size_t WS_Y = 202 * MiB;
constexpr size_t WS_HID = 70 * MiB;
constexpr size_t WS_END = 256 * MiB;

__device__ __forceinline__ unsigned f2bf(float f) { unsigned u = __builtin_bit_cast(unsigned, f); return (u + 0x7fffu + ((u >> 16) & 1u)) >> 16; }
__device__ __forceinline__ float bf2f(bf16 b) { return __builtin_bit_cast(float, (unsigned)b << 16); }
__device__ __forceinline__ float sigmoidf_(float x) { return 1.f / (1.f + expf(-x)); }
__device__ __forceinline__ float siluf_(float x) { return x / (1.f + expf(-x)); }
__device__ __forceinline__ int lane_id() { int l; asm volatile("v_mbcnt_lo_u32_b32 %0, -1, 0\n\tv_mbcnt_hi_u32_b32 %0, -1, %0" : "=v"(l)); return l; }
__device__ __forceinline__ int nat_row(int m) { return (m >> 12) * LP + 128 + (m & 4095); }

namespace pg8 {
#define PG8_LAS __attribute__((address_space(3)))
typedef unsigned short bf16_t;
typedef short bf16x8 __attribute__((ext_vector_type(8)));
typedef float f32x4 __attribute__((ext_vector_type(4)));
typedef unsigned u32x4 __attribute__((ext_vector_type(4)));
constexpr int BM = 256, BK = 64, HALF = 128, HTB = HALF * BK * 2  , STAGE_BYTES = 8 * HTB, NXCD = 8, WGM = 8;
__host__ __device__ __forceinline__ int lds_byte(int r, int c) { const int st = (r >> 4) * 2 + (c >> 5), rr = r & 15, cc = c & 31, ob = rr * 64 + cc * 2; return st * 1024 + (ob ^ (((ob >> 9) & 1) << 5)); }
__host__ __device__ __forceinline__ void stage_rc(int b, int& R, int& C) { const int st = b / 1024, sb = b % 1024, swz = sb ^ (((sb >> 9) & 1) << 5); R = (st >> 1) * 16 + swz / 64; C = (st & 1) * 32 + (swz % 64) / 2; }
__host__ __device__ __forceinline__ int perm32(int rho) { const int n = rho >> 4, i = rho & 15; return 8 * (i >> 2) + 4 * n + (i & 3); }
struct Unit { const char* A; const char* B; int nt; int pm, pn, sub; };
struct Gemm { int lda, ldb; };
__device__ __forceinline__ bool static_tile(int nM, int nN, int G, int c, int i, int& pm, int& pn) {
    const int nwg = nM * nN; const long L = (long)i * G + c; if (L >= nwg) return false;
    int wgid = (int)L; { const int q = nwg / NXCD, r = nwg % NXCD, xcd = wgid % NXCD, off = wgid / NXCD; wgid = (xcd < r ? xcd * (q + 1) : r * (q + 1) + (xcd - r) * q) + off; }
    const int nig = WGM * nN, gid = wgid / nig, fm = gid * WGM, gsz = (nM - fm) < WGM ? (nM - fm) : WGM;
    pm = fm + ((wgid % nig) % gsz); pn = (wgid % nig) / gsz; return true;
}
__device__ __forceinline__ unsigned cvt_pk_bf16(float lo, float hi) { unsigned r; asm volatile("v_cvt_pk_bf16_f32 %0, %1, %2" : "=v"(r) : "v"(lo), "v"(hi)); return r; }
template <class Epi, class Sched, bool ALIGN_EPI = false, bool SP2 = false>
__device__ __forceinline__ void gemm_phase(PG8_LAS unsigned char* lds, const Gemm g, const Sched& S, const Epi& E, const int wave_s) {
    int lane = lane_id(); asm volatile("" : "+v"(lane)); const int wid = wave_s, tid = wid * 64 + lane, wr = wid >> 2, wc = wid & 3, fr = lane & 15, fq = lane >> 4;
    const int lda = g.lda, ldb = g.ldb;
    unsigned voffA[2], voffB[2];
#pragma unroll
    for (int i = 0; i < 2; ++i) { int R, C; stage_rc(tid * 16 + i * 8192, R, C); const int Rb = Epi::PERM ? ((R & ~31) + perm32(R & 31)) : R;
        voffA[i] = (unsigned)(R * lda + C) * 2u; voffB[i] = (unsigned)(Rb * ldb + C) * 2u; }
    const size_t kstep = (size_t)(BK * 2);
    const size_t hstepA = (size_t)HALF * lda * 2, hstepB = (size_t)HALF * ldb * 2;
    const unsigned ldsw = (unsigned)wid * 1024u;
    const int aoff = lds_byte(wr * 64 + fr, fq * 8), boff = lds_byte(wc * 32 + fr, fq * 8);
#define PG8_SA(b, h) (((b) * 2 + (h)) * HTB)
#define PG8_SB(b, h) ((4 + (b) * 2 + (h)) * HTB)
#define PG8_STAGE(bufoff, gbase, voff) do { _Pragma("unroll") for (int _i = 0; _i < 2; ++_i) \
        __builtin_amdgcn_global_load_lds((const unsigned*)((const char*)(gbase) + (voff)[_i]), (PG8_LAS unsigned*)(lds + (bufoff) + ldsw + _i * 8192), 16, 0, 0); } while (0)
#define PG8_LDA(dst, b, h) do { _Pragma("unroll") for (int m = 0; m < 4; ++m) _Pragma("unroll") for (int k = 0; k < 2; ++k) dst[m][k] = *(const PG8_LAS bf16x8*)(lds + PG8_SA(b, h) + aoff + m * 2048 + k * 1024); } while (0)
#define PG8_LDB(dst, b, h) do { _Pragma("unroll") for (int n = 0; n < 2; ++n) _Pragma("unroll") for (int k = 0; k < 2; ++k) dst[n][k] = *(const PG8_LAS bf16x8*)(lds + PG8_SB(b, h) + boff + n * 2048 + k * 1024); } while (0)
#define PG8_MMA(ai, bj, At, Bt) do { __builtin_amdgcn_s_setprio(1); _Pragma("unroll") for (int m = 0; m < 4; ++m) _Pragma("unroll") for (int n = 0; n < 2; ++n) _Pragma("unroll") for (int k = 0; k < 2; ++k) \
        acc[ai][bj][m][n] = __builtin_amdgcn_mfma_f32_16x16x32_bf16(Bt[n][k], At[m][k], acc[ai][bj][m][n], 0, 0, 0); __builtin_amdgcn_s_setprio(0); } while (0)
#define PG8_WAIT_V(n) asm volatile("s_waitcnt vmcnt(" #n ")" ::: "memory")
#define PG8_WAIT_L(n) asm volatile("s_waitcnt lgkmcnt(" #n ")" ::: "memory")
#define PG8_BAR __builtin_amdgcn_s_barrier()
#define PG8_SCHED __builtin_amdgcn_sched_barrier(0)
    Unit cur, nxt; int ui = 0;
    if (!S.next(0, cur)) return;
    f32x4 acc[2][2][4][2];
#pragma unroll
    for (int a = 0; a < 2; ++a)
#pragma unroll
        for (int b = 0; b < 2; ++b)
#pragma unroll
            for (int m = 0; m < 4; ++m)
#pragma unroll
                for (int n = 0; n < 2; ++n) acc[a][b][m][n] = (f32x4){0.f, 0.f, 0.f, 0.f};
    bf16x8 At[4][2], B0[2][2], B1[2][2];
    const char* cA = cur.A; const char* cB = cur.B;
    S.a_ready(cur);
    if constexpr (SP2) {
        PG8_STAGE(PG8_SB(0, 0), cB, voffB); PG8_STAGE(PG8_SB(0, 1), cB + hstepB, voffB); PG8_STAGE(PG8_SA(0, 0), cA, voffA); PG8_STAGE(PG8_SA(0, 1), cA + hstepA, voffA);
        if (wr == 1) PG8_BAR;
        PG8_WAIT_V(2); PG8_BAR;
        PG8_STAGE(PG8_SB(1, 0), cB + kstep, voffB); PG8_STAGE(PG8_SA(1, 0), cA + kstep, voffA); PG8_STAGE(PG8_SB(1, 1), cB + hstepB + kstep, voffB);
        PG8_WAIT_V(6); PG8_BAR;
    } else {
        PG8_STAGE(PG8_SB(0, 0), cB, voffB); PG8_STAGE(PG8_SA(0, 0), cA, voffA); PG8_STAGE(PG8_SB(0, 1), cB + hstepB, voffB); PG8_STAGE(PG8_SA(0, 1), cA + hstepA, voffA);
        if (wr == 1) PG8_BAR;
        PG8_WAIT_V(4); PG8_BAR;
        PG8_STAGE(PG8_SB(1, 0), cB + kstep, voffB); PG8_STAGE(PG8_SA(1, 0), cA + kstep, voffA); PG8_STAGE(PG8_SB(1, 1), cB + hstepB + kstep, voffB);
        PG8_WAIT_V(6); PG8_BAR;
    }
    for (;;) {
        const bool has_next = S.next(ui + 1, nxt);
        const char* nA = has_next ? nxt.A : cA; const char* nB = has_next ? nxt.B : cB;
        const int nt = cur.nt;
        for (int t = 0; t < nt; t += 2) {
            const bool last = (t == nt - 2);
            const char* a1 = cA + (size_t)(t + 1) * kstep;
            const char* a2 = last ? nA : cA + (size_t)(t + 2) * kstep; const char* b2 = last ? nB : cB + (size_t)(t + 2) * kstep;
            const char* a3 = a2 + kstep; const char* b3 = b2 + kstep;
            if (last && has_next) S.a_ready(nxt);
            if constexpr (SP2) {
            PG8_LDB(B0, 0, 0); PG8_LDB(B1, 0, 1); PG8_SCHED; PG8_LDA(At, 0, 0); PG8_STAGE(PG8_SA(1, 1), a1 + hstepA, voffA);
            PG8_WAIT_V(8); PG8_WAIT_L(0); PG8_BAR; PG8_MMA(0, 0, At, B0); PG8_MMA(0, 1, At, B1); PG8_BAR; PG8_SCHED;
            PG8_LDA(At, 0, 1); PG8_STAGE(PG8_SB(0, 0), b2, voffB); PG8_STAGE(PG8_SB(0, 1), b2 + hstepB, voffB); PG8_STAGE(PG8_SA(0, 0), a2, voffA);
            PG8_WAIT_V(8); PG8_WAIT_L(0); PG8_BAR; PG8_MMA(1, 0, At, B0); PG8_MMA(1, 1, At, B1); PG8_BAR; PG8_SCHED;
            PG8_LDB(B0, 1, 0); PG8_LDB(B1, 1, 1); PG8_SCHED; PG8_LDA(At, 1, 0); PG8_STAGE(PG8_SA(0, 1), a2 + hstepA, voffA);
            PG8_WAIT_V(8); PG8_WAIT_L(0); PG8_BAR; PG8_MMA(0, 0, At, B0); PG8_MMA(0, 1, At, B1); PG8_BAR; PG8_SCHED;
            PG8_LDA(At, 1, 1); PG8_STAGE(PG8_SB(1, 0), b3, voffB); PG8_STAGE(PG8_SB(1, 1), b3 + hstepB, voffB); PG8_STAGE(PG8_SA(1, 0), a3, voffA);
            PG8_WAIT_V(8); PG8_WAIT_L(0); PG8_BAR; PG8_MMA(1, 0, At, B0); PG8_MMA(1, 1, At, B1); PG8_BAR; PG8_SCHED;
            } else {
            PG8_LDB(B0, 0, 0); PG8_SCHED; PG8_LDA(At, 0, 0); PG8_STAGE(PG8_SA(1, 1), a1 + hstepA, voffA);
            PG8_WAIT_L(8); PG8_BAR; PG8_WAIT_L(0); PG8_MMA(0, 0, At, B0); PG8_BAR; PG8_SCHED;
            PG8_LDB(B1, 0, 1); PG8_STAGE(PG8_SB(0, 0), b2, voffB);
            PG8_BAR; PG8_WAIT_L(0); PG8_MMA(0, 1, At, B1); PG8_BAR;
            PG8_LDA(At, 0, 1); PG8_STAGE(PG8_SA(0, 0), a2, voffA);
            PG8_BAR; PG8_WAIT_L(0); PG8_MMA(1, 0, At, B0); PG8_BAR; PG8_SCHED;
            PG8_STAGE(PG8_SB(0, 1), b2 + hstepB, voffB);
            PG8_WAIT_V(6); PG8_BAR; PG8_MMA(1, 1, At, B1); PG8_BAR;
            PG8_LDB(B0, 1, 0); PG8_SCHED; PG8_LDA(At, 1, 0); PG8_STAGE(PG8_SA(0, 1), a2 + hstepA, voffA);
            PG8_WAIT_L(8); PG8_BAR; PG8_WAIT_L(0); PG8_MMA(0, 0, At, B0); PG8_BAR; PG8_SCHED;
            PG8_LDB(B1, 1, 1); PG8_STAGE(PG8_SB(1, 0), b3, voffB);
            PG8_BAR; PG8_WAIT_L(0); PG8_MMA(0, 1, At, B1); PG8_BAR;
            PG8_LDA(At, 1, 1); PG8_STAGE(PG8_SA(1, 0), a3, voffA);
            PG8_BAR; PG8_WAIT_L(0); PG8_MMA(1, 0, At, B0); PG8_BAR; PG8_SCHED;
            PG8_STAGE(PG8_SB(1, 1), b3 + hstepB, voffB);
            PG8_WAIT_V(6); PG8_BAR; PG8_MMA(1, 1, At, B1); PG8_BAR;
            }
        }
        if constexpr (ALIGN_EPI) { if (wr == 0) PG8_BAR; }
        if constexpr (!Epi::AFTER_DRAIN) { E(acc, cur, wr, wc, fr, fq); S.done(cur); }
        if (!has_next) break;
#pragma unroll
        for (int a = 0; a < 2; ++a)
#pragma unroll
            for (int b = 0; b < 2; ++b)
#pragma unroll
                for (int m = 0; m < 4; ++m)
#pragma unroll
                    for (int n = 0; n < 2; ++n) acc[a][b][m][n] = (f32x4){0.f, 0.f, 0.f, 0.f};
        cur = nxt; cA = nA; cB = nB; ++ui;
        if constexpr (ALIGN_EPI) { if (wr == 1) PG8_BAR; }
    }
    PG8_WAIT_V(0);
    if constexpr (!ALIGN_EPI) { if (wr == 0) PG8_BAR; }
    PG8_BAR;
    if constexpr (Epi::AFTER_DRAIN) { E.fused(acc, cur, wr, wc, fr, fq, lds, wid, lane); S.done(cur); }
#undef PG8_SA
#undef PG8_SB
#undef PG8_STAGE
#undef PG8_LDA
#undef PG8_LDB
#undef PG8_MMA
#undef PG8_WAIT_V
#undef PG8_WAIT_L
#undef PG8_BAR
#undef PG8_SCHED
}
}

namespace attn_body {
using bf16=__hip_bfloat16;
using bf16x8=__attribute__((ext_vector_type(8)))short;
using s16x4=__attribute__((ext_vector_type(4)))short;
using f32x16=__attribute__((ext_vector_type(16)))float;
using u32x4=__attribute__((ext_vector_type(4)))unsigned;
constexpr int BATCH=4,NHEAD=8,SEQ=4224,D=64,QP=1024,KP=512;
constexpr int NW=8,QBLK=32,QB=QBLK*NW,KVBLK=64,NQB=16;
constexpr int ATTN_UNIT_ROWS=QB;
__device__ __forceinline__ int crow(int r,int hi){return (r&3)+8*(r>>2)+4*hi;}
#define SBAR() __builtin_amdgcn_sched_barrier(0)
__device__ __forceinline__ void cmask(f32x16&p0,f32x16&p1,int jb,int qrel,int hi){
  const float NEG=-INFINITY; int kb=64*jb+4*hi;
  #pragma unroll
  for(int r=0;r<16;++r){int kv=kb+(r&3)+8*(r>>2); if(kv>qrel)p0[r]=NEG; if(kv+32>qrel)p1[r]=NEG;}
}

constexpr int NSLOT=3, SLOTB=8192;
constexpr int LDS_K=0, LDS_V=NSLOT*SLOTB, LDS_WS=2*NSLOT*SLOTB, LDS_OST=LDS_WS+NW*64*4, LDS_CT=LDS_OST+NW*4096+2048, LDS_BYTES=LDS_CT+SEQ*4;
constexpr float C2=0.125f*1.4426950408889634f;
__device__ __forceinline__ void glds16(const void*gsrc,unsigned lds_dst){unsigned keep;
  asm volatile("s_mov_b32 %0, m0\n\ts_mov_b32 m0, %2\n\ts_nop 0\n\tglobal_load_lds_dwordx4 %1, off\n\ts_mov_b32 m0, %0":"=&s"(keep):"v"(gsrc),"s"(lds_dst):"memory");}
__device__ __forceinline__ float max3f(float a,float b,float c){float r;asm("v_max3_f32 %0, %1, %2, %3":"=v"(r):"v"(a),"v"(b),"v"(c));return r;}
__device__ __forceinline__ float max2f(float a,float b){float r;asm("v_max_f32_e32 %0, %1, %2":"=v"(r):"v"(a),"v"(b));return r;}
__device__ __forceinline__ float fadd_s(float a,float b){float r;asm("v_add_f32_e32 %0, %1, %2":"=v"(r):"v"(a),"v"(b));return r;}
__device__ __forceinline__ float fsub_s(float a,float b){float r;asm("v_sub_f32_e32 %0, %1, %2":"=v"(r):"v"(a),"v"(b));return r;}
typedef float f32x2_t __attribute__((ext_vector_type(2))); typedef float f32x4_t __attribute__((ext_vector_type(4))); typedef __bf16 bf16x2_t __attribute__((ext_vector_type(2)));
__device__ __forceinline__ unsigned cvtpk_s(float lo,float hi){f32x2_t v={lo,hi};bf16x2_t b=__builtin_convertvector(v,bf16x2_t);return __builtin_bit_cast(unsigned,b);}
#define WAIT_BAR(N) asm volatile("s_waitcnt vmcnt(" #N ") lgkmcnt(0)\n\ts_barrier":::"memory")

__device__ __forceinline__ void qkt(f32x16&p0,f32x16&p1,const char*Kslot,const bf16x8*qr,const f32x16&negm,int r32,int hi){
  const char*kb=Kslot+hi*1024+r32*16;
  #pragma unroll
  for(int d0=0;d0<4;++d0){
    const bf16x8 b0=*reinterpret_cast<const bf16x8*>(kb+d0*2048);
    const bf16x8 b1=*reinterpret_cast<const bf16x8*>(kb+d0*2048+512);
    if(d0==0){p0=__builtin_amdgcn_mfma_f32_32x32x16_bf16(b0,qr[0],negm,0,0,0);p1=__builtin_amdgcn_mfma_f32_32x32x16_bf16(b1,qr[0],negm,0,0,0);}
    else{p0=__builtin_amdgcn_mfma_f32_32x32x16_bf16(b0,qr[d0],p0,0,0,0);p1=__builtin_amdgcn_mfma_f32_32x32x16_bf16(b1,qr[d0],p1,0,0,0);}}
}
typedef __attribute__((address_space(3))) const char* lds_cptr;
typedef short v4i16_t __attribute__((ext_vector_type(4)));
__device__ __forceinline__ void kload8(bf16x8*kf,lds_cptr kp){
  kf[0]=*(const __attribute__((address_space(3))) bf16x8*)(kp);      kf[1]=*(const __attribute__((address_space(3))) bf16x8*)(kp+512);
  kf[2]=*(const __attribute__((address_space(3))) bf16x8*)(kp+2048); kf[3]=*(const __attribute__((address_space(3))) bf16x8*)(kp+2560);
  kf[4]=*(const __attribute__((address_space(3))) bf16x8*)(kp+4096); kf[5]=*(const __attribute__((address_space(3))) bf16x8*)(kp+4608);
  kf[6]=*(const __attribute__((address_space(3))) bf16x8*)(kp+6144); kf[7]=*(const __attribute__((address_space(3))) bf16x8*)(kp+6656);
}
__device__ __forceinline__ void kload2(bf16x8*kf,lds_cptr kp,int j){ kf[2*j]=*(const __attribute__((address_space(3))) bf16x8*)(kp+j*2048); kf[2*j+1]=*(const __attribute__((address_space(3))) bf16x8*)(kp+j*2048+512); }
__device__ __forceinline__ s16x4 vtr(lds_cptr p){ return __builtin_bit_cast(s16x4,__builtin_amdgcn_ds_read_tr16_b64_v4i16((__attribute__((address_space(3))) v4i16_t*)p)); }
__device__ __forceinline__ float rowmax(const f32x16&p0,const f32x16&p1){
  float a=max3f(p0[0],p0[1],p1[0]),b=max3f(p0[2],p0[3],p1[1]);a=max3f(a,p1[2],p1[3]);
  #pragma unroll
  for(int r=4;r<16;r+=4){a=max3f(a,p0[r],p0[r+1]);b=max3f(b,p0[r+2],p0[r+3]);a=max3f(a,p1[r],p1[r+1]);b=max3f(b,p1[r+2],p1[r+3]);}
  const float m=max2f(a,b);
  auto rr=__builtin_amdgcn_permlane32_swap(__float_as_uint(m),__float_as_uint(m),false,false);
  return max2f(__uint_as_float(rr[0]),__uint_as_float(rr[1]));
}
__device__ __forceinline__ void pv(f32x16*o,int vb,bf16x8 pa0,bf16x8 pa1,bf16x8 pa2,bf16x8 pa3){
  #pragma unroll
  for(int d0=0;d0<2;++d0){s16x4 lo[4],hi[4];
    #pragma unroll
    for(int ks=0;ks<4;++ks){
      asm volatile("ds_read_b64_tr_b16 %0,%1 offset:%c2":"=&v"(lo[ks]):"v"(vb),"i"(d0*4096+ks*1024):"memory");
      asm volatile("ds_read_b64_tr_b16 %0,%1 offset:%c2":"=&v"(hi[ks]):"v"(vb),"i"(d0*4096+ks*1024+512):"memory");}
    asm volatile("s_waitcnt lgkmcnt(0)":::"memory");SBAR();
    #define PK(k) (bf16x8){lo[k][0],lo[k][1],lo[k][2],lo[k][3],hi[k][0],hi[k][1],hi[k][2],hi[k][3]}
    o[d0]=__builtin_amdgcn_mfma_f32_32x32x16_bf16(pa0,PK(0),o[d0],0,0,0);
    o[d0]=__builtin_amdgcn_mfma_f32_32x32x16_bf16(pa1,PK(1),o[d0],0,0,0);
    o[d0]=__builtin_amdgcn_mfma_f32_32x32x16_bf16(pa2,PK(2),o[d0],0,0,0);
    o[d0]=__builtin_amdgcn_mfma_f32_32x32x16_bf16(pa3,PK(3),o[d0],0,0,0);
    #undef PK
  }
}

#ifndef ATTN_STORE16
#define ATTN_STORE16(p,v) (*(u32x4*)(p)=(v))
#endif
template<int THRL> __device__ __forceinline__ void attn_unit(int b,int h,int qb,const bf16*Q,const bf16*__restrict__ K,const bf16*__restrict__ V,bf16*O,const float*__restrict__ CQ,char*shm,const int wave_s){
  int lane=lane_id(); asm volatile("":"+v"(lane));
  const int wid=wave_s,tid=wid*64+lane,r32=lane&31,hi=lane>>5;
  const long rowbase=(long)b*SEQ; const int q0=128+qb*QB;
  const bf16*Qw=Q+(rowbase+q0+wid*QBLK)*QP+h*D;
  const bf16*Kh=K+rowbase*KP+h*D,*Vh=V+rowbase*KP+h*D;
  const unsigned lds0=(unsigned)(uintptr_t)shm;
  float*wsf=(float*)(shm+LDS_WS)+wid*64;
  const bf16*ksrc=Kh+(long)lane*KP+wid*8;
  const bf16*vsrc=Vh+(long)(16*(wid&3)+(lane>>2))*KP+(wid>>2)*32+(lane&3)*8;
  const unsigned kdst=lds0+LDS_K+wid*1024, vdst=lds0+LDS_V+wid*1024;
  #define PT(t) (((t)<2)?((t)^1):(t))
  #define DMA_K(t,slot) glds16(ksrc+(long)PT(t)*KVBLK*KP,(unsigned)__builtin_amdgcn_readfirstlane(kdst+(slot)))
  #define DMA_V(t,slot) glds16(vsrc+(long)PT(t)*KVBLK*KP,(unsigned)__builtin_amdgcn_readfirstlane(vdst+(slot)))
  const int vb0=(int)(lds0+LDS_V)+((lane>>4)&1)*32+(lane&3)*8+(4*hi+((lane&15)>>2))*64;
  const char*Kbase=shm+LDS_K; bf16x8 kf[8];
  const lds_cptr shm3=(lds_cptr)shm; const lds_cptr kp0=shm3+LDS_K+hi*1024+r32*16; const lds_cptr vp0=shm3+LDS_V+((lane>>4)&1)*32+(lane&3)*8+(4*hi+((lane&15)>>2))*64;
  const int NT=(q0+QB)/KVBLK;
  DMA_K(0,0);DMA_V(0,0);DMA_K(1,SLOTB);
  bf16x8 qr[4];
  #pragma unroll
  for(int d0=0;d0<4;++d0)qr[d0]=*reinterpret_cast<const bf16x8*>(&Qw[(long)r32*QP+d0*16+hi*8]);
  { const float*cg=CQ+(long)(b*NHEAD+h)*SEQ; __attribute__((address_space(3))) float*ct=(__attribute__((address_space(3))) float*)((lds_cptr)shm+LDS_CT); const int ncp=q0+QB;
    for(int i=tid;i<ncp;i+=NW*64)ct[i]=cg[i]; }
  const lds_cptr ctp=(lds_cptr)shm+LDS_CT+hi*16;
  float mhat=0.f,l_reg=0.f;f32x16 o[2];o[0]=f32x16{};o[1]=f32x16{};
  const float cqp=CQ[(long)(b*NHEAD+h)*SEQ+q0+wid*QBLK+r32];
  const f32x16 negm=f32x16{};
  float base=cqp;
  const int qrel=wid*QBLK+r32;
  #define CMASK(P0,P1,t) do{int jb_=(t)-(NT-4); if(jb_>=0)cmask(P0,P1,jb_,qrel,hi);}while(0)
  bool resc=false;
  #define START(P0,P1) do{ const float rm=rowmax(P0,P1); resc=false; \
    { const float dl=rm; mhat=fadd_s(mhat,dl); \
      _Pragma("unroll") for(int r=0;r<16;++r){P0[r]=fsub_s(P0[r],dl);P1[r]=fsub_s(P1[r],dl);} \
      base=cqp-mhat; } \
    _Pragma("unroll") for(int r=0;r<16;++r)P0[r]=__builtin_amdgcn_exp2f(P0[r]); }while(0)
  #define RESC() do{ if(resc){ asm volatile("s_waitcnt lgkmcnt(0)":::"memory"); \
      _Pragma("unroll") for(int d_=0;d_<2;++d_) _Pragma("unroll") for(int r=0;r<16;++r)o[d_][r]*=wsf[crow(r,hi)]; } }while(0)
  #define CKSUB(C0,C1,t) do{ const lds_cptr cp_=ctp+256*PT(t); \
    const f32x2_t b2_={base,base}; \
    _Pragma("unroll") for(int g_=0;g_<4;++g_){ const f32x4_t a_=*(const __attribute__((address_space(3))) f32x4_t*)(cp_+32*g_); \
      f32x2_t x_={C0[4*g_],C0[4*g_+1]},y_={C0[4*g_+2],C0[4*g_+3]}; x_=(x_-(f32x2_t){a_[0],a_[1]})+b2_; y_=(y_-(f32x2_t){a_[2],a_[3]})+b2_; \
      C0[4*g_]=x_[0];C0[4*g_+1]=x_[1];C0[4*g_+2]=y_[0];C0[4*g_+3]=y_[1]; } SBAR(); \
    _Pragma("unroll") for(int g_=0;g_<4;++g_){ const f32x4_t a_=*(const __attribute__((address_space(3))) f32x4_t*)(cp_+128+32*g_); \
      f32x2_t x_={C1[4*g_],C1[4*g_+1]},y_={C1[4*g_+2],C1[4*g_+3]}; x_=(x_-(f32x2_t){a_[0],a_[1]})+b2_; y_=(y_-(f32x2_t){a_[2],a_[3]})+b2_; \
      C1[4*g_]=x_[0];C1[4*g_+1]=x_[1];C1[4*g_+2]=y_[0];C1[4*g_+3]=y_[1]; } SBAR(); }while(0)
  f32x16 pA0,pA1,pB0,pB1;
  int sl_prev=0,sl_cur=0,sl_next=SLOTB;
  #define ROT() do{sl_prev=sl_cur;sl_cur=sl_next;sl_next=(sl_next==(NSLOT-1)*SLOTB)?0:sl_next+SLOTB;}while(0)
  DMA_K(2,2*SLOTB);
  WAIT_BAR(3);
  qkt(pA0,pA1,Kbase,qr,negm,r32,hi);asm volatile("s_nop 15\n\ts_nop 7":"+v"(pA0),"+v"(pA1));CKSUB(pA0,pA1,0);CMASK(pA0,pA1,0);
  START(pA0,pA1);
  _Pragma("unroll") for(int r=0;r<16;++r)pA1[r]=__builtin_amdgcn_exp2f(pA1[r]);
  WAIT_BAR(0);
  DMA_K(3,0);DMA_V(1,SLOTB);
  ROT();
  kload8(kf,kp0+sl_cur);
  WAIT_BAR(2);
  s16x4 vlo[8],vhi[8]; u32x4 pw0,pw1,pw2,pw3;
  #define PKW(P,B) cvtpk_s(P[B],P[B+1])
  #define PAF(k) __builtin_bit_cast(bf16x8,pw##k)
  #define VFR(i) (bf16x8){vlo[i][0],vlo[i][1],vlo[i][2],vlo[i][3],vhi[i][0],vhi[i][1],vhi[i][2],vhi[i][3]}
  #define PIN(x) asm volatile("":"+v"(x))
  #define MX3(a,b,c) __builtin_fmaxf(__builtin_fmaxf((a),(b)),(c))
  #define GAPA(MF,A0,A1,A2,A3,W0,W1,PW) do{ MF; sacc+=A0; sacc+=A1; sacc+=A2; sacc+=A3; PIN(sacc); W0; W1; PIN(PW); SBAR(); }while(0)
  #define EX(v) __builtin_amdgcn_exp2f(v)
  #define GAPB(MF,X,B) do{ MF; X[B]=EX(X[B]); X[B+1]=EX(X[B+1]); X[B+2]=EX(X[B+2]); X[B+3]=EX(X[B+3]); PIN(X); SBAR(); }while(0)
  #define VRD(i) do{ vlo[i]=vtr(vp_+(((i)>>2)*4096+((i)&3)*1024)); vhi[i]=vtr(vp_+(((i)>>2)*4096+((i)&3)*1024+512)); }while(0)
  #define KRD(G,j) do{ if(G){ kload2(kf,kp0+sl_next,j); SBAR(); } }while(0)
  #define STEP(C0,C1,P0,P1,t,GK,GV,GL) do{ SBAR(); \
    const lds_cptr vp_=vp0+sl_prev; \
    VRD(0); SBAR(); float sacc=(P0[0]+P0[1]); \
    GAPA(C0=__builtin_amdgcn_mfma_f32_32x32x16_bf16(kf[0],qr[0],negm,0,0,0), P0[2],P0[3],P0[4],P0[5],     pw0[0]=PKW(P0,0), pw0[1]=PKW(P0,2), pw0); \
    VRD(4); SBAR(); GAPA(C1=__builtin_amdgcn_mfma_f32_32x32x16_bf16(kf[1],qr[0],negm,0,0,0), P0[6],P0[7],P0[8],P0[9],     pw0[2]=PKW(P0,4), pw0[3]=PKW(P0,6), pw0); \
    VRD(1); SBAR(); GAPA(C0=__builtin_amdgcn_mfma_f32_32x32x16_bf16(kf[2],qr[1],C0,0,0,0),   P0[10],P0[11],P0[12],P0[13], pw1[0]=PKW(P0,8), pw1[1]=PKW(P0,10), pw1); \
    VRD(5); SBAR(); GAPA(C1=__builtin_amdgcn_mfma_f32_32x32x16_bf16(kf[3],qr[1],C1,0,0,0),   P0[14],P0[15],P1[0],P1[1],   pw1[2]=PKW(P0,12),pw1[3]=PKW(P0,14), pw1); \
    VRD(2); SBAR(); GAPA(C0=__builtin_amdgcn_mfma_f32_32x32x16_bf16(kf[4],qr[2],C0,0,0,0),   P1[2],P1[3],P1[4],P1[5],     pw2[0]=PKW(P1,0), pw2[1]=PKW(P1,2), pw2); \
    VRD(6); SBAR(); GAPA(C1=__builtin_amdgcn_mfma_f32_32x32x16_bf16(kf[5],qr[2],C1,0,0,0),   P1[6],P1[7],P1[8],P1[9],     pw2[2]=PKW(P1,4), pw2[3]=PKW(P1,6), pw2); \
    VRD(3); SBAR(); GAPA(C0=__builtin_amdgcn_mfma_f32_32x32x16_bf16(kf[6],qr[3],C0,0,0,0),   P1[10],P1[11],P1[12],P1[13], pw3[0]=PKW(P1,8), pw3[1]=PKW(P1,10), pw3); \
    VRD(7); SBAR(); GAPA(C1=__builtin_amdgcn_mfma_f32_32x32x16_bf16(kf[7],qr[3],C1,0,0,0),   P1[14],P1[15],0.f,0.f,       pw3[2]=PKW(P1,12),pw3[3]=PKW(P1,14), pw3); \
    l_reg+=sacc; \
    if(GK){DMA_K((t)+3,sl_cur);} if(GV){DMA_V((t)+1,sl_next);} \
    CKSUB(C0,C1,t); CMASK(C0,C1,t); \
    { float a=MX3(C0[0],C0[1],C1[0]),b=MX3(C0[2],C0[3],C1[1]); a=MX3(a,C1[2],C1[3]); \
      _Pragma("unroll") for(int r=4;r<16;r+=4){a=MX3(a,C0[r],C0[r+1]);b=MX3(b,C0[r+2],C0[r+3]);a=MX3(a,C1[r],C1[r+1]);b=MX3(b,C1[r+2],C1[r+3]);} \
      float rm=__builtin_fmaxf(a,b); { auto rr=__builtin_amdgcn_permlane32_swap(__float_as_uint(rm),__float_as_uint(rm),false,false); rm=__builtin_fmaxf(__uint_as_float(rr[0]),__uint_as_float(rr[1])); } \
      resc=false; \
      if(__builtin_expect(__any(rm>(float)THRL),0)){ const float dl=__builtin_fmaxf(rm,0.f); mhat+=dl; \
        _Pragma("unroll") for(int r=0;r<16;++r){C0[r]-=dl;C1[r]-=dl;} \
        base=cqp-mhat; \
        const float f=__builtin_amdgcn_exp2f(-dl); l_reg*=f; if(hi==0)wsf[r32]=f; resc=true; } } \
    SBAR(); \
    GAPB(o[0]=__builtin_amdgcn_mfma_f32_32x32x16_bf16(PAF(0),VFR(0),o[0],0,0,0), C0,0); \
    GAPB(o[1]=__builtin_amdgcn_mfma_f32_32x32x16_bf16(PAF(0),VFR(4),o[1],0,0,0), C0,4); \
    KRD(GL,0); GAPB(o[0]=__builtin_amdgcn_mfma_f32_32x32x16_bf16(PAF(1),VFR(1),o[0],0,0,0), C0,8); \
    KRD(GL,1); GAPB(o[1]=__builtin_amdgcn_mfma_f32_32x32x16_bf16(PAF(1),VFR(5),o[1],0,0,0), C0,12); \
    KRD(GL,2); GAPB(o[0]=__builtin_amdgcn_mfma_f32_32x32x16_bf16(PAF(2),VFR(2),o[0],0,0,0), C1,0); \
    KRD(GL,3); GAPB(o[1]=__builtin_amdgcn_mfma_f32_32x32x16_bf16(PAF(2),VFR(6),o[1],0,0,0), C1,4); \
    GAPB(o[0]=__builtin_amdgcn_mfma_f32_32x32x16_bf16(PAF(3),VFR(3),o[0],0,0,0), C1,8); \
    GAPB(o[1]=__builtin_amdgcn_mfma_f32_32x32x16_bf16(PAF(3),VFR(7),o[1],0,0,0), C1,12); \
    }while(0)
  int t=1;
  #undef CMASK
  #define CMASK(P0,P1,t) do{}while(0)
  for(;t+5<NT;t+=2){
    STEP(pB0,pB1,pA0,pA1,t,true,true,true);     WAIT_BAR(2); RESC(); ROT();
    STEP(pA0,pA1,pB0,pB1,t+1,true,true,true);   WAIT_BAR(2); RESC(); ROT();
  }
  #undef CMASK
  #define CMASK(P0,P1,t) do{int jb_=(t)-(NT-4); if(jb_>=0)cmask(P0,P1,jb_,qrel,hi);}while(0)
  #define ENDW(tt) do{ if((tt)+3<NT){WAIT_BAR(2);} else if((tt)+2<NT){WAIT_BAR(1);} else {WAIT_BAR(0);} }while(0)
  for(;t+1<NT;t+=2){
    STEP(pB0,pB1,pA0,pA1,t,(t+3<NT),(t+1<NT),(t+1<NT));       ENDW(t);   RESC(); ROT();
    STEP(pA0,pA1,pB0,pB1,t+1,(t+4<NT),(t+2<NT),(t+2<NT));     ENDW(t+1); RESC(); ROT();
  }
  STEP(pB0,pB1,pA0,pA1,NT-1,false,false,false); RESC();
  { float sacc=pB0[0]+pB0[1]; _Pragma("unroll") for(int r=2;r<16;++r)sacc+=pB0[r]; _Pragma("unroll") for(int r=0;r<16;++r)sacc+=pB1[r]; l_reg+=sacc;
    pw0=(u32x4){PKW(pB0,0),PKW(pB0,2),PKW(pB0,4),PKW(pB0,6)};pw1=(u32x4){PKW(pB0,8),PKW(pB0,10),PKW(pB0,12),PKW(pB0,14)};pw2=(u32x4){PKW(pB1,0),PKW(pB1,2),PKW(pB1,4),PKW(pB1,6)};pw3=(u32x4){PKW(pB1,8),PKW(pB1,10),PKW(pB1,12),PKW(pB1,14)};
    SBAR(); pv(o,vb0+sl_cur,PAF(0),PAF(1),PAF(2),PAF(3)); }
  #undef PKW
  #undef PAF
  #undef VFR
  #undef PIN
  #undef MX3
  #undef GAPA
  #undef GAPB
  #undef EX
  #undef VRD
  #undef KRD
  #undef STEP
  #undef ENDW
  {auto rr=__builtin_amdgcn_permlane32_swap(__float_as_uint(l_reg),__float_as_uint(l_reg),false,false);l_reg=__uint_as_float(rr[0])+__uint_as_float(rr[1]);}
  int lane_e=lane_id(); asm volatile("":"+v"(lane_e));
  const int r32e=lane_e&31,hie=lane_e>>5; float*wsfe=(float*)(shm+LDS_WS)+wid*64;
  if(hie==0)wsfe[32+r32e]=l_reg;asm volatile("s_waitcnt lgkmcnt(0)":::"memory");
  float rli[16];
  #pragma unroll
  for(int r=0;r<16;++r)rli[r]=__builtin_amdgcn_rcpf(wsfe[32+crow(r,hie)]);
  bf16*Ow=O+(rowbase+q0+wid*QBLK)*QP+h*D;
  { bf16*stg=(bf16*)(shm+LDS_OST)+wid*2048;
    #pragma unroll
    for(int r=0;r<16;++r){const int orow=crow(r,hie);
      #pragma unroll
      for(int d0=0;d0<2;++d0)stg[orow*64+d0*32+r32e]=__float2bfloat16(o[d0][r]*rli[r]);}
    asm volatile("s_waitcnt lgkmcnt(0)":::"memory");
    #pragma unroll
    for(int i=0;i<4;++i){const int row=i*8+(lane_e>>3),ch=lane_e&7; const u32x4 v=*(const u32x4*)(stg+row*64+ch*8); ATTN_STORE16(Ow+(long)row*QP+ch*8,v);} }
  asm volatile("s_waitcnt lgkmcnt(0)\n\ts_barrier":::"memory");
  #undef DMA_K
  #undef PT
  #undef CKSUB
  #undef DMA_V
  #undef CMASK
  #undef START
  #undef RESC
  #undef ROT
}
constexpr int ATTN_LDS_BYTES=LDS_BYTES;
struct AttnTensors { const bf16* Q; const bf16* K; const bf16* V; bf16* O; const float* CQ; };
struct AttnUnit { int bh; int qb; };
struct StaticOrder {
  int vcu;
  __device__ __forceinline__ explicit StaticOrder(int grid,int block):vcu((block%8)*(grid/8)+block/8){}
  __device__ __forceinline__ bool next(int i,AttnUnit&u)const{ if(i>=2)return false; const int s=vcu&7; u.bh=vcu>>3; u.qb=(i==0)?s:15-s; return true; }
  __device__ __forceinline__ void a_ready(const AttnUnit&)const{}
  __device__ __forceinline__ void done(const AttnUnit&)const{}
};
struct QueueOrder {
  unsigned* ctr; volatile __attribute__((address_space(3))) unsigned* slot; bool t0;
  __device__ __forceinline__ bool next(int,AttnUnit&u)const{ if(t0)*slot=atomicAdd(ctr,1u); __syncthreads(); const unsigned idx=(unsigned)__builtin_amdgcn_readfirstlane((int)*slot);
    if(idx>=(unsigned)(BATCH*NHEAD*NQB))return false; u.qb=NQB-1-(int)(idx>>5); u.bh=(int)(idx&31); return true; }
  __device__ __forceinline__ void a_ready(const AttnUnit&)const{}
  __device__ __forceinline__ void done(const AttnUnit&)const{}
};
template<class Sched,int THRL=8> __device__ __forceinline__ void attn_phase(char*lds,const AttnTensors&T,const Sched&S,const int wave_s){
  AttnUnit u;
  for(int i=0;S.next(i,u);++i){ S.a_ready(u); attn_unit<THRL>(u.bh/NHEAD,u.bh%NHEAD,u.qb,T.Q,T.K,T.V,T.O,T.CQ,lds,wave_s); S.done(u); }
}
#undef SBAR
#undef WAIT_BAR
}

namespace dn {
typedef short bf16x8 __attribute__((ext_vector_type(8)));
typedef float f32x16 __attribute__((ext_vector_type(16)));
typedef float f32x4 __attribute__((ext_vector_type(4)));
typedef float f32x2 __attribute__((ext_vector_type(2)));
typedef unsigned u32x4 __attribute__((ext_vector_type(4)));
typedef unsigned u32x2 __attribute__((ext_vector_type(2)));
#define DLAS __attribute__((address_space(3)))
constexpr int NCH = 66, NITEM = 16 * 65;
constexpr int IMG_W = 0, IMG_Q = 16384, IMG_K = 32768, IMG_A = 49152, IMG_BYTES = 57344;
constexpr float QSCALE = 0.08838834764831845f;
__device__ __forceinline__ int img_off128(int m, int k) { const int ch = 2 * (k >> 4) + ((k >> 2) & 1), pos = 4 * ((k >> 3) & 1) + (k & 3); return m * 256 + ((ch ^ (m & 15)) << 4) + pos * 2; }
__device__ __forceinline__ int img_off64(int m, int k)  { const int ch = 2 * (k >> 4) + ((k >> 2) & 1), pos = 4 * ((k >> 3) & 1) + (k & 3); return m * 128 + ((ch ^ ((m >> 1) & 7)) << 4) + pos * 2; }
__device__ __forceinline__ float bfl(unsigned w) { return __builtin_bit_cast(float, w << 16); }
__device__ __forceinline__ float bfh(unsigned w) { return __builtin_bit_cast(float, w & 0xffff0000u); }
typedef __bf16 bf16x2_t __attribute__((ext_vector_type(2)));
__device__ __forceinline__ unsigned pkbf(float lo, float hi) { const f32x2 v = {lo, hi}; return __builtin_bit_cast(unsigned, __builtin_convertvector(v, bf16x2_t)); }
__device__ __forceinline__ float wsum(float v) {
#pragma unroll
    for (int o = 1; o < 64; o <<= 1) v += __shfl_xor(v, o);
    return v;
}
struct PrepArgs { const bf16* DQKV; const float* cw; const float* GG; const float* BT; unsigned char* PREP; float* U; float* CD; unsigned* FLAG; unsigned* TS; };
constexpr int L_QB = 0, L_KB = 17408, L_RHS = 34816, L_AM = 100352, L_AIMG = 117760, L_SC = 125952, L_IMG = L_RHS;

template <int J> __device__ __forceinline__ void solve2_load(f32x4 (&C)[8], int amt_h) {
#pragma unroll
    for (int g = 0; g < 8; ++g) C[g] = *(const DLAS f32x4*)((const DLAS unsigned char*)(size_t)0 + amt_h + (J * 68 + 4 * g) * 4);
}
template <int J> __device__ __forceinline__ float solve2_xj(const float (&x)[32]) {
    const float own = x[J & 31]; const auto rr = __builtin_amdgcn_permlane32_swap(__float_as_uint(own), __float_as_uint(own), false, false);
    return J < 32 ? __uint_as_float(rr[0]) : __uint_as_float(rr[1]);
}
template <int J> __device__ __forceinline__ void solve2_apply(float (&x)[32], const f32x4 (&C)[8], float xj) {
#pragma unroll
    for (int g = 0; g < 8; ++g) { x[4 * g] -= C[g].x * xj; x[4 * g + 1] -= C[g].y * xj; x[4 * g + 2] -= C[g].z * xj; x[4 * g + 3] -= C[g].w * xj; }
}
template <int J> __device__ __forceinline__ void solve2_rows(float (&x)[32], f32x4 (&CA)[8], f32x4 (&CB)[8], int amt_h) {
    if constexpr (J < 63) {
        const float xj = solve2_xj<J>(x);
        if constexpr (J + 1 < 63) { asm volatile("" : "+v"(amt_h) : "v"(xj)); solve2_load<J + 1>(CB, amt_h); }
        solve2_apply<J>(x, CA, xj);
        solve2_rows<J + 1>(x, CB, CA, amt_h);
    }
}
#define DN_FRESH_LANE() asm volatile("" : "+v"(lane))
#define PSTAMP(i) do { if (PROBE_TS && P.TS && wave == 0 && lane == 0) __hip_atomic_store(P.TS + (i), (unsigned)__builtin_amdgcn_s_memrealtime(), __ATOMIC_RELAXED, __HIP_MEMORY_SCOPE_AGENT); } while (0)
__device__ __forceinline__ void prep_item(DLAS unsigned char* lds, const PrepArgs& P, int bh, int n, int wave, int lane) {
    DN_FRESH_LANE(); PSTAMP(0);
    const int b = bh >> 2, h = bh & 3; const size_t rowbase = (size_t)b * LP + 64 * n; const int item = bh * NCH + n;
    int vz = 0; asm volatile("" : "+v"(vz));
    DLAS float* SCf = (DLAS float*)(lds + L_SC + vz);
    if (wave == 0) { const float g = P.GG[(size_t)bh * LP + 64 * n + lane], be = P.BT[(size_t)bh * LP + 64 * n + lane]; float gc = g;
#pragma unroll
        for (int o = 1; o < 64; o <<= 1) { const float t = __shfl_up(gc, o); if (lane >= o) gc += t; }
        const float gl = __shfl(gc, 63);
        SCf[lane] = gc; SCf[64 + lane] = be; SCf[128 + lane] = __expf(gc); SCf[192 + lane] = __expf(gl - gc); SCf[256 + lane] = be * __expf(gc);
        if (lane == 63) P.CD[item] = __expf(gc); }
    { const int r0 = 8 * wave;
      unsigned u[3][11]; float w0[3][4], w1[3][4];
      const unsigned lo4 = 4u * (unsigned)lane, lo8 = 8u * (unsigned)lane;
#pragma unroll
      for (int which = 0; which < 3; ++which) { const int colu = which * 512 + h * 128;
        const unsigned char* wb = (const unsigned char*)(P.cw + colu); const unsigned char* ub = (const unsigned char*)(P.DQKV + (rowbase + r0 - 3) * 1536 + colu);
#pragma unroll
        for (int i = 0; i < 4; ++i) { const f32x2 wv = *(const f32x2*)(wb + (size_t)i * 1536 * 4 + lo8); w0[which][i] = wv.x; w1[which][i] = wv.y; }
#pragma unroll
        for (int rr = 0; rr < 11; ++rr) u[which][rr] = *(const unsigned*)(ub + (size_t)rr * 1536 * 2 + lo4); }
#pragma unroll
      for (int which = 0; which < 3; ++which) { float a0[8], a1[8], ss[8];
#pragma unroll
        for (int r = 0; r < 8; ++r) { float x0 = 0.f, x1 = 0.f;
#pragma unroll
            for (int i = 0; i < 4; ++i) { x0 += w0[which][i] * bfl(u[which][r + i]); x1 += w1[which][i] * bfh(u[which][r + i]); }
            x0 = x0 * __builtin_amdgcn_rcpf(1.f + __expf(-x0)); x1 = x1 * __builtin_amdgcn_rcpf(1.f + __expf(-x1)); a0[r] = x0; a1[r] = x1; ss[r] = x0 * x0 + x1 * x1; }
        if (which < 2) {
#pragma unroll
            for (int o = 1; o < 64; o <<= 1)
#pragma unroll
                for (int r = 0; r < 8; ++r) ss[r] += __shfl_xor(ss[r], o);
#pragma unroll
            for (int r = 0; r < 8; ++r) { const float rs = rsqrtf(ss[r] + EPS); a0[r] *= rs; a1[r] *= rs; } }
#pragma unroll
        for (int r = 0; r < 8; ++r) { const int row = r0 + r;
            if (which < 2) { *(DLAS unsigned*)(lds + (which == 0 ? L_QB : L_KB) + row * 272 + 4 * lane) = pkbf(a0[r], a1[r]);
                if (which == 1) *(DLAS f32x2*)(lds + L_RHS + row * 1024 + 512 + 8 * lane) = (f32x2){a0[r], a1[r]}; }
            else *(DLAS f32x2*)(lds + L_RHS + row * 1024 + 8 * lane) = (f32x2){a0[r], a1[r]}; } } }
    __syncthreads();
    DN_FRESH_LANE(); PSTAMP(1);
    { const int which = wave >> 2, ti = (wave >> 1) & 1, tj = wave & 1, m = lane & 31, hh = lane >> 5;
      const DLAS unsigned char* ap = lds + (which == 0 ? L_KB : L_QB) + (32 * ti + m) * 272 + hh * 16; const DLAS unsigned char* bp = lds + L_KB + (32 * tj + m) * 272 + hh * 16;
      f32x16 acc = f32x16{};
#pragma unroll
      for (int s = 0; s < 8; ++s) acc = __builtin_amdgcn_mfma_f32_32x32x16_bf16(*(const DLAS bf16x8*)(ap + 32 * s), *(const DLAS bf16x8*)(bp + 32 * s), acc, 0, 0, 0);
      const int col = 32 * tj + m; const float gcc = SCf[col];
#pragma unroll
      for (int r = 0; r < 16; ++r) { const int row = 32 * ti + (r & 3) + 8 * (r >> 2) + 4 * hh; const float d = __expf(fminf(SCf[row] - gcc, 0.f));
          if (which == 0) { *(DLAS float*)(lds + L_AM + (row * 68 + col) * 4) = col < row ? SCf[64 + row] * acc[r] * d : 0.f; }
          else { const float v = col <= row ? acc[r] * QSCALE * d : 0.f; *(DLAS unsigned short*)(lds + L_AIMG + img_off64(row, col)) = (unsigned short)(pkbf(v, 0.f) & 0xffffu); } } }
    __syncthreads();
    DN_FRESH_LANE(); PSTAMP(2);
    if (wave < 4) {
        const int c = 64 * wave + lane; float x[64];
#pragma unroll
        for (int i = 0; i < 64; ++i) { const float sc = (c < 128) ? SCf[64 + i] : SCf[64 + i] * SCf[128 + i]; x[i] = *(const DLAS float*)(lds + L_RHS + (i * 256 + c) * 4) * sc; }
        __syncthreads();
#pragma unroll
        for (int i = 1; i < 64; ++i) { float s0 = 0.f, s1 = 0.f, s2 = 0.f, s3 = 0.f;
#pragma unroll
            for (int j4 = 0; j4 < (i + 3) / 4; ++j4) { const f32x4 a = *(const DLAS f32x4*)(lds + vz + L_AM + (i * 68 + 4 * j4) * 4);
                s0 += a.x * x[4 * j4]; s1 += a.y * x[4 * j4 + 1]; s2 += a.z * x[4 * j4 + 2]; s3 += a.w * x[4 * j4 + 3]; }
            x[i] -= (s0 + s1) + (s2 + s3); __builtin_amdgcn_sched_barrier(0); }
        if (c < 128) {
            float* up = P.U + (size_t)item * 8192 + (size_t)(c >> 5) * 2048 + (c & 31) * 16;
#pragma unroll
            for (int t = 0; t < 2; ++t)
#pragma unroll
                for (int hi = 0; hi < 2; ++hi)
#pragma unroll
                    for (int q = 0; q < 4; ++q) { const int rb = 32 * t + 8 * q + 4 * hi; *(f32x4*)(up + t * 1024 + hi * 512 + 4 * q) = (f32x4){x[rb], x[rb + 1], x[rb + 2], x[rb + 3]}; }
        } else { const int dk = c - 128;
#pragma unroll
            for (int i = 0; i < 64; ++i) *(DLAS unsigned short*)(lds + L_IMG + IMG_W + img_off128(i, dk)) = (unsigned short)(pkbf(-x[i], 0.f) & 0xffffu); }
    } else {
        __syncthreads();
        const int t = (wave - 4) * 64 + lane;
        { const int i = t >> 2, d0 = (t & 3) * 32; const float sc = QSCALE * SCf[128 + i];
#pragma unroll
          for (int g8 = 0; g8 < 4; ++g8) { const u32x4 qv = *(const DLAS u32x4*)(lds + L_QB + i * 272 + (d0 + 8 * g8) * 2);
              u32x2 lo, hi2; lo.x = pkbf(bfl(qv.x) * sc, bfh(qv.x) * sc); lo.y = pkbf(bfl(qv.y) * sc, bfh(qv.y) * sc); hi2.x = pkbf(bfl(qv.z) * sc, bfh(qv.z) * sc); hi2.y = pkbf(bfl(qv.w) * sc, bfh(qv.w) * sc);
              *(DLAS u32x2*)(lds + L_IMG + IMG_Q + img_off128(i, d0 + 8 * g8)) = lo; *(DLAS u32x2*)(lds + L_IMG + IMG_Q + img_off128(i, d0 + 8 * g8 + 4)) = hi2; } }
        { const int d = t >> 1, g0 = (t & 1) * 8;
#pragma unroll
          for (int g = 0; g < 8; ++g) { const int c0 = 4 * (g0 + g); float v[4];
#pragma unroll
              for (int e = 0; e < 4; ++e) v[e] = bfl((unsigned)*(const DLAS unsigned short*)(lds + L_KB + (c0 + e) * 272 + d * 2)) * SCf[192 + c0 + e];
              u32x2 w; w.x = pkbf(v[0], v[1]); w.y = pkbf(v[2], v[3]); *(DLAS u32x2*)(lds + L_IMG + IMG_K + img_off64(d, c0)) = w; } }
    }
    __syncthreads();
    DN_FRESH_LANE(); PSTAMP(3);
    { const int t = wave * 64 + lane; unsigned char* dst = P.PREP + (size_t)item * IMG_BYTES;
#pragma unroll
      for (int p = 0; p < 6; ++p) *(u32x4*)(dst + (p * 512 + t) * 16) = *(const DLAS u32x4*)(lds + L_IMG + (p * 512 + t) * 16);
      *(u32x4*)(dst + IMG_A + t * 16) = *(const DLAS u32x4*)(lds + L_AIMG + t * 16); }
    asm volatile("s_waitcnt vmcnt(0)" ::: "memory");
    __syncthreads(); PSTAMP(4);
    if (wave == 0 && lane == 0) { __builtin_amdgcn_fence(__ATOMIC_RELEASE, "agent"); asm volatile("s_waitcnt vmcnt(0)" ::: "memory"); __hip_atomic_store(P.FLAG + item, 1u, __ATOMIC_RELAXED, __HIP_MEMORY_SCOPE_AGENT); }
    PSTAMP(5);
}
struct RecArgs { const unsigned char* PREP; const float* U; const float* CD; const bf16* DZ; const float* onw; bf16* OD; const unsigned* FLAG; unsigned* TS; };
__device__ __forceinline__ void rec_wait_chunk(const unsigned* f) { unsigned sp = 0;
    while (__builtin_amdgcn_readfirstlane((int)__hip_atomic_load(f, __ATOMIC_RELAXED, __HIP_MEMORY_SCOPE_AGENT)) == 0) { __builtin_amdgcn_s_sleep(4); if (++sp > (1u << 22)) break; }
    __builtin_amdgcn_fence(__ATOMIC_ACQUIRE, "agent"); }
constexpr int R_IMG0 = 0, R_IMG1 = IMG_BYTES, R_OB = 2 * IMG_BYTES, R_BYTES = R_OB + 64 * 128 * 4;
#define DN_BAR() do { asm volatile("s_waitcnt vmcnt(0) lgkmcnt(0)" ::: "memory"); __builtin_amdgcn_s_barrier(); asm volatile("" ::: "memory"); } while (0)
__device__ __forceinline__ bf16x8 pack8(const f32x16& v, int s) { u32x4 w; w.x = pkbf(v[8 * s], v[8 * s + 1]); w.y = pkbf(v[8 * s + 2], v[8 * s + 3]); w.z = pkbf(v[8 * s + 4], v[8 * s + 5]); w.w = pkbf(v[8 * s + 6], v[8 * s + 7]); return __builtin_bit_cast(bf16x8, w); }
__device__ __forceinline__ void rec_dma_images(DLAS unsigned char* dst, const unsigned char* src, int w4, int lane) {
    const unsigned char* gp = src + w4 * 1024 + lane * 16; DLAS unsigned char* lp = dst + w4 * 1024;
#pragma unroll 1
    for (int p = 0; p < 14; ++p) { __builtin_amdgcn_global_load_lds((const unsigned*)gp, (DLAS unsigned*)lp, 16, 0, 0); gp += 4096; lp += 4096; }
}
struct ZPre { u32x4 z[4]; };
__device__ __forceinline__ void rec_load_z(ZPre& Z, const RecArgs& A, int b, int h, int n, int t256) {
    const int row = t256 >> 2, c0 = (t256 & 3) * 32; const bf16* zp = A.DZ + ((size_t)b * LP + 64 * n + row) * 512 + h * 128 + c0;
#pragma unroll
    for (int q = 0; q < 4; ++q) Z.z[q] = *(const u32x4*)(zp + 8 * q);
}
template <int MODE> __device__ __forceinline__ void rec_finalize(const DLAS unsigned char* lds, const RecArgs& A, const u32x4 (&RS)[18], const float (&nw)[32], int b, int h, int n, int t256) {
    const int row = t256 >> 2, c0 = (t256 & 3) * 32; const size_t grow = (size_t)b * LP + 64 * n + row;
    const DLAS float* op = (const DLAS float*)(lds + R_OB) + row * 128 + c0; float v[32]; float ss = 0.f;
#pragma unroll
    for (int q = 0; q < 8; ++q) { const f32x4 t = *(const DLAS f32x4*)(op + 4 * q); v[4 * q] = t.x; v[4 * q + 1] = t.y; v[4 * q + 2] = t.z; v[4 * q + 3] = t.w; ss += (t.x * t.x + t.y * t.y) + (t.z * t.z + t.w * t.w); }
    ss += __shfl_xor(ss, 1); ss += __shfl_xor(ss, 2);
    const float rs = rsqrtf(ss * (1.f / 128.f) + EPS);
    bf16* dst = A.OD + grow * 1024 + 512 + h * 128 + c0;
#pragma unroll
    for (int q = 0; q < 4; ++q) { const u32x4 z = RS[14 + q]; float zz[8] = {bfl(z.x), bfh(z.x), bfl(z.y), bfh(z.y), bfl(z.z), bfh(z.z), bfl(z.w), bfh(z.w)}; float r[8];
#pragma unroll
        for (int e = 0; e < 8; ++e) r[e] = v[8 * q + e] * rs * zz[e];
        u32x4 o; o.x = pkbf(r[0], r[1]); o.y = pkbf(r[2], r[3]); o.z = pkbf(r[4], r[5]); o.w = pkbf(r[6], r[7]); if (MODE == 0) *(u32x4*)(dst + 8 * q) = o; else asm volatile("" :: "v"(o)); }
}
#define CSTAMP(cond, i) do { if (PROBE_TS && MODE == 0 && A.TS && (cond)) __hip_atomic_store(A.TS + (i), (unsigned)__builtin_amdgcn_s_memrealtime(), __ATOMIC_RELAXED, __HIP_MEMORY_SCOPE_AGENT); } while (0)
#define DN_BAR_L() do { asm volatile("s_waitcnt lgkmcnt(0)" ::: "memory"); __builtin_amdgcn_s_barrier(); asm volatile("" ::: "memory"); } while (0)
template <int MODE> __device__ __forceinline__ void rec_chain(DLAS unsigned char* lds, const RecArgs& A, int bh, int wave, int lane) {
    const int b = bh >> 2, h = bh & 3;
    if (wave >= 4) {
        const int w4 = wave - 4, t256 = w4 * 64 + lane;
        const unsigned voff = (unsigned)t256 * 16u;
        const unsigned* flg = A.FLAG + bh * NCH;
        int ready = 0;
#define REC_ENSURE(k) do { if (MODE == 0) { unsigned sp_ = 0; bool adv_ = false; while (ready < (k)) { const int i_ = ready + 1 + (lane & 15); \
              const unsigned f_ = (i_ < NCH) ? __hip_atomic_load(flg + i_, __ATOMIC_RELAXED, __HIP_MEMORY_SCOPE_AGENT) : 0u; \
              const unsigned long long m_ = __ballot(f_ == 0u) & 0xffffull; const int run_ = m_ ? (int)__builtin_ctzll(m_) : 16; \
              if (run_ > 0) { ready += run_; adv_ = true; } else { __builtin_amdgcn_s_sleep(8); if (++sp_ > (1u << 20)) break; } } \
            if (adv_) __builtin_amdgcn_fence(__ATOMIC_ACQUIRE, "agent"); } } while (0)
        u32x4 R0[18], R1[18];
        const unsigned zoff = (unsigned)(((t256 >> 2) * 512 + (t256 & 3) * 32) * 2);
#define REC_LOADR(RS, nn, zn_) do { if ((zn_) < NCH) { const unsigned char* zb_ = (const unsigned char*)(A.DZ + ((size_t)b * LP + 64 * (zn_)) * 512 + h * 128); asm volatile("" : "+s"(zb_)); \
            _Pragma("unroll") for (int q = 0; q < 4; ++q) asm volatile("global_load_dwordx4 %0, %1, %2 offset:%c3" : "=v"(RS[14 + q]) : "v"(zoff), "s"(zb_), "i"(16 * q)); } \
        if ((nn) < NCH) { REC_ENSURE(nn); const unsigned char* g_ = A.PREP + (size_t)(bh * NCH + (nn)) * IMG_BYTES; asm volatile("" : "+s"(g_)); \
            _Pragma("unroll") for (int p = 0; p < 14; ++p) { const unsigned char* gp_ = g_ + p * 4096; asm volatile("global_load_dwordx4 %0, %1, %2" : "=v"(RS[p]) : "v"(voff), "s"(gp_)); } } } while (0)
#define REC_RETIRE(RS, n) do { if ((n) > 2 && (n) < 63) asm volatile("s_waitcnt vmcnt(22)" ::: "memory"); else asm volatile("s_waitcnt vmcnt(0)" ::: "memory"); \
        _Pragma("unroll") for (int p = 0; p < 18; ++p) asm volatile("" : "+v"(RS[p])); } while (0)
#define REC_STORER(RS, nn) do { DLAS unsigned char* d_ = lds + (((nn) & 1) ? R_IMG1 : R_IMG0) + t256 * 16; _Pragma("unroll") for (int p = 0; p < 14; ++p) *(DLAS u32x4*)(d_ + p * 4096) = RS[p]; } while (0)
#define REC_ITER(RS, n) do { CSTAMP((n) == 40 && t256 == 0, 10); \
            if (MODE != 1) { REC_RETIRE(RS, n); CSTAMP((n) == 40 && t256 == 0, 21); if ((n) > 1) rec_finalize<MODE>(lds, A, RS, nw, b, h, (n) - 1, t256); CSTAMP((n) == 40 && t256 == 0, 11); \
                if ((n) + 1 < NCH) REC_STORER(RS, (n) + 1); CSTAMP((n) == 40 && t256 == 0, 12); \
                REC_LOADR(RS, (n) + 3, (n) + 1); } CSTAMP((n) == 40 && t256 == 0, 13); \
            DN_BAR_L();        CSTAMP((n) == 40 && t256 == 0, 14); \
            DN_BAR_L();        CSTAMP((n) == 40 && t256 == 0, 15); } while (0)
        REC_LOADR(R1, 1, NCH); REC_LOADR(R0, 2, NCH);
        float nw[32];
#pragma unroll
        for (int q = 0; q < 8; ++q) { const f32x4 t = *(const f32x4*)(A.onw + (t256 & 3) * 32 + 4 * q); nw[4 * q] = t.x; nw[4 * q + 1] = t.y; nw[4 * q + 2] = t.z; nw[4 * q + 3] = t.w; }
        REC_RETIRE(R1, 0); REC_STORER(R1, 1); REC_LOADR(R1, 3, 1);
        DN_BAR_L();
        for (int n = 1; n + 1 < NCH; n += 2) { REC_ITER(R0, n); REC_ITER(R1, n + 1); }
        REC_ITER(R0, NCH - 1);
        if (MODE != 1) { REC_RETIRE(R1, 0); rec_finalize<MODE>(lds, A, R1, nw, b, h, NCH - 1, t256); }
#undef REC_LOADR
#undef REC_RETIRE
#undef REC_STORER
#undef REC_ITER
#undef REC_ENSURE
    } else {
        const int m = lane & 31, hh = lane >> 5;
        f32x16 S[4]; bf16x8 Sb[8]; f32x16 un[2];
#pragma unroll
        for (int d = 0; d < 4; ++d) S[d] = f32x16{};
#pragma unroll
        for (int s = 0; s < 8; ++s) Sb[s] = bf16x8{};
        if (MODE == 0) rec_wait_chunk(A.FLAG + bh * NCH + 1);
        { const float* up = A.U + (size_t)(bh * NCH + 1) * 8192 + wave * 2048 + lane * 16;
#pragma unroll
          for (int t = 0; t < 2; ++t) { const f32x4 a = *(const f32x4*)(up + t * 1024), bq = *(const f32x4*)(up + t * 1024 + 4), c = *(const f32x4*)(up + t * 1024 + 8), d = *(const f32x4*)(up + t * 1024 + 12);
              un[t] = (f32x16){a.x, a.y, a.z, a.w, bq.x, bq.y, bq.z, bq.w, c.x, c.y, c.z, c.w, d.x, d.y, d.z, d.w}; } }
        DN_BAR_L();
        const int c15 = (hh ^ (m & 15)) << 4, c7 = (hh ^ ((m >> 1) & 7)) << 4;
        const int aW0 = IMG_W + m * 256, aW1 = IMG_W + (32 + m) * 256, aQ0 = IMG_Q + m * 256, aQ1 = IMG_Q + (32 + m) * 256, aA0 = IMG_A + m * 128, aA1 = IMG_A + (32 + m) * 128, aK0 = IMG_K + m * 128;
#define FR(off) (*(const DLAS bf16x8*)(img + (off)))
#define SB_() __builtin_amdgcn_sched_barrier(0)
#define MF_(a, b, c) c = __builtin_amdgcn_mfma_f32_32x32x16_bf16(a, b, c, 0, 0, 0)
#define LD_G1(F, s) do { F[0] = FR(aW0 + ((32 * (s)) ^ c15)); F[1] = FR(aQ0 + ((32 * (s)) ^ c15)); F[2] = FR(aW1 + ((32 * (s)) ^ c15)); F[3] = FR(aQ1 + ((32 * (s)) ^ c15)); } while (0)
#define MM_G1(F, s) do { MF_(F[0], Sb[s], vn[0]); MF_(F[1], Sb[s], o[0]); MF_(F[2], Sb[s], vn[1]); MF_(F[3], Sb[s], o[1]); } while (0)
#define LD_G2(F, j) do { F[0] = FR(aA0 + ((32 * (2 * (j))) ^ c7)); F[1] = FR(aA1 + ((32 * (2 * (j))) ^ c7)); F[2] = FR(aA0 + ((32 * (2 * (j) + 1)) ^ c7)); F[3] = FR(aA1 + ((32 * (2 * (j) + 1)) ^ c7)); } while (0)
#define MM_G2(F, j) do { MF_(F[0], vb[2 * (j)], o[0]); MF_(F[1], vb[2 * (j)], o[1]); MF_(F[2], vb[2 * (j) + 1], o[0]); MF_(F[3], vb[2 * (j) + 1], o[1]); } while (0)
#define LD_G3(F, s) do { F[0] = FR(aK0 + ((32 * (s)) ^ c7)); F[1] = FR(aK0 + 32 * 128 + ((32 * (s)) ^ c7)); F[2] = FR(aK0 + 64 * 128 + ((32 * (s)) ^ c7)); F[3] = FR(aK0 + 96 * 128 + ((32 * (s)) ^ c7)); } while (0)
#define MM_G3(F, s) do { MF_(F[0], vb[s], S[0]); MF_(F[1], vb[s], S[1]); MF_(F[2], vb[s], S[2]); MF_(F[3], vb[s], S[3]); } while (0)
        for (int n = 1; n < NCH; ++n) {
            if (MODE == 2) { DN_BAR_L(); DN_BAR_L(); continue; }
            if (PROBE_TS && MODE == 0 && A.TS && wave == 0 && lane == 0 && (n % 10) == 0) __hip_atomic_store(A.TS + n / 10, (unsigned)__builtin_amdgcn_s_memrealtime(), __ATOMIC_RELAXED, __HIP_MEMORY_SCOPE_AGENT);
            const DLAS unsigned char* img = lds + ((n & 1) ? R_IMG1 : R_IMG0);
            const float cd = A.CD[bh * NCH + n];
            f32x16 vn[2], o[2]; bf16x8 fa[4], fb[4];
#pragma unroll
            for (int t = 0; t < 2; ++t) { vn[t] = un[t]; o[t] = f32x16{}; }
            CSTAMP(n == 40 && wave == 0 && lane == 0, 16);
            LD_G1(fa, 0); SB_();
            LD_G1(fb, 1); SB_(); MM_G1(fa, 0); S[0] = S[0] * cd; SB_();
            LD_G1(fa, 2); SB_(); MM_G1(fb, 1); S[1] = S[1] * cd; SB_();
            LD_G1(fb, 3); SB_(); MM_G1(fa, 2); S[2] = S[2] * cd; SB_();
            LD_G1(fa, 4); SB_(); MM_G1(fb, 3); S[3] = S[3] * cd; SB_();
            LD_G1(fb, 5); SB_(); MM_G1(fa, 4); SB_();
            LD_G1(fa, 6); SB_(); MM_G1(fb, 5); SB_();
            LD_G1(fb, 7); SB_(); MM_G1(fa, 6); SB_();
            LD_G2(fa, 0); SB_(); MM_G1(fb, 7); SB_(); CSTAMP(n == 40 && wave == 0 && lane == 0, 17);
            if (n + 1 < NCH) {
                const float* up = A.U + (size_t)(bh * NCH + n + 1) * 8192 + wave * 2048 + lane * 16;
#pragma unroll
                for (int t = 0; t < 2; ++t) { const f32x4 a = *(const f32x4*)(up + t * 1024), bq = *(const f32x4*)(up + t * 1024 + 4), c = *(const f32x4*)(up + t * 1024 + 8), d = *(const f32x4*)(up + t * 1024 + 12);
                    un[t] = (f32x16){a.x, a.y, a.z, a.w, bq.x, bq.y, bq.z, bq.w, c.x, c.y, c.z, c.w, d.x, d.y, d.z, d.w}; } }
            bf16x8 vb[4];
#pragma unroll
            for (int t = 0; t < 2; ++t) { vb[2 * t] = pack8(vn[t], 0); vb[2 * t + 1] = pack8(vn[t], 1); }
            SB_();
            LD_G2(fb, 1); SB_(); MM_G2(fa, 0); SB_();
            LD_G3(fa, 0); SB_(); MM_G2(fb, 1); SB_();
            LD_G3(fb, 1); SB_(); MM_G3(fa, 0); SB_();
            LD_G3(fa, 2); SB_(); MM_G3(fb, 1); SB_();
            LD_G3(fb, 3); SB_(); MM_G3(fa, 2); SB_();
            MM_G3(fb, 3); SB_();
#pragma unroll
            for (int d = 0; d < 4; ++d) { Sb[2 * d] = pack8(S[d], 0); Sb[2 * d + 1] = pack8(S[d], 1); }
            CSTAMP(n == 40 && wave == 0 && lane == 0, 18);
            DN_BAR_L();
            CSTAMP(n == 40 && wave == 0 && lane == 0, 19);
            { DLAS float* ob = (DLAS float*)(lds + R_OB) + 32 * wave + m;
#pragma unroll
              for (int t = 0; t < 2; ++t)
#pragma unroll
                  for (int r = 0; r < 16; ++r) ob[(32 * t + (r & 3) + 8 * (r >> 2) + 4 * hh) * 128] = o[t][r]; }
            DN_BAR_L();
            CSTAMP(n == 40 && wave == 0 && lane == 0, 20);
        }
    }
}
#undef FR
#undef SB_
#undef MF_
#undef LD_G1
#undef MM_G1
#undef LD_G2
#undef MM_G2
#undef LD_G3
#undef MM_G3
}

__device__ __forceinline__ float fsigmoid_g(float x) { return __builtin_amdgcn_rcpf(1.f + __builtin_amdgcn_exp2f(-LOG2E * x)); }
struct EpiG1 { static constexpr bool PERM = true, AFTER_DRAIN = false;
    bf16 *OD, *FK, *FV, *DQKV, *DZ; const float* onw;
    __device__ __forceinline__ void operator()(const pg8::f32x4 (&acc)[2][2][4][2], const pg8::Unit& u, int wr, int wc, int fr, int fq) const {
        const int pn = u.pn; bf16* base; int ldc, colt; float sc = 1.f;
        if (pn < 2) { base = OD; ldc = 1024; colt = pn * 256; sc = C2; }
        else if (pn < 4) { base = FK; ldc = 512; colt = (pn - 2) * 256; }
        else if (pn < 6) { base = FV; ldc = 512; colt = (pn - 4) * 256; }
        else if (pn < 12) { base = DQKV; ldc = 1536; colt = (pn - 6) * 256; }
        else { base = DZ; ldc = 512; colt = (pn - 12) * 256; }
        const int row0 = u.pm * 256 + wr * 64 + fr, col0 = colt + wc * 32 + 8 * fq;
#pragma unroll
        for (int ai = 0; ai < 2; ++ai)
#pragma unroll
            for (int m = 0; m < 4; ++m) { bf16* rowp = base + (size_t)(row0 + ai * 128 + m * 16) * ldc + col0;
#pragma unroll
                for (int bj = 0; bj < 2; ++bj) { pg8::f32x4 v0 = acc[ai][bj][m][0] * sc, v1 = acc[ai][bj][m][1] * sc; pg8::u32x4 w;
                    if (pn >= 12) { const int cw_ = (col0 + bj * 128) & 127; const pg8::f32x4 n0 = *(const pg8::f32x4*)(onw + cw_), n1 = *(const pg8::f32x4*)(onw + cw_ + 4);
#pragma unroll
                        for (int e = 0; e < 4; ++e) { v0[e] = v0[e] * fsigmoid_g(v0[e]) * n0[e]; v1[e] = v1[e] * fsigmoid_g(v1[e]) * n1[e]; } }
                    w.x = pg8::cvt_pk_bf16(v0[0], v0[1]); w.y = pg8::cvt_pk_bf16(v0[2], v0[3]); w.z = pg8::cvt_pk_bf16(v1[0], v1[1]); w.w = pg8::cvt_pk_bf16(v1[2], v1[3]);
                    *(pg8::u32x4*)(rowp + bj * 128) = w; } }
    }
};
struct SchedG1 { int c, G; const char* A; const char* B;
    __device__ __forceinline__ bool next(int i, pg8::Unit& u) const { int pm, pn; if (!pg8::static_tile(R / 256, 14, G, c, i, pm, pn)) return false;
        u.pm = pm; u.pn = pn; u.sub = 0; u.nt = 16; u.A = A + (size_t)pm * 256 * 1024 * 2; u.B = B + (size_t)pn * 256 * 1024 * 2; return true; }
    __device__ __forceinline__ void a_ready(const pg8::Unit&) const {}
    __device__ __forceinline__ void done(const pg8::Unit&) const {}
};

#define LAS __attribute__((address_space(3)))
typedef float f32x4 __attribute__((ext_vector_type(4)));
typedef unsigned v4u __attribute__((ext_vector_type(4)));
constexpr int NWAVES = 8, MISC_OFF = 147456, LDS_BYTES = MISC_OFF + 256;

#define LDS_WAIT() asm volatile("s_waitcnt lgkmcnt(0)" ::: "memory")
__device__ __forceinline__ unsigned pk2(float lo, float hi) { return f2bf(lo) | (f2bf(hi) << 16); }
__device__ __forceinline__ float wave_sum(float v) {
#pragma unroll
    for (int o = 1; o < 64; o <<= 1) v += __shfl_xor(v, o);
    return v;
}
__device__ __forceinline__ float fsigmoid(float x) { return __builtin_amdgcn_rcpf(1.f + __builtin_amdgcn_exp2f(-LOG2E * x)); }
__device__ __forceinline__ int nat_row0(int pm) { return (pm >> 4) * LP + 128 + (pm & 15) * 256; }
struct EpiBr { static constexpr bool PERM = true, AFTER_DRAIN = false;
    bf16* S; bf16* Y;
    __device__ __forceinline__ void operator()(const pg8::f32x4 (&acc)[2][2][4][2], const pg8::Unit& u, int wr, int wc, int fr, int fq) const {
        v4u* Sg = (v4u*)S + ((wr * 4 + wc) * 64 + fq * 16 + fr); const int sub = u.sub;
        const int row0 = u.pm * 256 + wr * 64 + fr, col0 = u.pn * 256 + wc * 32 + 8 * fq;
#pragma unroll
        for (int ai = 0; ai < 2; ++ai)
#pragma unroll
            for (int m = 0; m < 4; ++m)
#pragma unroll
                for (int bj = 0; bj < 2; ++bj) { const int idx = ((ai * 4 + m) * 2 + bj) * 512; const pg8::f32x4 v0 = acc[ai][bj][m][0], v1 = acc[ai][bj][m][1];
                    if ((sub & 1) == 0) { v4u w; w.x = pg8::cvt_pk_bf16(fsigmoid(v0[0]), fsigmoid(v0[1])); w.y = pg8::cvt_pk_bf16(fsigmoid(v0[2]), fsigmoid(v0[3]));
                        w.z = pg8::cvt_pk_bf16(fsigmoid(v1[0]), fsigmoid(v1[1])); w.w = pg8::cvt_pk_bf16(fsigmoid(v1[2]), fsigmoid(v1[3])); Sg[idx] = w; }
                    else { const v4u s = Sg[idx]; bf16* yp = Y + (size_t)(row0 + ai * 128 + m * 16) * 1024 + col0 + bj * 128;
                        float t[8]; t[0] = __builtin_bit_cast(float, s.x << 16) * v0[0]; t[1] = __builtin_bit_cast(float, s.x & 0xffff0000u) * v0[1]; t[2] = __builtin_bit_cast(float, s.y << 16) * v0[2]; t[3] = __builtin_bit_cast(float, s.y & 0xffff0000u) * v0[3];
                        t[4] = __builtin_bit_cast(float, s.z << 16) * v1[0]; t[5] = __builtin_bit_cast(float, s.z & 0xffff0000u) * v1[1]; t[6] = __builtin_bit_cast(float, s.w << 16) * v1[2]; t[7] = __builtin_bit_cast(float, s.w & 0xffff0000u) * v1[3];
                        if (sub == 3) { const v4u y = *(const v4u*)yp; t[0] += __builtin_bit_cast(float, y.x << 16); t[1] += __builtin_bit_cast(float, y.x & 0xffff0000u); t[2] += __builtin_bit_cast(float, y.y << 16); t[3] += __builtin_bit_cast(float, y.y & 0xffff0000u);
                            t[4] += __builtin_bit_cast(float, y.z << 16); t[5] += __builtin_bit_cast(float, y.z & 0xffff0000u); t[6] += __builtin_bit_cast(float, y.w << 16); t[7] += __builtin_bit_cast(float, y.w & 0xffff0000u); }
                        v4u w; w.x = pg8::cvt_pk_bf16(t[0], t[1]); w.y = pg8::cvt_pk_bf16(t[2], t[3]); w.z = pg8::cvt_pk_bf16(t[4], t[5]); w.w = pg8::cvt_pk_bf16(t[6], t[7]); *(v4u*)yp = w; } }
    }
};
struct SchedBr { int c, G; const char *HN, *OD, *WG, *WB;
    __device__ __forceinline__ bool next(int i, pg8::Unit& u) const { int pm, pn; if (!pg8::static_tile(64, 4, G, c, i >> 2, pm, pn)) return false;
        const int sub = i & 3; u.pm = pm; u.pn = pn; u.sub = sub; const size_t arow = (size_t)nat_row0(pm) * 2048;
        if ((sub & 1) == 0) { u.nt = 16; u.A = HN + arow; u.B = WG + (size_t)((sub >> 1) * 1024 + pn * 256) * 2048; }
        else { u.nt = 8; u.A = OD + arow + (sub >> 1) * 1024; u.B = WB + (size_t)(pn * 256) * 2048 + (sub >> 1) * 1024; }
        return true; }
    __device__ __forceinline__ void a_ready(const pg8::Unit&) const {}
    __device__ __forceinline__ void done(const pg8::Unit&) const {}
};
struct SchedStd { int c, G, nM, nN, nt; const char* A; const char* B; size_t astep, bstep;
    __device__ __forceinline__ bool next(int i, pg8::Unit& u) const { int pm, pn; if (!pg8::static_tile(nM, nN, G, c, i, pm, pn)) return false;
        u.pm = pm; u.pn = pn; u.sub = 0; u.nt = nt; u.A = A + (size_t)pm * astep; u.B = B + (size_t)pn * bstep; return true; }
    __device__ __forceinline__ void a_ready(const pg8::Unit&) const {}
    __device__ __forceinline__ void done(const pg8::Unit&) const {}
};
struct EpiRes { static constexpr bool PERM = false, AFTER_DRAIN = true;
    const float* base; float* out; bf16* HB; float* SS;
    __device__ __forceinline__ void fused(pg8::f32x4 (&acc)[2][2][4][2], const pg8::Unit& u, int wr, int wc, int fr, int fq, PG8_LAS unsigned char* lds, int wid, int lane) const {
        LAS float* P = (LAS float*)lds; const int col0 = u.pn * 256 + wc * 32 + 4 * fq;
#pragma unroll
        for (int ai = 0; ai < 2; ++ai)
#pragma unroll
            for (int m = 0; m < 4; ++m) { const int r = ai * 128 + wr * 64 + m * 16 + fr; const size_t off = (size_t)(u.pm * 256 + r) * 1024 + col0; float s = 0.f;
#pragma unroll
                for (int bj = 0; bj < 2; ++bj)
#pragma unroll
                    for (int n = 0; n < 2; ++n) { const pg8::f32x4 h = *(const pg8::f32x4*)(base + off + bj * 128 + n * 16) + acc[ai][bj][m][n];
                        *(pg8::f32x4*)(out + off + bj * 128 + n * 16) = h; s += (h[0] * h[0] + h[1] * h[1]) + (h[2] * h[2] + h[3] * h[3]);
                        if (HB) { unsigned long long w = (unsigned long long)pg8::cvt_pk_bf16(h[0], h[1]) | ((unsigned long long)pg8::cvt_pk_bf16(h[2], h[3]) << 32); *(unsigned long long*)(HB + off + bj * 128 + n * 16) = w; } }
                s += __shfl_xor(s, 16); s += __shfl_xor(s, 32);
                if (fq == 0) P[r * 4 + wc] = s; }
        asm volatile("s_waitcnt lgkmcnt(0)" ::: "memory"); __builtin_amdgcn_s_barrier(); asm volatile("" ::: "memory");
        const int t = wid * 64 + lane; if (t < 256) SS[(size_t)u.pn * RT + u.pm * 256 + t] = (P[t * 4] + P[t * 4 + 1]) + (P[t * 4 + 2] + P[t * 4 + 3]);
    }
};
struct EpiGU { static constexpr bool PERM = true, AFTER_DRAIN = false;
    const float* SS; bf16* HID;
    __device__ __forceinline__ void operator()(const pg8::f32x4 (&acc)[2][2][4][2], const pg8::Unit& u, int wr, int wc, int fr, int fq) const {
        const int row0 = u.pm * 256 + wr * 64 + fr, col0 = u.pn * 128 + wc * 32 + 8 * fq;
#pragma unroll
        for (int ai = 0; ai < 2; ++ai)
#pragma unroll
            for (int m = 0; m < 4; ++m) { const int row = row0 + ai * 128 + m * 16;
                const float rs = rsqrtf(((SS[row] + SS[RT + row]) + (SS[2 * RT + row] + SS[3 * RT + row])) * (1.f / DM) + EPS); float h[8];
#pragma unroll
                for (int n = 0; n < 2; ++n)
#pragma unroll
                    for (int e = 0; e < 4; ++e) { const float g = acc[ai][0][m][n][e] * rs, up = acc[ai][1][m][n][e] * rs; h[4 * n + e] = g * fsigmoid(g) * up; }
                v4u w; w.x = pg8::cvt_pk_bf16(h[0], h[1]); w.y = pg8::cvt_pk_bf16(h[2], h[3]); w.z = pg8::cvt_pk_bf16(h[4], h[5]); w.w = pg8::cvt_pk_bf16(h[6], h[7]);
                *(v4u*)(HID + (size_t)row * DFF + col0) = w; }
    }
};
#define XB_TMO      128
#define XB_XCNT(j)  (256  + 64 * (j))
#define XB_XSUB(j)  (1280 + 64 * (j))
#define XB_XGEN(j)  (2304 + 64 * (j))
#define XB_TOP      3328
#define XB_TOPGEN   3392
#define XCD_BAR_WORDS 3456
#define XB_SPIN_CAP (1u << 18)

__device__ __forceinline__ unsigned xb_ld(unsigned* p)              { return __hip_atomic_load(p, __ATOMIC_RELAXED, __HIP_MEMORY_SCOPE_AGENT); }
__device__ __forceinline__ unsigned xb_add(unsigned* p, unsigned v) { return __hip_atomic_fetch_add(p, v, __ATOMIC_RELAXED, __HIP_MEMORY_SCOPE_AGENT); }
__device__ __forceinline__ unsigned xb_xcc_id() { return (unsigned)__builtin_amdgcn_s_getreg((3 << 11) | 20) & 0xFu; }
#define XB_SPIN(cond, bar) do { unsigned _sp = 0; while (cond) { __builtin_amdgcn_s_sleep(1); \
    if ((++_sp & 255u) == 0u) { if (xb_ld(&(bar)[XB_TMO])) break; if (_sp > XB_SPIN_CAP) { atomicAdd(&(bar)[XB_TMO], 1u); break; } } } } while (0)

struct XcdBarrier {
    unsigned* bar; unsigned x;
    volatile LAS unsigned* st;
};

__device__ __forceinline__ XcdBarrier xcd_barrier_post(unsigned* bar, volatile LAS unsigned* st, bool t0) {
    XcdBarrier b; b.bar = bar; b.x = xb_xcc_id(); b.st = st;
    if (t0) (void)xb_add(&bar[XB_XCNT(b.x)], 1u);
    return b;
}
__device__ __forceinline__ void xcd_barrier_complete(unsigned* bar, unsigned x, unsigned& nloc, unsigned& nx) {
    const unsigned G = gridDim.x * gridDim.y * gridDim.z;
    unsigned sum, cnt, mine, sp = 0u;
    for (;;) {
        sum = 0u; cnt = 0u; mine = 0u;
#pragma unroll
        for (unsigned j = 0; j < 16; ++j) { const unsigned c = xb_ld(&bar[XB_XCNT(j)]); sum += c; cnt += (c > 0u) ? 1u : 0u; mine = (j == x) ? c : mine; }
        if (sum == G) break;
        __builtin_amdgcn_s_sleep(1);
        if ((++sp & 255u) == 0u) { if (xb_ld(&bar[XB_TMO])) break; if (sp > XB_SPIN_CAP) { atomicAdd(&bar[XB_TMO], 1u); break; } }
    }
    nloc = mine > 0u ? mine : 1u; nx = cnt > 0u ? cnt : 1u;
}

__device__ __forceinline__ void xcd_barrier(const XcdBarrier& b, bool t0) {
    asm volatile("s_waitcnt vmcnt(0)" ::: "memory");
    __syncthreads();
    if (t0) {
        unsigned* bar = b.bar;
        __builtin_amdgcn_s_waitcnt(0);
        unsigned nloc = b.st[0], nx = b.st[1];
        if (nloc == 0u) { xcd_barrier_complete(bar, b.x, nloc, nx); b.st[0] = nloc; b.st[1] = nx; }
        const unsigned old = xb_add(&bar[XB_XSUB(b.x)], 1u);
        const unsigned gen = old / nloc;
        if (old + 1u == (gen + 1u) * nloc) {
            __builtin_amdgcn_fence(__ATOMIC_RELEASE, "agent");
            asm volatile("s_waitcnt vmcnt(0)" ::: "memory");
            const unsigned og = xb_add(&bar[XB_TOP], 1u);
            const unsigned tg = og / nx;
            if (og + 1u == (tg + 1u) * nx) xb_add(&bar[XB_TOPGEN], 1u);
            else XB_SPIN(xb_ld(&bar[XB_TOPGEN]) == tg, bar);
            __builtin_amdgcn_fence(__ATOMIC_ACQUIRE, "agent");
            xb_add(&bar[XB_XGEN(b.x)], 1u);
            asm volatile("s_waitcnt vmcnt(0)" ::: "memory");
        } else {
            XB_SPIN(xb_ld(&bar[XB_XGEN(b.x)]) == gen, bar);
            __builtin_amdgcn_fence(__ATOMIC_ACQUIRE, "agent");
            asm volatile("s_waitcnt vmcnt(0)" ::: "memory");
        }
    }
    __syncthreads();
}


struct Args { const float* in[17]; float* out; unsigned char* ws; int ph_lo, ph_hi; };

__device__ __forceinline__ void p0_transpose_item(const float* __restrict__ W, int srcN, int col0, int k0, bf16* __restrict__ WT, int drow0, int ldk, int koff, const float* __restrict__ scale, LAS float* scr, int lane) {
    float tv[32];
#pragma unroll
    for (int i = 0; i < 32; ++i) { const int kk = 2 * i + (lane >> 5); tv[i] = W[(size_t)(k0 + kk) * srcN + col0 + (lane & 31)]; }
#pragma unroll
    for (int i = 0; i < 32; ++i) { const int kk = 2 * i + (lane >> 5); float v = tv[i]; if (scale) v *= scale[k0 + kk]; scr[kk * 33 + (lane & 31)] = v; }
    LDS_WAIT(); asm volatile("" ::: "memory");
    const int c = lane & 7;
#pragma unroll
    for (int j = 0; j < 4; ++j) { const int n = (lane >> 3) + 8 * j; const LAS float* s = scr + (8 * c) * 33 + n;
        v4u o; o.x = pk2(s[0 * 33], s[1 * 33]); o.y = pk2(s[2 * 33], s[3 * 33]); o.z = pk2(s[4 * 33], s[5 * 33]); o.w = pk2(s[6 * 33], s[7 * 33]);
        *(v4u*)(WT + (size_t)(drow0 + n) * ldk + koff + k0 + 8 * c) = o; }
    LDS_WAIT(); asm volatile("" ::: "memory");
}
__device__ __forceinline__ bool p0_mat(int& r, const float* W, int srcN, int col0, int Ncols, int K, bf16* WT, int drow0, int ldk, int koff, const float* scale, int rowmode, LAS float* scr, int lane) {
    const int nblk = Ncols / 32, nitems = (K / 64) * nblk;
    if (r >= nitems) { r -= nitems; return false; }
    const int kb = r / nblk, nb = r % nblk, n0 = 32 * nb;
    const int dr = rowmode == 0 ? drow0 + n0 : ((n0 >> 7) * 256 + (n0 & 127) + (rowmode == 2 ? 128 : 0));
    p0_transpose_item(W, srcN, col0 + n0, 64 * kb, WT, dr, ldk, koff, scale, scr, lane); return true;
}

__global__ void __launch_bounds__(NWAVES * 64, 2) mega(Args args) {
    extern __shared__ __attribute__((aligned(16))) unsigned char lds_raw[];
    cg::grid_group grid = cg::this_grid();
    LAS unsigned char* lds = (LAS unsigned char*)lds_raw;
#define FRESH_TID() int lane = lane_id(); asm volatile("" : "+v"(lane)); const int wave = wave_s, tid = wave * 64 + lane; (void)tid
    const int wave_s = __builtin_amdgcn_readfirstlane((int)threadIdx.x >> 6);
    const int G = gridDim.x, bx = blockIdx.x;
    const int vcu = (G % 8 == 0) ? (bx % 8) * (G / 8) + bx / 8 : bx;
    unsigned char* ws = args.ws;
    const float* x = args.in[0]; const float* meta = args.in[1]; const float* mix_nw = args.in[2]; const float* w_in = args.in[3];
    const float* fbias = args.in[4]; const float* a_log = args.in[6]; const float* dt_bias = args.in[7];
    const float* wbf = args.in[9]; const float* wbd = args.in[10]; const float* wout = args.in[11];
    const float* ffn_nw = args.in[12]; const float* wg = args.in[13]; const float* wu = args.in[14]; const float* wd = args.in[15];
    float *CQ = (float*)(ws + WS_CQ), *GG = (float*)(ws + WS_GG), *BT = (float*)(ws + WS_BT), *LF = (float*)(ws + WS_LF);
    bf16 *WIN = (bf16*)(ws + WS_WIN), *WG = (bf16*)(ws + WS_WG), *WB = (bf16*)(ws + WS_WB), *WOUT = (bf16*)(ws + WS_WOUT), *WGU = (bf16*)(ws + WS_WGU), *WDN = (bf16*)(ws + WS_WDN);
    bf16 *HN = (bf16*)(ws + WS_HN), *OD = (bf16*)(ws + WS_OD), *FK = (bf16*)(ws + WS_FK), *FV = (bf16*)(ws + WS_FV), *DQKV = (bf16*)(ws + WS_DQKV), *DZ = (bf16*)(ws + WS_DZ), *Y = (bf16*)(ws + WS_Y), *HID = (bf16*)(ws + WS_HID), *H1B = HN;
    float *SS1 = (float*)(ws + WS_SS1), *SS2 = (float*)(ws + WS_SS2);
    const int lo = args.ph_lo, hi = args.ph_hi;
    if (hi < 0) grid.sync();
    { int l0 = lane_id(); if (wave_s == 0 && l0 < 64) ((volatile LAS unsigned*)(lds + MISC_OFF))[l0] = 0u; }
    __syncthreads();
    const XcdBarrier xbar = xcd_barrier_post((unsigned*)(ws + WS_BAR), (volatile LAS unsigned*)(lds + MISC_OFF), wave_s == 0 && lane_id() == 0);
#define GRID_SYNC() xcd_barrier(xbar, wave_s == 0 && lane_id() == 0)
#define STAMP(k) do { if (PROBE_TS && bx == 0 && wave_s == 0 && lane_id() == 0) { const unsigned long long t_ = __builtin_amdgcn_s_memrealtime(); ((volatile LAS unsigned*)(lds + MISC_OFF))[32 + 2 * (k)] = (unsigned)t_; } } while (0)
    STAMP(0);
#define STAMPG(slot, blk) do { if (PROBE_TS && bx == (blk) && wave_s == 0 && lane_id() == 0) __hip_atomic_store((unsigned*)(ws + WS_BAR) + 6144 + (slot), (unsigned)__builtin_amdgcn_s_memrealtime(), __ATOMIC_RELAXED, __HIP_MEMORY_SCOPE_AGENT); } while (0)
    STAMPG(29, 0);
#define IN(k) (lo <= (k) && (k) < hi)
#define BOTH(k) (IN(k) && IN((k) + 1))

    if (IN(0)) {
      { int reps_ = 1 + ((PROBE_REP >> 0) & 1); asm volatile("" : "+s"(reps_)); for (int rep_ = 0; rep_ < reps_; ++rep_) {
        FRESH_TID();
        const int gw = vcu * NWAVES + wave, NGW = G * NWAVES;
        { LAS float* scr = (LAS float*)(lds + wave * 16384);
          constexpr int NITEMS = 16 * 112 + 16 * 64 + 2 * 8 * 32 + 16 * 32 + 2 * 16 * 88 + 44 * 32;
          for (int it = gw; it < NITEMS; it += NGW) { int r = it;
            if (p0_mat(r, w_in, DIN, 0, 1536, 1024, WIN, 0, 1024, 0, nullptr, 0, scr, lane)) continue;
            if (p0_mat(r, w_in, DIN, 1544, 1536, 1024, WIN, 1536, 1024, 0, nullptr, 0, scr, lane)) continue;
            if (p0_mat(r, w_in, DIN, 3088, 512, 1024, WIN, 3072, 1024, 0, nullptr, 0, scr, lane)) continue;
            if (p0_mat(r, w_in, DIN, 3600, 2048, 1024, WG, 0, 1024, 0, nullptr, 0, scr, lane)) continue;
            if (p0_mat(r, wbf, 1024, 0, 1024, 512, WB, 0, 1024, 0, nullptr, 0, scr, lane)) continue;
            if (p0_mat(r, wbd, 1024, 0, 1024, 512, WB, 0, 1024, 512, nullptr, 0, scr, lane)) continue;
            if (p0_mat(r, wout, 1024, 0, 1024, 1024, WOUT, 0, 1024, 0, nullptr, 0, scr, lane)) continue;
            if (p0_mat(r, wg, DFF, 0, DFF, 1024, WGU, 0, 1024, 0, ffn_nw, 1, scr, lane)) continue;
            if (p0_mat(r, wu, DFF, 0, DFF, 1024, WGU, 0, 1024, 0, ffn_nw, 2, scr, lane)) continue;
            p0_mat(r, wd, 1024, 0, 1024, DFF, WDN, 0, DFF, 0, nullptr, 0, scr, lane);
          } }
        STAMPG(27, 0);
        __syncthreads();
        LAS float* W16 = (LAS float*)lds;
#pragma unroll 2
        for (int i = tid; i < 1024 * 4; i += NWAVES * 64) { const int k = i >> 2, q = i & 3;
            const f32x4 v = *(const f32x4*)(w_in + (size_t)k * DIN + (q < 2 ? 1536 + 4 * q : 3080 + 4 * (q - 2)));
            *(LAS f32x4*)(W16 + ((k & 3) * 256 + (k >> 2)) * 20 + 4 * q) = v; }
        __syncthreads();
        f32x4 vnx[4];
#define HN_SRC(rr) (((rr) % LP) < NPAD ? (const float*)nullptr : (((rr) % LP) < 128 ? meta + (size_t)(((rr) % LP) - NPAD) * DM : x + ((size_t)((rr) / LP) * SEQ + (((rr) % LP) - 128)) * DM))
#define HN_LOAD(dst, rr) do { const float* s_ = HN_SRC(rr); _Pragma("unroll") for (int j = 0; j < 4; ++j) dst[j] = s_ ? ((const f32x4*)s_)[lane + 64 * j] : (f32x4){0.f, 0.f, 0.f, 0.f}; } while (0)
        f32x4 nwr[4];
#pragma unroll
        for (int j = 0; j < 4; ++j) nwr[j] = ((const f32x4*)mix_nw)[lane + 64 * j];
        if (gw < R) HN_LOAD(vnx, gw);
        for (int r = gw; r < R; r += NGW) {
            const int b = r / LP, pos = r % LP;
            f32x4 v[4]; float ss = 0.f;
#pragma unroll
            for (int j = 0; j < 4; ++j) { v[j] = vnx[j]; ss += (v[j].x * v[j].x + v[j].y * v[j].y) + (v[j].z * v[j].z + v[j].w * v[j].w); }
            if (r + NGW < R) HN_LOAD(vnx, r + NGW);
            const float rs = rsqrtf(wave_sum(ss) * (1.f / DM) + EPS);
            unsigned long long* o8 = (unsigned long long*)(HN + (size_t)r * DM) + lane;
            float acc[16];
#pragma unroll
            for (int c = 0; c < 16; ++c) acc[c] = 0.f;
#pragma unroll
            for (int j = 0; j < 4; ++j) { asm volatile("" ::: "memory");
                const f32x4 hn = v[j] * rs * nwr[j];
                o8[64 * j] = (unsigned long long)pk2(hn.x, hn.y) | ((unsigned long long)pk2(hn.z, hn.w) << 32);
#pragma unroll
                for (int e = 0; e < 4; ++e) { const LAS float* wr_ = W16 + (e * 256 + lane + 64 * j) * 20; const float he = hn[e];
#pragma unroll
                    for (int q = 0; q < 4; ++q) { const f32x4 w = *(const LAS f32x4*)(wr_ + 4 * q); acc[4 * q] += he * w.x; acc[4 * q + 1] += he * w.y; acc[4 * q + 2] += he * w.z; acc[4 * q + 3] += he * w.w; } } }
            float a8[8], a4[4], a2[2], mine;
            { const bool up = (lane & 32) != 0;
#pragma unroll
              for (int j = 0; j < 8; ++j) { const float keep = up ? acc[j + 8] : acc[j], send = up ? acc[j] : acc[j + 8]; a8[j] = keep + __shfl_xor(send, 32); } }
            { const bool up = (lane & 16) != 0;
#pragma unroll
              for (int j = 0; j < 4; ++j) { const float keep = up ? a8[j + 4] : a8[j], send = up ? a8[j] : a8[j + 4]; a4[j] = keep + __shfl_xor(send, 16); } }
            { const bool up = (lane & 8) != 0;
#pragma unroll
              for (int j = 0; j < 2; ++j) { const float keep = up ? a4[j + 2] : a4[j], send = up ? a4[j] : a4[j + 2]; a2[j] = keep + __shfl_xor(send, 8); } }
            { const bool up = (lane & 4) != 0; const float keep = up ? a2[1] : a2[0], send = up ? a2[0] : a2[1]; mine = keep + __shfl_xor(send, 4); }
            mine += __shfl_xor(mine, 1); mine += __shfl_xor(mine, 2);
            if ((lane & 3) == 0) { const bool valid = pos >= NPAD; const int j = lane >> 2;
                const float bias = j < 8 ? fbias[j] : (j < 12 ? 0.f : dt_bias[j - 12]); const float z = mine + bias;
                const float e = __expf(-fabsf(z)), l1p = __logf(1.f + e);
                if (j < 8) LF[(size_t)(b * 8 + j) * LP + pos] = fminf(z, 0.f) - l1p;
                else if (j < 12) BT[(size_t)(b * 4 + (j - 8)) * LP + pos] = valid ? (z >= 0.f ? 1.f : e) * __builtin_amdgcn_rcpf(1.f + e) : 0.f;
                else GG[(size_t)(b * 4 + (j - 12)) * LP + pos] = valid ? -__expf(a_log[j - 12]) * (fmaxf(z, 0.f) + l1p) : 0.f; }
        }
#undef HN_SRC
#undef HN_LOAD
      } }
        STAMPG(28, 0);
        if (BOTH(0)) { GRID_SYNC(); for (int e_ = 0; e_ < PROBE_SYNC; ++e_) GRID_SYNC(); } STAMP(1);
    }
    if (IN(1)) {
      { int reps_ = 1 + ((PROBE_REP >> 1) & 1); asm volatile("" : "+s"(reps_)); for (int rep_ = 0; rep_ < reps_; ++rep_) {
        __syncthreads();
        { pg8::Gemm g{1024, 1024}; SchedG1 S{bx, G, (const char*)HN, (const char*)WIN}; EpiG1 E{OD, FK, FV, DQKV, DZ, args.in[8]};
          pg8::gemm_phase<EpiG1, SchedG1, true, true>(lds, g, S, E, wave_s); }
        if (bx >= G - 32) {
            FRESH_TID();
            __syncthreads();
            const int bh = bx - (G - 32); LAS float* part = (LAS float*)lds;
            const float* lf = LF + (size_t)bh * LP; float* cq = CQ + (size_t)bh * LP;
            float v[9]; float run = 0.f;
#pragma unroll
            for (int e = 0; e < 9; ++e) { const int i = tid * 9 + e; const float t = (i < LP && i >= NPAD) ? lf[i] : 0.f; run += t; v[e] = run; }
            float incl = run;
#pragma unroll
            for (int o = 1; o < 64; o <<= 1) { const float t = __shfl_up(incl, o); if (lane >= o) incl += t; }
            if (lane == 63) part[wave] = incl;
            __syncthreads();
            float base = incl - run;
            for (int w = 0; w < wave; ++w) base += part[w];
#pragma unroll
            for (int e = 0; e < 9; ++e) { const int i = tid * 9 + e; if (i < LP) cq[i] = i >= NPAD ? (base + v[e]) * LOG2E : 1e30f; }
        }
      } }
        if (BOTH(1)) { GRID_SYNC(); for (int e_ = 0; e_ < PROBE_SYNC; ++e_) GRID_SYNC(); } STAMP(2);
    }
    if (IN(2)) {
        FRESH_TID();
        __syncthreads();
        unsigned* FLAG = (unsigned*)(ws + WS_BAR) + 4096;
        const dn::PrepArgs P{DQKV, args.in[5], GG, BT, (unsigned char*)args.out, (float*)(ws + WS_U), (float*)(ws + WS_CD), FLAG, (PROBE_TS && bx == 17) ? (unsigned*)(ws + WS_BAR) + 6144 + 30 : nullptr};
        STAMPG(20, 0);
        if (bx < 16) {
            const dn::RecArgs A{(const unsigned char*)args.out, (const float*)(ws + WS_U), (const float*)(ws + WS_CD), DZ, args.in[8], OD, FLAG, (PROBE_TS && bx == 0) ? (unsigned*)(ws + WS_BAR) + 6144 + 40 : nullptr};
            dn::rec_chain<0>(lds, A, bx, wave, lane); __syncthreads(); STAMPG(21, 0);
            if ((PROBE_REP >> 10) & 1) { dn::rec_chain<1>(lds, A, bx, wave, lane); __syncthreads(); }
            if ((PROBE_REP >> 12) & 1) { dn::rec_chain<2>(lds, A, bx, wave, lane); __syncthreads(); } }
        { unsigned* ctr = (unsigned*)(ws + WS_BAR) + 3584; volatile LAS unsigned* slot = (volatile LAS unsigned*)(lds + MISC_OFF + 64);
#define PULL_(idx_) do { int ln_ = lane_id(); asm volatile("" : "+v"(ln_)); if (wave_s == 0 && ln_ == 0) *slot = atomicAdd(ctr, 1u); __syncthreads(); idx_ = (unsigned)__builtin_amdgcn_readfirstlane((int)*slot); } while (0)
          unsigned idx; PULL_(idx);
          while (idx < (unsigned)dn::NITEM) { int ln = lane_id(); asm volatile("" : "+v"(ln)); dn::prep_item(lds, P, (int)(idx & 15u), 1 + (int)(idx >> 4), wave_s, ln); PULL_(idx); }
          STAMPG(23, 17); STAMPG(25, 255);
          while (idx < (unsigned)dn::NITEM + 512u) { const unsigned u = idx - (unsigned)dn::NITEM; const int bh = (int)(u & 31u), qb = 15 - (int)(u >> 5);
              attn_body::attn_unit<8>(bh >> 3, bh & 7, qb, (const attn_body::bf16*)OD, (const attn_body::bf16*)FK, (const attn_body::bf16*)FV, (attn_body::bf16*)OD, CQ, (char*)lds_raw, wave_s); PULL_(idx); }
          STAMPG(22, 0); STAMPG(24, 17); STAMPG(26, 255);
#undef PULL_
        }
        if (BOTH(2)) { GRID_SYNC(); for (int e_ = 0; e_ < PROBE_SYNC; ++e_) GRID_SYNC(); } STAMP(3);
    }
    if (IN(3)) { STAMP(4); }
    if (IN(4)) {
      { int reps_ = 1 + ((PROBE_REP >> 4) & 1); asm volatile("" : "+s"(reps_)); for (int rep_ = 0; rep_ < reps_; ++rep_) {
        __syncthreads();
        { pg8::Gemm g{1024, 1024}; SchedBr S{bx, G, (const char*)HN, (const char*)OD, (const char*)WG, (const char*)WB}; EpiBr E{(bf16*)args.out + (size_t)bx * 65536, Y};
          pg8::gemm_phase<EpiBr, SchedBr, true, true>(lds, g, S, E, wave_s); }
      } }
        if (BOTH(4)) { GRID_SYNC(); for (int e_ = 0; e_ < PROBE_SYNC; ++e_) GRID_SYNC(); } STAMP(5);
    }
    if (IN(5)) {
      if ((PROBE_REP >> 11) & 1) { const unsigned long long t0_ = __builtin_amdgcn_s_memrealtime(); while (__builtin_amdgcn_s_memrealtime() - t0_ < 10000ull) __builtin_amdgcn_s_sleep(8); }
      { int reps_ = 1 + ((PROBE_REP >> 5) & 1); asm volatile("" : "+s"(reps_)); for (int rep_ = 0; rep_ < reps_; ++rep_) {
        __syncthreads();
        { pg8::Gemm g{1024, 1024}; SchedStd S{bx, G, 64, 4, 16, (const char*)Y, (const char*)WOUT, (size_t)256 * 1024 * 2, (size_t)256 * 1024 * 2}; EpiRes E{x, args.out, H1B, SS1};
          pg8::gemm_phase<EpiRes, SchedStd, false, true>(lds, g, S, E, wave_s); }
      } }
        if (BOTH(5)) { GRID_SYNC(); for (int e_ = 0; e_ < PROBE_SYNC; ++e_) GRID_SYNC(); } STAMP(6);
    }
    if (IN(6)) {
      { int reps_ = 1 + ((PROBE_REP >> 6) & 1); asm volatile("" : "+s"(reps_)); for (int rep_ = 0; rep_ < reps_; ++rep_) {
        __syncthreads();
        { pg8::Gemm g{1024, 1024}; SchedStd S{bx, G, 64, 22, 16, (const char*)H1B, (const char*)WGU, (size_t)256 * 1024 * 2, (size_t)256 * 1024 * 2}; EpiGU E{SS1, HID};
          pg8::gemm_phase<EpiGU, SchedStd, true, true>(lds, g, S, E, wave_s); }
      } }
        if (BOTH(6)) { GRID_SYNC(); for (int e_ = 0; e_ < PROBE_SYNC; ++e_) GRID_SYNC(); } STAMP(7);
    }
    if (IN(7)) {
        __syncthreads();
        { pg8::Gemm g{DFF, DFF}; SchedStd S{bx, G, 64, 4, 44, (const char*)HID, (const char*)WDN, (size_t)256 * DFF * 2, (size_t)256 * DFF * 2}; EpiRes E{args.out, args.out, nullptr, SS2};
          pg8::gemm_phase<EpiRes, SchedStd, false, true>(lds, g, S, E, wave_s); }
        if (BOTH(7)) { GRID_SYNC(); for (int e_ = 0; e_ < PROBE_SYNC; ++e_) GRID_SYNC(); } STAMP(8);
    }
    if (IN(8)) {
        FRESH_TID();
        const int gw = vcu * NWAVES + wave, NGW = G * NWAVES; const float* fnw = args.in[16];
        for (int m = gw; m < RT; m += NGW) { f32x4* o = (f32x4*)(args.out + (size_t)m * DM) + lane;
            const float rs = rsqrtf(((SS2[m] + SS2[RT + m]) + (SS2[2 * RT + m] + SS2[3 * RT + m])) * (1.f / DM) + EPS);
#pragma unroll
            for (int j = 0; j < 4; ++j) o[64 * j] = o[64 * j] * rs * ((const f32x4*)fnw)[lane + 64 * j]; }
        STAMP(9);
        if (PROBE_TS && bx == 0 && wave_s == 0 && lane_id() == 0) { asm volatile("s_waitcnt vmcnt(0) lgkmcnt(0)" ::: "memory"); volatile LAS unsigned* ts_ = (volatile LAS unsigned*)(lds + MISC_OFF) + 32;
            unsigned d_ = PROBE_TS == 10 ? ts_[2 * 9] - ts_[0] : ts_[2 * (PROBE_TS % 100)] - ts_[2 * ((PROBE_TS % 100) - 1)];
            if (PROBE_TS >= 100) { const unsigned* g_ = (const unsigned*)(ws + WS_BAR) + 6144; d_ = __hip_atomic_load(g_ + PROBE_TS / 100, __ATOMIC_RELAXED, __HIP_MEMORY_SCOPE_AGENT) - __hip_atomic_load(g_ + PROBE_TS % 100, __ATOMIC_RELAXED, __HIP_MEMORY_SCOPE_AGENT); }
            args.out[0] += (PROBE_TS >= 5000 ? 2e-3f : 1e-4f) * (float)(int)d_; }
    }
#undef IN
#undef BOTH
}
extern "C" void kernel_launch(void* const* d_in, const int* in_sizes, int n_in, void* d_out, int out_size, void* d_ws, size_t ws_size, hipStream_t stream) {
    if (n_in != 17 || ws_size < WS_END || out_size != RT * DM) { fprintf(stderr, "kernel_launch: unexpected shapes (n_in %d, ws %zu, out %d)\n", n_in, ws_size, out_size); return; }
    static int grid = 0;
    if (grid == 0) {
        int dev = 0, cus = 0, per_cu = 0; (void)hipGetDevice(&dev); (void)hipDeviceGetAttribute(&cus, hipDeviceAttributeMultiprocessorCount, dev);
        if (hipFuncSetAttribute((const void*)mega, hipFuncAttributeMaxDynamicSharedMemorySize, LDS_BYTES) != hipSuccess) { fprintf(stderr, "kernel_launch: hipFuncSetAttribute failed\n"); grid = -1; return; }
        if (hipOccupancyMaxActiveBlocksPerMultiprocessor(&per_cu, (const void*)mega, NWAVES * 64, LDS_BYTES) != hipSuccess || per_cu < 1) { fprintf(stderr, "kernel_launch: occupancy query says %d\n", per_cu); per_cu = 1; }
        (void)hipGetLastError();
        grid = cus;
        if (grid != 256) fprintf(stderr, "kernel_launch: %d CUs (built for 256)\n", grid);
    }
    if (grid < 0) return;
    unsigned char* ws = (unsigned char*)d_ws; float* out = (float*)d_out;
    if (hipMemsetAsync((char*)d_ws + WS_BAR, 0, 32768, stream) != hipSuccess) { fprintf(stderr, "kernel_launch: memset failed\n"); return; }
    Args a{}; for (int i = 0; i < 17; ++i) a.in[i] = (const float*)d_in[i]; a.out = out; a.ws = ws; a.ph_lo = 0; a.ph_hi = 9;
    { void* params[] = {&a}; hipError_t e = hipLaunchCooperativeKernel((const void*)mega, dim3(grid), dim3(NWAVES * 64), params, LDS_BYTES, stream);
      if (e != hipSuccess) { fprintf(stderr, "kernel_launch: cooperative launch failed: %s\n", hipGetErrorString(e)); return; } }
}
```
